# Optimizing an MI355X kernel written in HIP

```python
import math
import jax, jax.numpy as jnp
from jax import lax
import numpy as np

D_MODEL = 1024
BATCH = 8
SEQ = 2048
DEPTH = 1
DEC_BATCH = 32
DEC_SEQ = 1
PAST_LEN = 16384
PAGE_SIZE = 128

RET_HEADS = 8
RET_DK = 64
RET_DV = 128
RET_CHUNK = 128
ROPE_BASE = 10000.0
ATT_WINDOWS = (128, 512, 2048)
ATT_DILATIONS = (1, 4, 16)
ATT_GROUPS = 3
ATT_HEADS_PER_GROUP = 4
ATT_HEADS = ATT_GROUPS * ATT_HEADS_PER_GROUP
ATT_HD = 128
REL_BUCKETS = 32
REL_MAX_DIST = 2048
D_FF = 4 * D_MODEL
D_PLE = 256
NORM_EPS = 1e-6

RET_QK_W = RET_HEADS * RET_DK
RET_V_W = RET_HEADS * RET_DV
ATT_W = ATT_HEADS * ATT_HD
ATT_OUT_W = ATT_HEADS_PER_GROUP * ATT_HD
IN_SPLITS = (RET_QK_W, RET_QK_W, RET_V_W, RET_V_W, ATT_W, ATT_W, ATT_W, D_MODEL, D_MODEL)
N_IN = sum(IN_SPLITS)

kernel_name = "retention_dilated_swa_hybrid_step"


def rms_norm(x, g):
    xf = x.astype(jnp.float32)
    y = xf * lax.rsqrt(jnp.mean(xf * xf, axis=-1, keepdims=True) + NORM_EPS)
    return (y * g.astype(jnp.float32)).astype(x.dtype)


def rotary(x, pos):
    half = x.shape[-1] // 2
    inv = ROPE_BASE ** (-jnp.arange(half, dtype=jnp.float32) / half)
    ang = pos.astype(jnp.float32)[:, None] * inv[None, :]
    cos = jnp.cos(ang)[None, :, None, :]
    sin = jnp.sin(ang)[None, :, None, :]
    x1, x2 = x[..., :half], x[..., half:]
    return jnp.concatenate([x1 * cos - x2 * sin, x1 * sin + x2 * cos], axis=-1)


def ret_log_decay():
    return jnp.log1p(-jnp.exp2(-5.0 - jnp.arange(RET_HEADS, dtype=jnp.float32)))


def retention_chunk(state, q, k, v, log_gamma):
    C = q.shape[1]
    i = jnp.arange(C, dtype=jnp.float32)
    diff = i[:, None] - i[None, :]
    decay = jnp.where(diff[None] >= 0,
                      jnp.exp(jnp.maximum(diff, 0.0)[None] * log_gamma[:, None, None]), 0.0)
    scores = jnp.einsum('bihk,bjhk->bhij', q, k) * decay[None]
    o_in = jnp.einsum('bhij,bjhv->bihv', scores, v)
    q_decay = jnp.exp((i + 1.0)[:, None] * log_gamma[None, :])
    o_cross = jnp.einsum('bihk,bhkv->bihv', q, state) * q_decay[None, :, :, None]
    k_decay = jnp.exp((C - 1.0 - i)[:, None] * log_gamma[None, :])
    new_state = (state * jnp.exp(C * log_gamma)[None, :, None, None]
                 + jnp.einsum('bjhk,bjhv->bhkv', k * k_decay[None, :, :, None], v))
    return new_state, o_in + o_cross


def retention_scan(q, k, v, state0, log_gamma):
    B, S, H, _ = q.shape
    nc = S // RET_CHUNK
    xs = tuple(a.reshape(B, nc, RET_CHUNK, H, a.shape[-1]).swapaxes(0, 1) for a in (q, k, v))

    def step(st, chunk):
        qc, kc, vc = chunk
        return retention_chunk(st, qc, kc, vc, log_gamma)

    st, o = lax.scan(step, state0, xs)
    return o.swapaxes(0, 1).reshape(B, S, H, v.shape[-1]), st


def retention_readout(o, g, gn_g):
    B, T = o.shape[0], o.shape[1]
    mu = jnp.mean(o, axis=-1, keepdims=True)
    var = jnp.mean(jnp.square(o - mu), axis=-1, keepdims=True)
    on = ((o - mu) * lax.rsqrt(var + NORM_EPS)).reshape(B, T, RET_V_W) * gn_g.astype(jnp.float32)
    return jax.nn.silu(g.astype(jnp.float32)) * on


def rel_bucket(dist):
    max_exact = REL_BUCKETS // 2
    d = dist.astype(jnp.int32)
    log_ratio = jnp.log(jnp.maximum(d, 1).astype(jnp.float32) / max_exact) / math.log(REL_MAX_DIST / max_exact)
    large = max_exact + (log_ratio * (REL_BUCKETS - max_exact)).astype(jnp.int32)
    large = jnp.minimum(large, REL_BUCKETS - 1)
    return jnp.where(d < max_exact, d, large)


def group_bias(rel_bias, g):
    dil = ATT_DILATIONS[g]
    nk = ATT_WINDOWS[g] // dil
    b = rel_bucket(jnp.arange(nk) * dil)
    tab = rel_bias[b][:, g * ATT_HEADS_PER_GROUP:(g + 1) * ATT_HEADS_PER_GROUP]
    return tab.T.astype(jnp.float32)


def dilated_attn_prompt(q, k, v, dil, nk, bias):
    B, S, H, E = q.shape
    L = S // dil
    nb = -(-L // nk)
    Lp = nb * nk

    def to_stream(a):
        a = a.reshape(B, L, dil, H, E).transpose(0, 2, 1, 3, 4)
        a = jnp.pad(a, ((0, 0), (0, 0), (0, Lp - L), (0, 0), (0, 0)))
        return a.reshape(B, dil, nb, nk, H, E)

    def with_prev(a):
        prev = jnp.pad(a, ((0, 0), (0, 0), (1, 0), (0, 0), (0, 0), (0, 0)))[:, :, :nb]
        return jnp.concatenate([prev, a], axis=3)

    qs = to_stream(q)
    kk = with_prev(to_stream(k))
    vv = with_prev(to_stream(v))
    i = jnp.arange(nk)[:, None]
    c = jnp.arange(2 * nk)[None, :]
    jd = i + nk - c
    rel_ok = (jd >= 0) & (jd < nk)
    blk = jnp.arange(nb)[:, None, None]
    ok = rel_ok[None] & ((blk > 0) | (c[None] >= nk))
    b_full = bias[:, jnp.clip(jd, 0, nk - 1)]
    s = jnp.einsum('bdnihe,bdnche->bdnhic', qs, kk) * (E ** -0.5) + b_full
    s = jnp.where(ok[:, None], s, -jnp.inf)
    m = jnp.max(s, axis=-1, keepdims=True)
    p = jnp.exp(s - m)
    den = jnp.sum(p, axis=-1, keepdims=True)
    o = jnp.einsum('bdnhic,bdnche->bdnihe', p, vv) / jnp.swapaxes(den, 3, 4)
    lse = jnp.swapaxes((m + jnp.log(den))[..., 0], 3, 4)

    def from_stream(a):
        a = a.reshape((B, dil, Lp) + a.shape[4:])[:, :, :L]
        a = jnp.swapaxes(a, 1, 2)
        return a.reshape((B, S) + a.shape[3:])

    return from_stream(o), from_stream(lse)


def dilated_attn_sample(q, k_new, v_new, k_buf, v_buf, dil, nk, bias, window):
    T = q.shape[1]
    Lb = k_buf.shape[1]
    kf = jnp.concatenate([k_buf.astype(jnp.float32), k_new], axis=1)
    vf = jnp.concatenate([v_buf.astype(jnp.float32), v_new], axis=1)
    idx = Lb + jnp.arange(T)[:, None] - jnp.arange(nk)[None, :] * dil
    ok = idx >= 0
    kg = jnp.take(kf, jnp.maximum(idx, 0), axis=1)
    vg = jnp.take(vf, jnp.maximum(idx, 0), axis=1)
    s = jnp.einsum('bthe,btjhe->bthj', q, kg) * (q.shape[-1] ** -0.5) + bias.T[None, None] .T.T if False else jnp.einsum('bthe,btjhe->bthj', q, kg) * (q.shape[-1] ** -0.5) + bias[None, None]
    s = jnp.where(ok[None, :, None, :], s, -jnp.inf)
    m = jnp.max(s, axis=-1, keepdims=True)
    p = jnp.exp(s - m)
    den = jnp.sum(p, axis=-1, keepdims=True)
    o = jnp.einsum('bthj,btjhe->bthe', p, vg) / den
    lse = (m + jnp.log(den))[..., 0]
    n_keep = min(window, Lb + T)
    return o, lse, kf[:, kf.shape[1] - n_keep:], vf[:, vf.shape[1] - n_keep:]


def decoder_layer(x, ple, pos, ret_state, kv_cache, lw, rel_bias):
    ln1, w_in_l, gn_g, w_rb, w_ab, w_o, ln2, w_u, w_d, w_pl, w_pg = lw
    f32 = jnp.float32
    B, T, _ = x.shape
    h = rms_norm(x, ln1)
    split_idx = [int(s) for s in np.cumsum(IN_SPLITS)[:-1]]
    rq, rk, rv, rg, aq, ak, av, gr, ga = jnp.split(h @ w_in_l, split_idx, axis=-1)
    rq = rotary(rq.reshape(B, T, RET_HEADS, RET_DK).astype(f32), pos)
    rk = rotary(rk.reshape(B, T, RET_HEADS, RET_DK).astype(f32), pos) * (RET_DK ** -0.5)
    rv = rv.reshape(B, T, RET_HEADS, RET_DV).astype(f32)
    lg = ret_log_decay()
    if ret_state is None:
        ro, new_ret = retention_scan(rq, rk, rv, jnp.zeros((B, RET_HEADS, RET_DK, RET_DV), f32), lg)
    else:
        new_ret, ro = retention_chunk(ret_state.astype(f32), rq, rk, rv, lg)
    ret_out = retention_readout(ro, rg, gn_g)
    aq = aq.reshape(B, T, ATT_GROUPS, ATT_HEADS_PER_GROUP, ATT_HD).astype(f32)
    ak = ak.reshape(B, T, ATT_GROUPS, ATT_HEADS_PER_GROUP, ATT_HD).astype(f32)
    av = av.reshape(B, T, ATT_GROUPS, ATT_HEADS_PER_GROUP, ATT_HD).astype(f32)
    outs, lses, new_kv = [], [], []
    for g in range(ATT_GROUPS):
        bias = group_bias(rel_bias, g)
        dil = ATT_DILATIONS[g]
        nk = ATT_WINDOWS[g] // dil
        if kv_cache is None:
            o, lse = dilated_attn_prompt(aq[:, :, g], ak[:, :, g], av[:, :, g], dil, nk, bias)
            keep = min(ATT_WINDOWS[g], T)
            kb, vb = ak[:, T - keep:, g], av[:, T - keep:, g]
        else:
            o, lse, kb, vb = dilated_attn_sample(aq[:, :, g], ak[:, :, g], av[:, :, g],
                                                 kv_cache[g][0], kv_cache[g][1], dil, nk, bias, ATT_WINDOWS[g])
        outs.append(o)
        lses.append(lse)
        new_kv.append((kb.astype(x.dtype), vb.astype(x.dtype)))
    alpha = jax.nn.softmax(jnp.stack(lses, axis=0), axis=0)
    att_out = jnp.sum(alpha[..., None] * jnp.stack(outs, axis=0), axis=0).reshape(B, T, ATT_OUT_W)
    mixed = (jax.nn.sigmoid(gr.astype(f32)) * (ret_out.astype(x.dtype) @ w_rb).astype(f32)
             + jax.nn.sigmoid(ga.astype(f32)) * (att_out.astype(x.dtype) @ w_ab).astype(f32))
    x = x + mixed.astype(x.dtype) @ w_o
    u = rms_norm(x, ln2) @ w_u
    x = x + jnp.square(jax.nn.relu(u)) @ w_d
    x = x + jax.nn.sigmoid(x @ w_pg) * (ple.astype(x.dtype) @ w_pl)
    return x, new_ret.astype(x.dtype), new_kv


def setup_inputs(seed: int = 0) -> dict:
    key = jax.random.key(seed)
    ks = iter(jax.random.split(key, 40))
    f32 = jnp.float32

    def nrm(shape, scale):
        return jax.random.normal(next(ks), shape, f32) * scale

    def gain(shape):
        return 1.0 + 0.05 * jax.random.normal(next(ks), shape, f32)

    out = {
        "x_prompt": nrm((BATCH, SEQ, D_MODEL), 1.0),
        "x_sample": nrm((DEC_BATCH, DEC_SEQ, D_MODEL), 1.0),
        "state_ret": nrm((DEPTH, DEC_BATCH, RET_HEADS, RET_DK, RET_DV), 0.5),
    }
    for w in ATT_WINDOWS:
        lb = min(w, PAST_LEN)
        out["cache_k_w%d" % w] = nrm((DEPTH, DEC_BATCH, lb, ATT_HEADS_PER_GROUP, ATT_HD), 1.0)
        out["cache_v_w%d" % w] = nrm((DEPTH, DEC_BATCH, lb, ATT_HEADS_PER_GROUP, ATT_HD), 1.0)
    out.update({
        "p_prompt": nrm((DEPTH, BATCH, SEQ, D_PLE), 1.0),
        "p_sample": nrm((DEPTH, DEC_BATCH, DEC_SEQ, D_PLE), 1.0),
        "ln1_g": gain((DEPTH, D_MODEL)),
        "w_in": nrm((DEPTH, D_MODEL, N_IN), D_MODEL ** -0.5),
        "ret_gn_g": gain((DEPTH, RET_V_W)),
        "w_ret_br": nrm((DEPTH, RET_V_W, D_MODEL), RET_V_W ** -0.5),
        "w_att_br": nrm((DEPTH, ATT_OUT_W, D_MODEL), ATT_OUT_W ** -0.5),
        "w_out": nrm((DEPTH, D_MODEL, D_MODEL), D_MODEL ** -0.5),
        "ln2_g": gain((DEPTH, D_MODEL)),
        "w_up": nrm((DEPTH, D_MODEL, D_FF), D_MODEL ** -0.5),
        "w_down": nrm((DEPTH, D_FF, D_MODEL), D_FF ** -0.5),
        "w_ple": nrm((DEPTH, D_PLE, D_MODEL), D_PLE ** -0.5),
        "w_ple_gate": nrm((DEPTH, D_MODEL, D_MODEL), D_MODEL ** -0.5),
        "rel_bias": nrm((REL_BUCKETS, ATT_HEADS), 0.5),
        "lnf_g": gain((D_MODEL,)),
    })
    return out


def reference(x_prompt, x_sample, state_ret, cache_k_w128, cache_v_w128, cache_k_w512, cache_v_w512,
              cache_k_w2048, cache_v_w2048, p_prompt, p_sample, ln1_g, w_in, ret_gn_g, w_ret_br, w_att_br,
              w_out, ln2_g, w_up, w_down, w_ple, w_ple_gate, rel_bias, lnf_g):
    cache_k = (cache_k_w128, cache_k_w512, cache_k_w2048)
    cache_v = (cache_v_w128, cache_v_w512, cache_v_w2048)
    xp, xs = x_prompt, x_sample
    pos_p = jnp.arange(xp.shape[1], dtype=jnp.int32)
    pos_s = PAST_LEN + jnp.arange(xs.shape[1], dtype=jnp.int32)
    ret_p, ret_s = [], []
    kv_p = [([], []) for _ in range(ATT_GROUPS)]
    kv_s = [([], []) for _ in range(ATT_GROUPS)]
    for l in range(DEPTH):
        lw = (ln1_g[l], w_in[l], ret_gn_g[l], w_ret_br[l], w_att_br[l], w_out[l], ln2_g[l],
              w_up[l], w_down[l], w_ple[l], w_ple_gate[l])
        xp, st_p, nkv_p = decoder_layer(xp, p_prompt[l], pos_p, None, None, lw, rel_bias)
        layer_cache = [(cache_k[g][l], cache_v[g][l]) for g in range(ATT_GROUPS)]
        xs, st_s, nkv_s = decoder_layer(xs, p_sample[l], pos_s, state_ret[l], layer_cache, lw, rel_bias)
        ret_p.append(st_p)
        ret_s.append(st_s)
        for g in range(ATT_GROUPS):
            kv_p[g][0].append(nkv_p[g][0])
            kv_p[g][1].append(nkv_p[g][1])
            kv_s[g][0].append(nkv_s[g][0])
            kv_s[g][1].append(nkv_s[g][1])
    y_prompt = rms_norm(xp, lnf_g)
    y_sample = rms_norm(xs, lnf_g)
    new_state_ret_prompt = jnp.stack(ret_p)
    new_k_w128_prompt = jnp.stack(kv_p[0][0])
    new_v_w128_prompt = jnp.stack(kv_p[0][1])
    new_k_w512_prompt = jnp.stack(kv_p[1][0])
    new_v_w512_prompt = jnp.stack(kv_p[1][1])
    new_k_w2048_prompt = jnp.stack(kv_p[2][0])
    new_v_w2048_prompt = jnp.stack(kv_p[2][1])
    new_state_ret_sample = jnp.stack(ret_s)
    new_k_w128_sample = jnp.stack(kv_s[0][0])
    new_v_w128_sample = jnp.stack(kv_s[0][1])
    new_k_w512_sample = jnp.stack(kv_s[1][0])
    new_v_w512_sample = jnp.stack(kv_s[1][1])
    new_k_w2048_sample = jnp.stack(kv_s[2][0])
    new_v_w2048_sample = jnp.stack(kv_s[2][1])
    return (y_prompt, y_sample,
            new_state_ret_prompt, new_k_w128_prompt, new_v_w128_prompt, new_k_w512_prompt, new_v_w512_prompt,
            new_k_w2048_prompt, new_v_w2048_prompt,
            new_state_ret_sample, new_k_w128_sample, new_v_w128_sample, new_k_w512_sample, new_v_w512_sample,
            new_k_w2048_sample, new_v_w2048_sample)
```

```cpp
#include <hip/hip_runtime.h>
#include <hip/hip_cooperative_groups.h>
#include <cstdio>
#include <cstdint>
namespace cg = cooperative_groups;

#define LAS __attribute__((address_space(3)))
typedef unsigned short bf16;
typedef short bf16x8 __attribute__((ext_vector_type(8)));
typedef float f32x4 __attribute__((ext_vector_type(4)));
typedef float f32x2 __attribute__((ext_vector_type(2)));
typedef unsigned u32x4 __attribute__((ext_vector_type(4)));
typedef unsigned u32x2 __attribute__((ext_vector_type(2)));

constexpr int D = 1024, NB = 8, SEQ = 2048, MP = NB * SEQ, SB = 32, MT = MP + SB, MPAD = 16640;
constexpr int NIN = 9728, DFF = 4096, DPLE = 256;
constexpr int NWAVES = 8, NTHREADS = NWAVES * 64;
constexpr int LDS_BYTES = 147456;
constexpr float NORM_EPS = 1e-6f;
constexpr float LOG2E = 1.4426950408889634f;
constexpr float QSCALE = 0.08838834764831845f * LOG2E;

constexpr size_t O_Y = 0;
constexpr size_t O_STP = (size_t)MT * 1024;
constexpr size_t O_KVP0 = O_STP + 524288;
constexpr size_t O_STS = O_KVP0 + 2 * 524288 + 2 * 2097152 + 2 * 8388608;
constexpr size_t O_KVS0 = O_STS + 2097152;
constexpr size_t O_END = O_KVS0 + 2 * 2097152 + 2 * 8388608 + 2 * 33554432;
static_assert(O_END == 129531904, "d_out size");
__host__ __device__ constexpr int win_of(int g) { return g == 0 ? 128 : (g == 1 ? 512 : 2048); }
__host__ __device__ constexpr int dil_of(int g) { return g == 0 ? 1 : (g == 1 ? 4 : 16); }
__host__ __device__ constexpr size_t okvp(int g, int isv) {
    return O_KVP0 + (g == 0 ? 0 : (g == 1 ? 2 * 524288 : 2 * 524288 + 2 * 2097152)) + (size_t)isv * (size_t)NB * win_of(g) * 512;
}
__host__ __device__ constexpr size_t okvs(int g, int isv) {
    return O_KVS0 + (g == 0 ? 0 : (g == 1 ? 2 * 2097152 : 2 * 2097152 + 2 * 8388608)) + (size_t)isv * (size_t)SB * win_of(g) * 512;
}

constexpr size_t MiB = 1u << 20;
constexpr size_t WS_CTL = 0, CTL_ZERO_BYTES = 1 * MiB;
constexpr size_t WS_ROPE = 1 * MiB;
constexpr size_t WS_BIAS = 1 * MiB + 768 * 1024;
constexpr size_t WS_WIN = 2 * MiB;
constexpr size_t WS_WRB = 21 * MiB;
constexpr size_t WS_WAB = 23 * MiB;
constexpr size_t WS_WO = 24 * MiB;
constexpr size_t WS_WU = 26 * MiB;
constexpr size_t WS_WD = 34 * MiB;
constexpr size_t WS_WPL = 42 * MiB;
constexpr size_t WS_WPG = 43 * MiB;
constexpr size_t WS_HN = 48 * MiB;
constexpr size_t WS_PB = 81 * MiB;
constexpr size_t WS_P = 90 * MiB;
constexpr size_t WS_RQ = 123 * MiB;
constexpr size_t WS_RK = 140 * MiB;
constexpr size_t WS_RV = 157 * MiB;
constexpr size_t WS_RG = 190 * MiB;
constexpr size_t WS_AQ = 223 * MiB;
constexpr size_t WS_AK = 272 * MiB;
constexpr size_t WS_AV = 321 * MiB;
constexpr size_t WS_SGR = 370 * MiB;
constexpr size_t WS_SGA = 403 * MiB;
constexpr size_t WS_OG = 436 * MiB;
constexpr size_t WS_LSE = 485 * MiB;
constexpr size_t WS_END = 486 * MiB;
static_assert(WS_AQ + (size_t)MPAD * 4096 * 2 <= WS_SGR, "U overlay");

__device__ __forceinline__ unsigned f2bf(float f) { unsigned u = __float_as_uint(f); return (u + 0x7fffu + ((u >> 16) & 1u)) >> 16; }
__device__ __forceinline__ float bf2f(unsigned b) { return __uint_as_float(b << 16); }
__device__ __forceinline__ unsigned pk2(float lo, float hi) { return f2bf(lo) | (f2bf(hi) << 16); }
__device__ __forceinline__ float bflo(unsigned w) { return __uint_as_float(w << 16); }
__device__ __forceinline__ float bfhi(unsigned w) { return __uint_as_float(w & 0xffff0000u); }
__device__ __forceinline__ float wave_sum(float v) {
#pragma unroll
    for (int o = 1; o < 64; o <<= 1) v += __shfl_xor(v, o);
    return v;
}
__device__ __forceinline__ float wave_max(float v) {
#pragma unroll
    for (int o = 1; o < 64; o <<= 1) v = fmaxf(v, __shfl_xor(v, o));
    return v;
}
__device__ __forceinline__ float sigmoidf_(float v) { return 1.0f / (1.0f + __expf(-v)); }
__device__ __forceinline__ void st_bf4(bf16* p, f32x4 v) { u32x2 w; w.x = pk2(v[0], v[1]); w.y = pk2(v[2], v[3]); *(u32x2*)p = w; }
__device__ __forceinline__ f32x4 ld_bf4(const bf16* p) { const u32x2 w = *(const u32x2*)p; return (f32x4){bflo(w.x), bfhi(w.x), bflo(w.y), bfhi(w.y)}; }

struct Params {
    const float* in[24];
    float* out;
    unsigned char* ws;
    int ph_lo, ph_hi;
};
enum { I_XP = 0, I_XS, I_STATE, I_CK128, I_CV128, I_CK512, I_CV512, I_CK2K, I_CV2K, I_PP, I_PS, I_LN1, I_WIN, I_GN, I_WRB, I_WAB, I_WO, I_LN2, I_WU, I_WD, I_WPL, I_WPG, I_RELB, I_LNF };

template <class Epi>
__device__ __forceinline__ void gemm_v1(const bf16* __restrict__ A, int lda, const bf16* __restrict__ Bt, int ldb, int M, int N, int K, const Epi& epi, int gw, int nw, int lane) {
    const int tn = N / 64, tm = M / 32, fr = lane & 15, fq = lane >> 4;
    for (int tile = gw; tile < tm * tn; tile += nw) {
        const int im = tile / tn, in = tile % tn;
        f32x4 acc[2][4];
#pragma unroll
        for (int a = 0; a < 2; ++a)
#pragma unroll
            for (int b = 0; b < 4; ++b) acc[a][b] = (f32x4){0.f, 0.f, 0.f, 0.f};
        const bf16* ap = A + (size_t)(im * 32 + fr) * lda + fq * 8;
        const bf16* bp = Bt + (size_t)(in * 64 + fr) * ldb + fq * 8;
#pragma unroll 2
        for (int k0 = 0; k0 < K; k0 += 32) {
            bf16x8 a[2], b[4];
#pragma unroll
            for (int mi = 0; mi < 2; ++mi) a[mi] = *(const bf16x8*)(ap + (size_t)mi * 16 * lda + k0);
#pragma unroll
            for (int ni = 0; ni < 4; ++ni) b[ni] = *(const bf16x8*)(bp + (size_t)ni * 16 * ldb + k0);
#pragma unroll
            for (int mi = 0; mi < 2; ++mi)
#pragma unroll
                for (int ni = 0; ni < 4; ++ni) acc[mi][ni] = __builtin_amdgcn_mfma_f32_16x16x32_bf16(b[ni], a[mi], acc[mi][ni], 0, 0, 0);
        }
#pragma unroll
        for (int mi = 0; mi < 2; ++mi)
#pragma unroll
            for (int ni = 0; ni < 4; ++ni) epi(im * 32 + mi * 16 + fr, in * 64 + ni * 16 + fq * 4, acc[mi][ni]);
    }
}
template <class Mid, class Epi>
__device__ __forceinline__ void gemm_v1_dual(const bf16* __restrict__ A1, int lda1, const bf16* __restrict__ B1, int ldb1, int K1,
                                             const bf16* __restrict__ A2, int lda2, const bf16* __restrict__ B2, int ldb2, int K2,
                                             int M, int N, const Mid& mid, const Epi& epi, int gw, int nw, int lane) {
    const int tn = N / 64, tm = M / 32, fr = lane & 15, fq = lane >> 4;
    for (int tile = gw; tile < tm * tn; tile += nw) {
        const int im = tile / tn, in = tile % tn;
        f32x4 acc[2][4];
#pragma unroll
        for (int a = 0; a < 2; ++a)
#pragma unroll
            for (int b = 0; b < 4; ++b) acc[a][b] = (f32x4){0.f, 0.f, 0.f, 0.f};
        {
            const bf16* ap = A1 + (size_t)(im * 32 + fr) * lda1 + fq * 8;
            const bf16* bp = B1 + (size_t)(in * 64 + fr) * ldb1 + fq * 8;
#pragma unroll 2
            for (int k0 = 0; k0 < K1; k0 += 32) {
                bf16x8 a[2], b[4];
#pragma unroll
                for (int mi = 0; mi < 2; ++mi) a[mi] = *(const bf16x8*)(ap + (size_t)mi * 16 * lda1 + k0);
#pragma unroll
                for (int ni = 0; ni < 4; ++ni) b[ni] = *(const bf16x8*)(bp + (size_t)ni * 16 * ldb1 + k0);
#pragma unroll
                for (int mi = 0; mi < 2; ++mi)
#pragma unroll
                    for (int ni = 0; ni < 4; ++ni) acc[mi][ni] = __builtin_amdgcn_mfma_f32_16x16x32_bf16(b[ni], a[mi], acc[mi][ni], 0, 0, 0);
            }
        }
#pragma unroll
        for (int mi = 0; mi < 2; ++mi)
#pragma unroll
            for (int ni = 0; ni < 4; ++ni) acc[mi][ni] = mid(im * 32 + mi * 16 + fr, in * 64 + ni * 16 + fq * 4, acc[mi][ni]);
        {
            const bf16* ap = A2 + (size_t)(im * 32 + fr) * lda2 + fq * 8;
            const bf16* bp = B2 + (size_t)(in * 64 + fr) * ldb2 + fq * 8;
#pragma unroll 2
            for (int k0 = 0; k0 < K2; k0 += 32) {
                bf16x8 a[2], b[4];
#pragma unroll
                for (int mi = 0; mi < 2; ++mi) a[mi] = *(const bf16x8*)(ap + (size_t)mi * 16 * lda2 + k0);
#pragma unroll
                for (int ni = 0; ni < 4; ++ni) b[ni] = *(const bf16x8*)(bp + (size_t)ni * 16 * ldb2 + k0);
#pragma unroll
                for (int mi = 0; mi < 2; ++mi)
#pragma unroll
                    for (int ni = 0; ni < 4; ++ni) acc[mi][ni] = __builtin_amdgcn_mfma_f32_16x16x32_bf16(b[ni], a[mi], acc[mi][ni], 0, 0, 0);
            }
        }
#pragma unroll
        for (int mi = 0; mi < 2; ++mi)
#pragma unroll
            for (int ni = 0; ni < 4; ++ni) epi(im * 32 + mi * 16 + fr, in * 64 + ni * 16 + fq * 4, acc[mi][ni]);
    }
}

struct EpiIn {
    bf16 *RQ, *RK, *RV, *RG, *AQ, *AK, *AV, *SGR, *SGA; const f32x2* rope; float* out;
    __device__ __forceinline__ void operator()(int row, int c, f32x4 v) const {
        if (c < 1024) {
            const bool isk = c >= 512; const int cc = c & 511;
            const int tp = row < MP ? (row & (SEQ - 1)) : SEQ;
            const int i0 = (cc & 63) >> 1;
            const f32x2 cs0 = rope[tp * 32 + i0], cs1 = rope[tp * 32 + i0 + 1];
            float a0 = v[0] * cs0.x - v[1] * cs0.y, b0 = v[0] * cs0.y + v[1] * cs0.x;
            float a1 = v[2] * cs1.x - v[3] * cs1.y, b1 = v[2] * cs1.y + v[3] * cs1.x;
            if (isk) { a0 *= 0.125f; b0 *= 0.125f; a1 *= 0.125f; b1 *= 0.125f; }
            st_bf4((isk ? RK : RQ) + (size_t)row * 512 + cc, (f32x4){a0, b0, a1, b1});
        } else if (c < 2048) {
            st_bf4(RV + (size_t)row * 1024 + (c - 1024), v);
        } else if (c < 3072) {
            f32x4 s;
#pragma unroll
            for (int j = 0; j < 4; ++j) s[j] = v[j] * sigmoidf_(v[j]);
            st_bf4(RG + (size_t)row * 1024 + (c - 2048), s);
        } else if (c < 4608) {
            st_bf4(AQ + (size_t)row * 1536 + (c - 3072), v * QSCALE);
        } else if (c < 7680) {
            const int isv = c >= 6144; const int cc = c - (isv ? 6144 : 4608); const int g = cc >> 9, hc = cc & 511;
            st_bf4((isv ? AV : AK) + (size_t)row * 1536 + cc, v);
            const int W = win_of(g);
            if (row < MP) {
                const int t = row & (SEQ - 1), b = row >> 11;
                if (t >= SEQ - W) *(f32x4*)(out + okvp(g, isv) + ((size_t)(b * W + t - (SEQ - W)) * 512 + hc)) = v;
            } else {
                const int bs = row - MP;
                *(f32x4*)(out + okvs(g, isv) + ((size_t)(bs * W + (W - 1)) * 512 + hc)) = v;
            }
        } else {
            const bool isa = c >= 8704;
            f32x4 s;
#pragma unroll
            for (int j = 0; j < 4; ++j) s[j] = sigmoidf_(v[j]);
            st_bf4((isa ? SGA : SGR) + (size_t)row * 1024 + (c - (isa ? 8704 : 7680)), s);
        }
    }
};
struct EpiStoreBf { bf16* O; int ld; __device__ __forceinline__ void operator()(int row, int c, f32x4 v) const { st_bf4(O + (size_t)row * ld + c, v); } };
struct MidGate {
    const bf16 *SGR, *SGA;
    __device__ __forceinline__ f32x4 operator()(int row, int c, f32x4 v) const {
        const f32x4 r = ld_bf4(SGR + (size_t)row * 1024 + c), a = ld_bf4(SGA + (size_t)row * 1024 + c);
        f32x4 o;
#pragma unroll
        for (int j = 0; j < 4; ++j) o[j] = v[j] * (r[j] / a[j]);
        return o;
    }
};
struct EpiMix {
    const bf16* SGA; bf16* MIX;
    __device__ __forceinline__ void operator()(int row, int c, f32x4 v) const {
        const f32x4 a = ld_bf4(SGA + (size_t)row * 1024 + c);
        st_bf4(MIX + (size_t)row * 1024 + c, v * a);
    }
};
struct EpiResIn {
    const float *xp, *xs; float* X;
    __device__ __forceinline__ void operator()(int row, int c, f32x4 v) const {
        const float* src = row < MP ? xp + (size_t)row * 1024 + c : xs + (size_t)(row - MP) * 1024 + c;
        *(f32x4*)(X + (size_t)row * 1024 + c) = *(const f32x4*)src + v;
    }
};
struct EpiRelu2 {
    bf16* U;
    __device__ __forceinline__ void operator()(int row, int c, f32x4 v) const {
        f32x4 s;
#pragma unroll
        for (int j = 0; j < 4; ++j) { const float r = fmaxf(v[j], 0.f); s[j] = r * r; }
        st_bf4(U + (size_t)row * DFF + c, s);
    }
};
struct EpiResX {
    float* X; bf16* XB;
    __device__ __forceinline__ void operator()(int row, int c, f32x4 v) const {
        float* p = X + (size_t)row * 1024 + c; const f32x4 o = *(const f32x4*)p + v; *(f32x4*)p = o;
        st_bf4(XB + (size_t)row * 1024 + c, o);
    }
};
struct EpiPle {
    float* X; const bf16* P;
    __device__ __forceinline__ void operator()(int row, int c, f32x4 v) const {
        float* p = X + (size_t)row * 1024 + c; const f32x4 pv = ld_bf4(P + (size_t)row * 1024 + c); f32x4 o = *(const f32x4*)p;
#pragma unroll
        for (int j = 0; j < 4; ++j) o[j] += sigmoidf_(v[j]) * pv[j];
        *(f32x4*)p = o;
    }
};

template <bool PERM>
__device__ __forceinline__ void transpose_item(const float* __restrict__ W, int K, int N, bf16* __restrict__ WT, LAS float* scr, int item, int lane) {
    const int nblk = N / 32, kb = item / nblk, nb = item % nblk, k0 = 64 * kb, n0 = 32 * nb;
    int srcc = n0 + (lane & 31);
    if (PERM && n0 < 1024) srcc = (n0 & ~63) + ((n0 & 32) >> 1) + ((lane & 31) >> 1) + 32 * (lane & 1);
#pragma unroll 8
    for (int i = 0; i < 32; ++i) { const int kk = 2 * i + (lane >> 5); scr[kk * 33 + (lane & 31)] = W[(size_t)(k0 + kk) * N + srcc]; }
    asm volatile("s_waitcnt lgkmcnt(0)" ::: "memory");
    const int c = lane & 7;
#pragma unroll
    for (int j = 0; j < 4; ++j) { const int n = (lane >> 3) + 8 * j; const LAS float* s = scr + (8 * c) * 33 + n;
        u32x4 o; o.x = pk2(s[0 * 33], s[1 * 33]); o.y = pk2(s[2 * 33], s[3 * 33]); o.z = pk2(s[4 * 33], s[5 * 33]); o.w = pk2(s[6 * 33], s[7 * 33]);
        *(u32x4*)(WT + (size_t)(n0 + n) * K + k0 + 8 * c) = o; }
    asm volatile("s_waitcnt lgkmcnt(0)" ::: "memory");
}
__device__ __forceinline__ void rms_row_to_bf16(const float* __restrict__ xrow, const float* __restrict__ g, bf16* __restrict__ orow, int lane) {
    f32x4 v[4]; float s = 0.f;
#pragma unroll
    for (int j = 0; j < 4; ++j) { v[j] = *(const f32x4*)(xrow + 4 * lane + 256 * j); s += (v[j][0] * v[j][0] + v[j][1] * v[j][1]) + (v[j][2] * v[j][2] + v[j][3] * v[j][3]); }
    const float r = rsqrtf(wave_sum(s) * (1.f / 1024.f) + NORM_EPS);
#pragma unroll
    for (int j = 0; j < 4; ++j) { const f32x4 gg = *(const f32x4*)(g + 4 * lane + 256 * j); st_bf4(orow + 4 * lane + 256 * j, v[j] * r * gg); }
}

constexpr int NPHASE = 11;
__global__ void __launch_bounds__(NTHREADS) fwd_kernel(Params p) {
    extern __shared__ __attribute__((aligned(16))) unsigned char lds_raw[];
    LAS unsigned char* lds = (LAS unsigned char*)lds_raw;
    cg::grid_group grid = cg::this_grid();
    const int tid = threadIdx.x, lane = tid & 63, wave = tid >> 6;
    const int G = gridDim.x, gw = blockIdx.x * NWAVES + wave, nw = G * NWAVES;
    const size_t gtid = (size_t)blockIdx.x * NTHREADS + tid, nthr = (size_t)G * NTHREADS;
    unsigned char* ws = p.ws; float* out = p.out;
    const f32x2* rope = (const f32x2*)(ws + WS_ROPE);
    float* bias2 = (float*)(ws + WS_BIAS);
    bf16* WIN = (bf16*)(ws + WS_WIN); bf16* WRB = (bf16*)(ws + WS_WRB); bf16* WAB = (bf16*)(ws + WS_WAB); bf16* WO = (bf16*)(ws + WS_WO);
    bf16* WU = (bf16*)(ws + WS_WU); bf16* WD = (bf16*)(ws + WS_WD); bf16* WPL = (bf16*)(ws + WS_WPL); bf16* WPG = (bf16*)(ws + WS_WPG);
    bf16* HN = (bf16*)(ws + WS_HN); bf16* ARET = HN; bf16* PB = (bf16*)(ws + WS_PB); bf16* P = (bf16*)(ws + WS_P);
    bf16* RQ = (bf16*)(ws + WS_RQ); bf16* AATT = RQ; bf16* RK = (bf16*)(ws + WS_RK); bf16* RV = (bf16*)(ws + WS_RV); bf16* MIX = RV;
    bf16* RG = (bf16*)(ws + WS_RG); bf16* H2 = RG; bf16* AQ = (bf16*)(ws + WS_AQ); bf16* AK = (bf16*)(ws + WS_AK); bf16* AV = (bf16*)(ws + WS_AV); bf16* U = AQ;
    bf16* SGR = (bf16*)(ws + WS_SGR); bf16* X2B = SGR; bf16* SGA = (bf16*)(ws + WS_SGA); bf16* OG = (bf16*)(ws + WS_OG); float* LSE = (float*)(ws + WS_LSE);
    float* X = out + O_Y;
    float* RO = out + O_Y;
    const int lo = p.ph_lo, hi = p.ph_hi;
#define IN(k) (lo <= (k) && (k) < hi)
#define SEAM(k) do { if (IN(k) && IN((k) + 1)) grid.sync(); } while (0)

    if (IN(0)) {
        LAS float* scr = (LAS float*)(lds + wave * 16384);
        constexpr int I_IN = 16 * (NIN / 32), I_RB = 16 * 32, I_AB = 8 * 32, I_O = 16 * 32, I_U = 16 * 128, I_D = 64 * 32, I_PL = 4 * 32, I_PG = 16 * 32;
        constexpr int NITEMS = I_IN + I_RB + I_AB + I_O + I_U + I_D + I_PL + I_PG;
        for (int it = gw; it < NITEMS; it += nw) {
            int r = it;
            if (r < I_IN) { transpose_item<true>(p.in[I_WIN], 1024, NIN, WIN, scr, r, lane); continue; } r -= I_IN;
            if (r < I_RB) { transpose_item<false>(p.in[I_WRB], 1024, 1024, WRB, scr, r, lane); continue; } r -= I_RB;
            if (r < I_AB) { transpose_item<false>(p.in[I_WAB], 512, 1024, WAB, scr, r, lane); continue; } r -= I_AB;
            if (r < I_O) { transpose_item<false>(p.in[I_WO], 1024, 1024, WO, scr, r, lane); continue; } r -= I_O;
            if (r < I_U) { transpose_item<false>(p.in[I_WU], 1024, DFF, WU, scr, r, lane); continue; } r -= I_U;
            if (r < I_D) { transpose_item<false>(p.in[I_WD], DFF, 1024, WD, scr, r, lane); continue; } r -= I_D;
            if (r < I_PL) { transpose_item<false>(p.in[I_WPL], DPLE, 1024, WPL, scr, r, lane); continue; } r -= I_PL;
            transpose_item<false>(p.in[I_WPG], 1024, 1024, WPG, scr, r, lane);
        }
        for (int m = gw; m < MT; m += nw) {
            const float* xr = m < MP ? p.in[I_XP] + (size_t)m * 1024 : p.in[I_XS] + (size_t)(m - MP) * 1024;
            rms_row_to_bf16(xr, p.in[I_LN1], HN + (size_t)m * 1024, lane);
            const float* pr = m < MP ? p.in[I_PP] + (size_t)m * DPLE : p.in[I_PS] + (size_t)(m - MP) * DPLE;
            st_bf4(PB + (size_t)m * DPLE + 4 * lane, *(const f32x4*)(pr + 4 * lane));
        }
        for (size_t i = gtid; i < (size_t)2049 * 32; i += nthr) {
            const int tp = (int)(i >> 5), j = (int)(i & 31);
            const float pos = tp < SEQ ? (float)tp : 16384.0f;
            const float inv = exp2f(-(float)j * (13.287712379549449f / 32.0f));
            const float ang = pos * inv;
            double rev = (double)ang * 0.15915494309189535; rev -= floor(rev);
            const float rr = (float)(rev * 6.283185307179586 - 3.141592653589793);
            float sn, cs; __sincosf(rr, &sn, &cs);
            ((f32x2*)(ws + WS_ROPE))[i] = (f32x2){-cs, -sn};
        }
        for (size_t i = gtid; i < 12 * 128; i += nthr) {
            const int gh = (int)(i >> 7), j = (int)(i & 127), g = gh >> 2;
            const int d = j * dil_of(g);
            int bkt;
            if (d < 16) bkt = d;
            else { const float lr = __logf((float)d / 16.0f) / 4.852030263919617f; bkt = 16 + (int)(lr * 16.0f); bkt = bkt < 31 ? bkt : 31; }
            bias2[i] = p.in[I_RELB][bkt * 12 + gh] * LOG2E;
        }
        for (int a = 0; a < 6; ++a) {
            const int g = a >> 1, isv = a & 1, W = win_of(g);
            const f32x4* src = (const f32x4*)p.in[I_CK128 + a]; f32x4* dst = (f32x4*)(out + okvs(g, isv));
            const size_t per = (size_t)(W - 1) * 128, tot = per * SB;
            for (size_t i = gtid; i < tot; i += nthr) { const size_t bs = i / per, r = i - bs * per; dst[bs * (size_t)W * 128 + r] = src[bs * (size_t)W * 128 + 128 + r]; }
        }
    }
    SEAM(0);

    if (IN(1)) {
        EpiIn E{RQ, RK, RV, RG, AQ, AK, AV, SGR, SGA, rope, out};
        gemm_v1(HN, 1024, WIN, 1024, MT, NIN, 1024, E, gw, nw, lane);
        EpiStoreBf E2{P, 1024};
        gemm_v1(PB, DPLE, WPL, DPLE, MT, 1024, DPLE, E2, gw, nw, lane);
    }
    SEAM(1);

    if (IN(2)) {
        for (size_t it = gtid; it < (size_t)NB * 8 * 128; it += nthr) {
            const int b = (int)(it >> 10), h = (int)(it >> 7) & 7, v = (int)(it & 127);
            const float gamma = 1.0f - exp2f(-5.0f - (float)h);
            float S[64];
#pragma unroll
            for (int k = 0; k < 64; ++k) S[k] = 0.f;
            for (int t = 0; t < SEQ; ++t) {
                const size_t row = (size_t)b * SEQ + t;
                const u32x4* kp = (const u32x4*)(RK + row * 512 + h * 64); const u32x4* qp = (const u32x4*)(RQ + row * 512 + h * 64);
                const float vv = bf2f(RV[row * 1024 + h * 128 + v]);
                float o = 0.f;
#pragma unroll
                for (int c8 = 0; c8 < 8; ++c8) {
                    const u32x4 kw = kp[c8], qw = qp[c8];
                    const unsigned kk[4] = {kw.x, kw.y, kw.z, kw.w}, qq[4] = {qw.x, qw.y, qw.z, qw.w};
#pragma unroll
                    for (int j = 0; j < 4; ++j) {
                        const int k0 = c8 * 8 + 2 * j;
                        S[k0] = gamma * S[k0] + bflo(kk[j]) * vv; o += bflo(qq[j]) * S[k0];
                        S[k0 + 1] = gamma * S[k0 + 1] + bfhi(kk[j]) * vv; o += bfhi(qq[j]) * S[k0 + 1];
                    }
                }
                RO[row * 1024 + h * 128 + v] = o;
            }
            float* so = out + O_STP + ((size_t)(b * 8 + h) * 64) * 128 + v;
#pragma unroll
            for (int k = 0; k < 64; ++k) so[(size_t)((k >> 1) + 32 * (k & 1)) * 128] = S[k];
        }
        for (size_t it = gtid; it < (size_t)SB * 8 * 128; it += nthr) {
            const int bs = (int)(it >> 10), h = (int)(it >> 7) & 7, v = (int)(it & 127);
            const float gamma = 1.0f - exp2f(-5.0f - (float)h);
            const size_t row = (size_t)MP + bs;
            const float vv = bf2f(RV[row * 1024 + h * 128 + v]);
            const float* si = p.in[I_STATE] + ((size_t)(bs * 8 + h) * 64) * 128 + v;
            float* so = out + O_STS + ((size_t)(bs * 8 + h) * 64) * 128 + v;
            float o = 0.f;
            for (int k = 0; k < 64; ++k) {
                const int ko = (k >> 1) + 32 * (k & 1);
                const float s = gamma * si[(size_t)ko * 128] + bf2f(RK[row * 512 + h * 64 + k]) * vv;
                o += bf2f(RQ[row * 512 + h * 64 + k]) * s;
                so[(size_t)ko * 128] = s;
            }
            RO[row * 1024 + h * 128 + v] = o;
        }
        LAS float* qs = (LAS float*)(lds + wave * 512);
        for (int it = gw; it < 3 * MP * 4; it += nw) {
            const int g = it / (MP * 4), rem = it - g * (MP * 4), row = rem >> 2, h = rem & 3, t = row & (SEQ - 1), dil = dil_of(g);
            const bf16* qp = AQ + (size_t)row * 1536 + g * 512 + h * 128;
            { const unsigned w = *(const unsigned*)(qp + 2 * lane); qs[2 * lane] = bflo(w); qs[2 * lane + 1] = bfhi(w); }
            asm volatile("s_waitcnt lgkmcnt(0)" ::: "memory");
            float s[2];
#pragma unroll
            for (int hh = 0; hh < 2; ++hh) {
                const int j = lane + 64 * hh; const int tk = t - j * dil;
                float acc = -INFINITY;
                if (tk >= 0) {
                    const u32x4* kp = (const u32x4*)(AK + (size_t)(row - j * dil) * 1536 + g * 512 + h * 128);
                    acc = 0.f;
#pragma unroll 4
                    for (int c8 = 0; c8 < 16; ++c8) {
                        const u32x4 kw = kp[c8]; const f32x4 q0 = *(const LAS f32x4*)(qs + c8 * 8), q1 = *(const LAS f32x4*)(qs + c8 * 8 + 4);
                        acc += bflo(kw.x) * q0[0] + bfhi(kw.x) * q0[1] + bflo(kw.y) * q0[2] + bfhi(kw.y) * q0[3]
                             + bflo(kw.z) * q1[0] + bfhi(kw.z) * q1[1] + bflo(kw.w) * q1[2] + bfhi(kw.w) * q1[3];
                    }
                    acc += bias2[(g * 4 + h) * 128 + j];
                }
                s[hh] = acc;
            }
            const float m = wave_max(fmaxf(s[0], s[1]));
            const float p0 = exp2f(s[0] - m), p1 = exp2f(s[1] - m);
            const float den = wave_sum(p0 + p1);
            float o0 = 0.f, o1 = 0.f;
            const int jmax = (t / dil) < 127 ? (t / dil) : 127;
            for (int j = 0; j <= jmax; ++j) {
                const float pj = __shfl(j < 64 ? p0 : p1, j & 63);
                const unsigned w = *(const unsigned*)(AV + (size_t)(row - j * dil) * 1536 + g * 512 + h * 128 + 2 * lane);
                o0 += pj * bflo(w); o1 += pj * bfhi(w);
            }
            const float inv = 1.0f / den;
            *(unsigned*)(OG + ((size_t)g * MPAD + row) * 512 + h * 128 + 2 * lane) = pk2(o0 * inv, o1 * inv);
            if (lane == 0) LSE[((size_t)g * MPAD + row) * 4 + h] = m + log2f(den);
            asm volatile("s_waitcnt lgkmcnt(0)" ::: "memory");
        }
        for (int it = gw; it < 3 * SB * 4; it += nw) {
            const int g = it / (SB * 4), rem = it - g * (SB * 4), bs = rem >> 2, h = rem & 3, dil = dil_of(g), W = win_of(g);
            const size_t row = (size_t)MP + bs;
            const float* ck = p.in[I_CK128 + 2 * g] + (size_t)bs * W * 512 + h * 128;
            const float* cv = p.in[I_CV128 + 2 * g] + (size_t)bs * W * 512 + h * 128;
            const bf16* qp = AQ + row * 1536 + g * 512 + h * 128;
            { const unsigned w = *(const unsigned*)(qp + 2 * lane); qs[2 * lane] = bflo(w); qs[2 * lane + 1] = bfhi(w); }
            asm volatile("s_waitcnt lgkmcnt(0)" ::: "memory");
            float s[2];
#pragma unroll
            for (int hh = 0; hh < 2; ++hh) {
                const int j = lane + 64 * hh;
                float acc = 0.f;
                if (j == 0) {
                    const bf16* kp = AK + row * 1536 + g * 512 + h * 128;
                    for (int e = 0; e < 128; ++e) acc += bf2f(kp[e]) * qs[e];
                } else {
                    const f32x4* kp = (const f32x4*)(ck + (size_t)(W - j * dil) * 512);
                    for (int c4 = 0; c4 < 32; ++c4) { const f32x4 kv = kp[c4]; const f32x4 q0 = *(const LAS f32x4*)(qs + c4 * 4); acc += kv[0] * q0[0] + kv[1] * q0[1] + kv[2] * q0[2] + kv[3] * q0[3]; }
                }
                s[hh] = acc + bias2[(g * 4 + h) * 128 + j];
            }
            const float m = wave_max(fmaxf(s[0], s[1]));
            const float p0 = exp2f(s[0] - m), p1 = exp2f(s[1] - m);
            const float den = wave_sum(p0 + p1);
            float o0 = 0.f, o1 = 0.f;
            for (int j = 0; j < 128; ++j) {
                const float pj = __shfl(j < 64 ? p0 : p1, j & 63);
                float v0, v1;
                if (j == 0) { const unsigned w = *(const unsigned*)(AV + row * 1536 + g * 512 + h * 128 + 2 * lane); v0 = bflo(w); v1 = bfhi(w); }
                else { const f32x2 vv = *(const f32x2*)(cv + (size_t)(W - j * dil) * 512 + 2 * lane); v0 = vv.x; v1 = vv.y; }
                o0 += pj * v0; o1 += pj * v1;
            }
            const float inv = 1.0f / den;
            *(unsigned*)(OG + ((size_t)g * MPAD + row) * 512 + h * 128 + 2 * lane) = pk2(o0 * inv, o1 * inv);
            if (lane == 0) LSE[((size_t)g * MPAD + row) * 4 + h] = m + log2f(den);
            asm volatile("s_waitcnt lgkmcnt(0)" ::: "memory");
        }
    }
    SEAM(2);

    if (IN(3)) {
        const float* gn = p.in[I_GN];
        for (int it = gw; it < MT * 8; it += nw) {
            const int row = it >> 3, h = it & 7;
            const size_t base = (size_t)row * 1024 + h * 128;
            const float x0 = RO[base + lane], x1 = RO[base + 64 + lane];
            const float mu = wave_sum(x0 + x1) * (1.f / 128.f);
            const float d0 = x0 - mu, d1 = x1 - mu;
            const float r = rsqrtf(wave_sum(d0 * d0 + d1 * d1) * (1.f / 128.f) + NORM_EPS);
            ARET[base + lane] = (bf16)f2bf(bf2f(RG[base + lane]) * d0 * r * gn[h * 128 + lane]);
            ARET[base + 64 + lane] = (bf16)f2bf(bf2f(RG[base + 64 + lane]) * d1 * r * gn[h * 128 + 64 + lane]);
        }
        for (int it = gw; it < MT * 4; it += nw) {
            const int row = it >> 2, h = it & 3;
            const float l0 = LSE[((size_t)0 * MPAD + row) * 4 + h], l1 = LSE[((size_t)1 * MPAD + row) * 4 + h], l2 = LSE[((size_t)2 * MPAD + row) * 4 + h];
            const float mx = fmaxf(l0, fmaxf(l1, l2));
            const float w0 = exp2f(l0 - mx), w1 = exp2f(l1 - mx), w2 = exp2f(l2 - mx), inv = 1.0f / (w0 + w1 + w2);
            const size_t off = (size_t)row * 512 + h * 128 + 2 * lane;
            const unsigned a = *(const unsigned*)(OG + (size_t)0 * MPAD * 512 + off), b = *(const unsigned*)(OG + (size_t)1 * MPAD * 512 + off), c = *(const unsigned*)(OG + (size_t)2 * MPAD * 512 + off);
            *(unsigned*)(AATT + off) = pk2((w0 * bflo(a) + w1 * bflo(b) + w2 * bflo(c)) * inv, (w0 * bfhi(a) + w1 * bfhi(b) + w2 * bfhi(c)) * inv);
        }
    }
    SEAM(3);

    if (IN(4)) {
        MidGate Mg{SGR, SGA}; EpiMix E{SGA, MIX};
        gemm_v1_dual(ARET, 1024, WRB, 1024, 1024, AATT, 512, WAB, 512, 512, MT, 1024, Mg, E, gw, nw, lane);
    }
    SEAM(4);
    if (IN(5)) { EpiResIn E{p.in[I_XP], p.in[I_XS], X}; gemm_v1(MIX, 1024, WO, 1024, MT, 1024, 1024, E, gw, nw, lane); }
    SEAM(5);
    if (IN(6)) { for (int m = gw; m < MT; m += nw) rms_row_to_bf16(X + (size_t)m * 1024, p.in[I_LN2], H2 + (size_t)m * 1024, lane); }
    SEAM(6);
    if (IN(7)) { EpiRelu2 E{U}; gemm_v1(H2, 1024, WU, 1024, MT, DFF, 1024, E, gw, nw, lane); }
    SEAM(7);
    if (IN(8)) { EpiResX E{X, X2B}; gemm_v1(U, DFF, WD, DFF, MT, 1024, DFF, E, gw, nw, lane); }
    SEAM(8);
    if (IN(9)) { EpiPle E{X, P}; gemm_v1(X2B, 1024, WPG, 1024, MT, 1024, 1024, E, gw, nw, lane); }
    SEAM(9);
    if (IN(10)) {
        const float* g = p.in[I_LNF];
        for (int m = gw; m < MT; m += nw) {
            float* xr = X + (size_t)m * 1024;
            f32x4 v[4]; float s = 0.f;
#pragma unroll
            for (int j = 0; j < 4; ++j) { v[j] = *(const f32x4*)(xr + 4 * lane + 256 * j); s += (v[j][0] * v[j][0] + v[j][1] * v[j][1]) + (v[j][2] * v[j][2] + v[j][3] * v[j][3]); }
            const float r = rsqrtf(wave_sum(s) * (1.f / 1024.f) + NORM_EPS);
#pragma unroll
            for (int j = 0; j < 4; ++j) { const f32x4 gg = *(const f32x4*)(g + 4 * lane + 256 * j); *(f32x4*)(xr + 4 * lane + 256 * j) = v[j] * r * gg; }
        }
    }
#undef IN
#undef SEAM
}

#ifndef MK_N_LAUNCHES
#define MK_N_LAUNCHES 1
#endif
extern "C" void kernel_launch(void* const* d_in, const int* in_sizes, int n_in, void* d_out, int out_size, void* d_ws, size_t ws_size, hipStream_t stream) {
    static int grid = 0;
    if (grid == 0) {
        if (n_in != 24 || (size_t)out_size != O_END || ws_size < WS_END) { fprintf(stderr, "kernel_launch: unexpected problem shape (n_in %d out %d ws %zu)\n", n_in, out_size, ws_size); grid = -1; return; }
        int dev = 0, cus = 0, per_cu = 0;
        if (hipGetDevice(&dev) != hipSuccess || hipDeviceGetAttribute(&cus, hipDeviceAttributeMultiprocessorCount, dev) != hipSuccess) { grid = -1; return; }
        if (hipFuncSetAttribute((const void*)fwd_kernel, hipFuncAttributeMaxDynamicSharedMemorySize, LDS_BYTES) != hipSuccess) { fprintf(stderr, "kernel_launch: hipFuncSetAttribute failed\n"); grid = -1; return; }
        if (hipOccupancyMaxActiveBlocksPerMultiprocessor(&per_cu, (const void*)fwd_kernel, NTHREADS, LDS_BYTES) != hipSuccess || per_cu < 1) { fprintf(stderr, "kernel_launch: occupancy query failed (%d)\n", per_cu); (void)hipGetLastError(); per_cu = 1; }
        grid = cus * (per_cu < 1 ? 1 : (per_cu > 1 ? 1 : per_cu));
    }
    if (grid < 0) return;
    (void)hipMemsetAsync((char*)d_ws + WS_CTL, 0, CTL_ZERO_BYTES, stream);
    Params p{};
    for (int i = 0; i < 24; ++i) p.in[i] = (const float*)d_in[i];
    p.out = (float*)d_out; p.ws = (unsigned char*)d_ws;
#if MK_N_LAUNCHES == 1
    p.ph_lo = 0; p.ph_hi = NPHASE;
    void* args[] = {&p};
    hipError_t e = hipLaunchCooperativeKernel((const void*)fwd_kernel, dim3(grid), dim3(NTHREADS), args, LDS_BYTES, stream);
    if (e != hipSuccess) fprintf(stderr, "kernel_launch: cooperative launch failed: %s (grid %d)\n", hipGetErrorString(e), grid);
#else
    for (int k = 0; k < NPHASE; ++k) { p.ph_lo = k; p.ph_hi = k + 1; hipLaunchKernelGGL(fwd_kernel, dim3(grid), dim3(NTHREADS), LDS_BYTES, stream, p); }
#endif
}
```

```cpp
#include <hip/hip_runtime.h>
#include <hip/hip_cooperative_groups.h>
#include <cstdio>
#include <cstdint>
namespace cg = cooperative_groups;

#define LAS __attribute__((address_space(3)))
typedef unsigned short bf16;
typedef short bf16x8 __attribute__((ext_vector_type(8)));
typedef float f32x4 __attribute__((ext_vector_type(4)));
typedef float f32x2 __attribute__((ext_vector_type(2)));
typedef unsigned u32x4 __attribute__((ext_vector_type(4)));
typedef unsigned u32x2 __attribute__((ext_vector_type(2)));

constexpr int D = 1024, NB = 8, SEQ = 2048, MP = NB * SEQ, SB = 32, MT = MP + SB, MPAD = 16640;
constexpr int NIN = 9728, DFF = 4096, DPLE = 256;
constexpr int NWAVES = 8, NTHREADS = NWAVES * 64;
constexpr int LDS_BYTES = 147456;
constexpr float NORM_EPS = 1e-6f;
constexpr float LOG2E = 1.4426950408889634f;
constexpr float QSCALE = 0.08838834764831845f * LOG2E;

constexpr size_t O_Y = 0;
constexpr size_t O_STP = (size_t)MT * 1024;
constexpr size_t O_KVP0 = O_STP + 524288;
constexpr size_t O_STS = O_KVP0 + 2 * 524288 + 2 * 2097152 + 2 * 8388608;
constexpr size_t O_KVS0 = O_STS + 2097152;
constexpr size_t O_END = O_KVS0 + 2 * 2097152 + 2 * 8388608 + 2 * 33554432;
static_assert(O_END == 129531904, "d_out size");
__host__ __device__ constexpr int win_of(int g) { return g == 0 ? 128 : (g == 1 ? 512 : 2048); }
__host__ __device__ constexpr int dil_of(int g) { return g == 0 ? 1 : (g == 1 ? 4 : 16); }
__host__ __device__ constexpr size_t okvp(int g, int isv) {
    return O_KVP0 + (g == 0 ? 0 : (g == 1 ? 2 * 524288 : 2 * 524288 + 2 * 2097152)) + (size_t)isv * (size_t)NB * win_of(g) * 512;
}
__host__ __device__ constexpr size_t okvs(int g, int isv) {
    return O_KVS0 + (g == 0 ? 0 : (g == 1 ? 2 * 2097152 : 2 * 2097152 + 2 * 8388608)) + (size_t)isv * (size_t)SB * win_of(g) * 512;
}

constexpr size_t MiB = 1u << 20;
constexpr size_t WS_CTL = 0, CTL_ZERO_BYTES = 1 * MiB;
constexpr size_t WS_ROPE = 1 * MiB;
constexpr size_t WS_BIAS = 1 * MiB + 768 * 1024;
constexpr size_t WS_WIN = 2 * MiB;
constexpr size_t WS_WRB = 21 * MiB;
constexpr size_t WS_WAB = 23 * MiB;
constexpr size_t WS_WO = 24 * MiB;
constexpr size_t WS_WU = 26 * MiB;
constexpr size_t WS_WD = 34 * MiB;
constexpr size_t WS_WPL = 42 * MiB;
constexpr size_t WS_WPG = 43 * MiB;
constexpr size_t WS_HN = 48 * MiB;
constexpr size_t WS_PB = 81 * MiB;
constexpr size_t WS_P = 90 * MiB;
constexpr size_t WS_RQ = 123 * MiB;
constexpr size_t WS_RK = 140 * MiB;
constexpr size_t WS_RV = 157 * MiB;
constexpr size_t WS_RG = 190 * MiB;
constexpr size_t WS_AQ = 223 * MiB;
constexpr size_t WS_AK = 272 * MiB;
constexpr size_t WS_AV = 321 * MiB;
constexpr size_t WS_SGR = 370 * MiB;
constexpr size_t WS_SGA = 403 * MiB;
constexpr size_t WS_OG = 436 * MiB;
constexpr size_t WS_LSE = 485 * MiB;
constexpr size_t WS_END = 486 * MiB;
static_assert(WS_AQ + (size_t)MPAD * 4096 * 2 <= WS_SGR, "U overlay");

__device__ __forceinline__ unsigned f2bf(float f) { unsigned u = __float_as_uint(f); return (u + 0x7fffu + ((u >> 16) & 1u)) >> 16; }
__device__ __forceinline__ float bf2f(unsigned b) { return __uint_as_float(b << 16); }
__device__ __forceinline__ unsigned pk2(float lo, float hi) { return f2bf(lo) | (f2bf(hi) << 16); }
__device__ __forceinline__ float bflo(unsigned w) { return __uint_as_float(w << 16); }
__device__ __forceinline__ float bfhi(unsigned w) { return __uint_as_float(w & 0xffff0000u); }
__device__ __forceinline__ float wave_sum(float v) {
#pragma unroll
    for (int o = 1; o < 64; o <<= 1) v += __shfl_xor(v, o);
    return v;
}
__device__ __forceinline__ float wave_max(float v) {
#pragma unroll
    for (int o = 1; o < 64; o <<= 1) v = fmaxf(v, __shfl_xor(v, o));
    return v;
}
__device__ __forceinline__ float sigmoidf_(float v) { return 1.0f / (1.0f + __expf(-v)); }
__device__ __forceinline__ void st_bf4(bf16* p, f32x4 v) { u32x2 w; w.x = pk2(v[0], v[1]); w.y = pk2(v[2], v[3]); *(u32x2*)p = w; }
__device__ __forceinline__ f32x4 ld_bf4(const bf16* p) { const u32x2 w = *(const u32x2*)p; return (f32x4){bflo(w.x), bfhi(w.x), bflo(w.y), bfhi(w.y)}; }

struct Params {
    const float* in[24];
    float* out;
    unsigned char* ws;
    int ph_lo, ph_hi;
};
enum { I_XP = 0, I_XS, I_STATE, I_CK128, I_CV128, I_CK512, I_CV512, I_CK2K, I_CV2K, I_PP, I_PS, I_LN1, I_WIN, I_GN, I_WRB, I_WAB, I_WO, I_LN2, I_WU, I_WD, I_WPL, I_WPG, I_RELB, I_LNF };

__device__ __forceinline__ void st_bf8(bf16* p, f32x4 a, f32x4 b) { u32x4 w; w.x = pk2(a[0], a[1]); w.y = pk2(a[2], a[3]); w.z = pk2(b[0], b[1]); w.w = pk2(b[2], b[3]); *(u32x4*)p = w; }
__device__ __forceinline__ void ld_bf8(const bf16* p, f32x4& a, f32x4& b) { const u32x4 w = *(const u32x4*)p; a = (f32x4){bflo(w.x), bfhi(w.x), bflo(w.y), bfhi(w.y)}; b = (f32x4){bflo(w.z), bfhi(w.z), bflo(w.w), bfhi(w.w)}; }

namespace pg8 {
typedef bf16 bf16_t;
constexpr int BM = 256, BK = 64, HALF = 128, HTB = HALF * BK * 2, STAGE_BYTES = 8 * HTB, NXCD = 8, WGM = 8;
__host__ __device__ __forceinline__ int lds_byte(int r, int c) { const int st = (r >> 4) * 2 + (c >> 5), rr = r & 15, cc = c & 31, ob = rr * 64 + cc * 2; return st * 1024 + (ob ^ (((ob >> 9) & 1) << 5)); }
__host__ __device__ __forceinline__ void stage_rc(int b, int& R, int& C) { const int st = b / 1024, sb = b % 1024, swz = sb ^ (((sb >> 9) & 1) << 5); R = (st >> 1) * 16 + swz / 64; C = (st & 1) * 32 + (swz % 64) / 2; }
__host__ __device__ __forceinline__ int perm32(int rho) { const int n = rho >> 4, i = rho & 15; return 8 * (i >> 2) + 4 * n + (i & 3); }
struct Unit { const char* A; const char* B; int lda, ldb, nt, pm, pn, kind, keep; };
__device__ __forceinline__ void tile_of(int L, int nM, int nN, int& pm, int& pn) {
    const int nwg = nM * nN; int wgid = L; { const int q = nwg / NXCD, r = nwg % NXCD, xcd = wgid % NXCD, off = wgid / NXCD; wgid = (xcd < r ? xcd * (q + 1) : r * (q + 1) + (xcd - r) * q) + off; }
    const int nig = WGM * nN, gid = wgid / nig, fm = gid * WGM, gsz = (nM - fm) < WGM ? (nM - fm) : WGM;
    pm = fm + ((wgid % nig) % gsz); pn = (wgid % nig) / gsz;
}
template <class F> __device__ __forceinline__ void for_tile(f32x4 (&acc)[2][2][4][2], const Unit& u, int wr, int wc, int fr, int fq, const F& f) {
#pragma unroll
    for (int ai = 0; ai < 2; ++ai)
#pragma unroll
        for (int m = 0; m < 4; ++m) { const int row = u.pm * BM + ai * HALF + wr * 64 + m * 16 + fr;
#pragma unroll
            for (int bj = 0; bj < 2; ++bj) f(row, u.pn * BM + bj * HALF + wc * 32 + 8 * fq, acc[ai][bj][m][0], acc[ai][bj][m][1]); }
}
template <class Epi, class Sched>
__device__ __forceinline__ void gemm_phase(LAS unsigned char* lds, const Sched& S, const Epi& E) {
    const int tid = threadIdx.x, wid = __builtin_amdgcn_readfirstlane(tid >> 6), lane = tid & 63, wr = wid >> 2, wc = wid & 3, fr = lane & 15, fq = lane >> 4;
    unsigned RA[2], RB[2], CC[2];
#pragma unroll
    for (int i = 0; i < 2; ++i) { int R, C; stage_rc(tid * 16 + i * 8192, R, C); RA[i] = 2u * (unsigned)R; RB[i] = 2u * (unsigned)((R & ~31) + perm32(R & 31)); CC[i] = 2u * (unsigned)C; }
    const size_t kstep = (size_t)(BK * 2);
    const unsigned ldsw = (unsigned)wid * 1024u;
    const int aoff = lds_byte(wr * 64 + fr, fq * 8), boff = lds_byte(wc * 32 + fr, fq * 8);
#define PG8_SA(b, h) (((b) * 2 + (h)) * HTB)
#define PG8_SB(b, h) ((4 + (b) * 2 + (h)) * HTB)
#define PG8_STAGE(bufoff, gbase, RR, ld) do { _Pragma("unroll") for (int _i = 0; _i < 2; ++_i) \
        __builtin_amdgcn_global_load_lds((const unsigned*)((const char*)(gbase) + (RR[_i] * (unsigned)(ld) + CC[_i])), (LAS unsigned*)(lds + (bufoff) + ldsw + _i * 8192), 16, 0, 0); } while (0)
#define PG8_LDA(dst, b, h) do { _Pragma("unroll") for (int m = 0; m < 4; ++m) _Pragma("unroll") for (int k = 0; k < 2; ++k) dst[m][k] = *(const LAS bf16x8*)(lds + PG8_SA(b, h) + aoff + m * 2048 + k * 1024); } while (0)
#define PG8_LDB(dst, b, h) do { _Pragma("unroll") for (int n = 0; n < 2; ++n) _Pragma("unroll") for (int k = 0; k < 2; ++k) dst[n][k] = *(const LAS bf16x8*)(lds + PG8_SB(b, h) + boff + n * 2048 + k * 1024); } while (0)
#define PG8_MMA(ai, bj, At, Bt) do { __builtin_amdgcn_s_setprio(1); _Pragma("unroll") for (int m = 0; m < 4; ++m) _Pragma("unroll") for (int n = 0; n < 2; ++n) _Pragma("unroll") for (int k = 0; k < 2; ++k) \
        acc[ai][bj][m][n] = __builtin_amdgcn_mfma_f32_16x16x32_bf16(Bt[n][k], At[m][k], acc[ai][bj][m][n], 0, 0, 0); __builtin_amdgcn_s_setprio(0); } while (0)
#define PG8_WAIT_V(n) asm volatile("s_waitcnt vmcnt(" #n ")" ::: "memory")
#define PG8_WAIT_L(n) asm volatile("s_waitcnt lgkmcnt(" #n ")" ::: "memory")
#define PG8_BAR __builtin_amdgcn_s_barrier()
#define PG8_SCHED __builtin_amdgcn_sched_barrier(0)
    Unit cur, nxt; int ui = 0;
    if (!S.next(0, cur)) return;
    f32x4 acc[2][2][4][2];
#pragma unroll
    for (int a = 0; a < 2; ++a)
#pragma unroll
        for (int b = 0; b < 2; ++b)
#pragma unroll
            for (int m = 0; m < 4; ++m)
#pragma unroll
                for (int n = 0; n < 2; ++n) acc[a][b][m][n] = (f32x4){0.f, 0.f, 0.f, 0.f};
    bf16x8 At[4][2], B0[2][2], B1[2][2];
    int ldAc = cur.lda, ldBc = cur.ldb;
    const char* cA = cur.A; const char* cB = cur.B;
#define HA(ld) ((size_t)HALF * 2 * (size_t)(ld))
    PG8_STAGE(PG8_SB(0, 0), cB, RB, ldBc); PG8_STAGE(PG8_SB(0, 1), cB + HA(ldBc), RB, ldBc); PG8_STAGE(PG8_SA(0, 0), cA, RA, ldAc); PG8_STAGE(PG8_SA(0, 1), cA + HA(ldAc), RA, ldAc);
    if (wr == 1) PG8_BAR;
    PG8_WAIT_V(2); PG8_BAR;
    PG8_STAGE(PG8_SB(1, 0), cB + kstep, RB, ldBc); PG8_STAGE(PG8_SA(1, 0), cA + kstep, RA, ldAc); PG8_STAGE(PG8_SB(1, 1), cB + HA(ldBc) + kstep, RB, ldBc);
    PG8_WAIT_V(6); PG8_BAR;
    for (;;) {
        const bool has_next = S.next(ui + 1, nxt);
        const char* nA = cA; const char* nB = cB; int ldAn = ldAc, ldBn = ldBc;
        if (has_next) { nA = nxt.A; nB = nxt.B; ldAn = nxt.lda; ldBn = nxt.ldb; }
        const int nt = cur.nt;
        for (int t = 0; t < nt; t += 2) {
            const bool last = (t == nt - 2);
            const char* a1 = cA + (size_t)(t + 1) * kstep;
            const char* a2 = last ? nA : cA + (size_t)(t + 2) * kstep; const char* b2 = last ? nB : cB + (size_t)(t + 2) * kstep;
            const char* a3 = a2 + kstep; const char* b3 = b2 + kstep;
            const int ldA2 = last ? ldAn : ldAc, ldB2 = last ? ldBn : ldBc;
            PG8_LDB(B0, 0, 0); PG8_LDB(B1, 0, 1); PG8_SCHED; PG8_LDA(At, 0, 0); PG8_STAGE(PG8_SA(1, 1), a1 + HA(ldAc), RA, ldAc);
            PG8_WAIT_V(8); PG8_WAIT_L(0); PG8_BAR; PG8_MMA(0, 0, At, B0); PG8_MMA(0, 1, At, B1); PG8_BAR; PG8_SCHED;
            PG8_LDA(At, 0, 1); PG8_STAGE(PG8_SB(0, 0), b2, RB, ldB2); PG8_STAGE(PG8_SB(0, 1), b2 + HA(ldB2), RB, ldB2); PG8_STAGE(PG8_SA(0, 0), a2, RA, ldA2);
            PG8_WAIT_V(8); PG8_WAIT_L(0); PG8_BAR; PG8_MMA(1, 0, At, B0); PG8_MMA(1, 1, At, B1); PG8_BAR; PG8_SCHED;
            PG8_LDB(B0, 1, 0); PG8_LDB(B1, 1, 1); PG8_SCHED; PG8_LDA(At, 1, 0); PG8_STAGE(PG8_SA(0, 1), a2 + HA(ldA2), RA, ldA2);
            PG8_WAIT_V(8); PG8_WAIT_L(0); PG8_BAR; PG8_MMA(0, 0, At, B0); PG8_MMA(0, 1, At, B1); PG8_BAR; PG8_SCHED;
            PG8_LDA(At, 1, 1); PG8_STAGE(PG8_SB(1, 0), b3, RB, ldB2); PG8_STAGE(PG8_SB(1, 1), b3 + HA(ldB2), RB, ldB2); PG8_STAGE(PG8_SA(1, 0), a3, RA, ldA2);
            PG8_WAIT_V(8); PG8_WAIT_L(0); PG8_BAR; PG8_MMA(1, 0, At, B0); PG8_MMA(1, 1, At, B1); PG8_BAR; PG8_SCHED;
        }
        if (wr == 0) PG8_BAR;
        E(acc, cur, wr, wc, fr, fq);
        if (!has_next) break;
        if (!cur.keep) {
#pragma unroll
            for (int a = 0; a < 2; ++a)
#pragma unroll
                for (int b = 0; b < 2; ++b)
#pragma unroll
                    for (int m = 0; m < 4; ++m)
#pragma unroll
                        for (int n = 0; n < 2; ++n) acc[a][b][m][n] = (f32x4){0.f, 0.f, 0.f, 0.f};
        }
        cur = nxt; cA = nA; cB = nB; ldAc = ldAn; ldBc = ldBn; ++ui;
        if (wr == 1) PG8_BAR;
    }
    PG8_WAIT_V(0);
    PG8_BAR;
#undef PG8_SA
#undef PG8_SB
#undef PG8_STAGE
#undef PG8_LDA
#undef PG8_LDB
#undef PG8_MMA
#undef PG8_WAIT_V
#undef PG8_WAIT_L
#undef PG8_BAR
#undef PG8_SCHED
#undef HA
}
}

template <class F>
__device__ __forceinline__ void sample_tile(LAS unsigned char* lds, const bf16* __restrict__ A, int lda, const bf16* __restrict__ Bt, int ldb, int K, int tile, const F& f) {
    const int tid = threadIdx.x, lane = tid & 63, wave = tid >> 6, fr = lane & 15, fq = lane >> 4;
    f32x4 acc[2][4];
#pragma unroll
    for (int a = 0; a < 2; ++a)
#pragma unroll
        for (int b = 0; b < 4; ++b) acc[a][b] = (f32x4){0.f, 0.f, 0.f, 0.f};
    const int kw = K / 8;
    const bf16* ap = A + (size_t)fr * lda + wave * kw + fq * 8;
    const bf16* bp = Bt + (size_t)(tile * 64 + fr) * ldb + wave * kw + fq * 8;
    for (int k0 = 0; k0 < kw; k0 += 32) {
        bf16x8 a[2], b[4];
#pragma unroll
        for (int mi = 0; mi < 2; ++mi) a[mi] = *(const bf16x8*)(ap + (size_t)mi * 16 * lda + k0);
#pragma unroll
        for (int ni = 0; ni < 4; ++ni) b[ni] = *(const bf16x8*)(bp + (size_t)ni * 16 * ldb + k0);
#pragma unroll
        for (int mi = 0; mi < 2; ++mi)
#pragma unroll
            for (int ni = 0; ni < 4; ++ni) acc[mi][ni] = __builtin_amdgcn_mfma_f32_16x16x32_bf16(b[ni], a[mi], acc[mi][ni], 0, 0, 0);
    }
    LAS float* part = (LAS float*)lds;
#pragma unroll
    for (int mi = 0; mi < 2; ++mi)
#pragma unroll
        for (int ni = 0; ni < 4; ++ni) *(LAS f32x4*)(part + ((size_t)wave * 32 + mi * 16 + fr) * 68 + ni * 16 + fq * 4) = acc[mi][ni];
    __syncthreads();
    if (tid < 256) {
        const int row = tid >> 3, cg = (tid & 7) * 8;
        f32x4 v0 = (f32x4){0.f, 0.f, 0.f, 0.f}, v1 = v0;
#pragma unroll
        for (int w = 0; w < 8; ++w) { v0 += *(const LAS f32x4*)(part + ((size_t)w * 32 + row) * 68 + cg); v1 += *(const LAS f32x4*)(part + ((size_t)w * 32 + row) * 68 + cg + 4); }
        f(MP + row, tile * 64 + cg, v0, v1);
    }
    __syncthreads();
}

struct EIn {
    bf16 *RQ, *RK, *RV, *RG, *AQ, *AK, *AV, *SGR, *SGA; const f32x2* rope; float* out;
    template <int SEG> __device__ __forceinline__ void seg(int row, int c, f32x4 v0, f32x4 v1) const {
        if (SEG == 0 || SEG == 1) {
            const int cc = c & 511, tp = row < MP ? (row & (SEQ - 1)) : SEQ, i0 = (cc & 63) >> 1;
            const f32x4 r0 = *(const f32x4*)(rope + tp * 32 + i0), r1 = *(const f32x4*)(rope + tp * 32 + i0 + 2);
            f32x4 o0, o1;
            o0[0] = v0[0] * r0[0] - v0[1] * r0[1]; o0[1] = v0[0] * r0[1] + v0[1] * r0[0]; o0[2] = v0[2] * r0[2] - v0[3] * r0[3]; o0[3] = v0[2] * r0[3] + v0[3] * r0[2];
            o1[0] = v1[0] * r1[0] - v1[1] * r1[1]; o1[1] = v1[0] * r1[1] + v1[1] * r1[0]; o1[2] = v1[2] * r1[2] - v1[3] * r1[3]; o1[3] = v1[2] * r1[3] + v1[3] * r1[2];
            if (SEG == 1) { o0 *= 0.125f; o1 *= 0.125f; }
            st_bf8((SEG == 1 ? RK : RQ) + (size_t)row * 512 + cc, o0, o1);
        } else if (SEG == 2) {
            st_bf8(RV + (size_t)row * 1024 + (c - 1024), v0, v1);
        } else if (SEG == 3) {
            f32x4 s0, s1;
#pragma unroll
            for (int j = 0; j < 4; ++j) { s0[j] = v0[j] * sigmoidf_(v0[j]); s1[j] = v1[j] * sigmoidf_(v1[j]); }
            st_bf8(RG + (size_t)row * 1024 + (c - 2048), s0, s1);
        } else if (SEG == 4) {
            st_bf8(AQ + (size_t)row * 1536 + (c - 3072), v0 * QSCALE, v1 * QSCALE);
        } else if (SEG == 5 || SEG == 6) {
            const int isv = SEG == 6; const int cc = c - (isv ? 6144 : 4608); const int g = cc >> 9, hc = cc & 511;
            st_bf8((isv ? AV : AK) + (size_t)row * 1536 + cc, v0, v1);
            const int W = win_of(g);
            float* dst = nullptr;
            if (row < MP) { const int t = row & (SEQ - 1), b = row >> 11; if (t >= SEQ - W) dst = out + okvp(g, isv) + ((size_t)(b * W + t - (SEQ - W)) * 512 + hc); }
            else { const int bs = row - MP; dst = out + okvs(g, isv) + ((size_t)(bs * W + (W - 1)) * 512 + hc); }
            if (dst) { *(f32x4*)dst = v0; *(f32x4*)(dst + 4) = v1; }
        } else {
            f32x4 s0, s1;
#pragma unroll
            for (int j = 0; j < 4; ++j) { s0[j] = sigmoidf_(v0[j]); s1[j] = sigmoidf_(v1[j]); }
            st_bf8((SEG == 8 ? SGA : SGR) + (size_t)row * 1024 + (c - (SEG == 8 ? 8704 : 7680)), s0, s1);
        }
    }
    __device__ __forceinline__ static int seg_of(int c) { return c < 512 ? 0 : c < 1024 ? 1 : c < 2048 ? 2 : c < 3072 ? 3 : c < 4608 ? 4 : c < 6144 ? 5 : c < 7680 ? 6 : c < 8704 ? 7 : 8; }
    __device__ __forceinline__ void operator()(int row, int c, f32x4 v0, f32x4 v1) const {
        switch (seg_of(c)) { case 0: seg<0>(row, c, v0, v1); break; case 1: seg<1>(row, c, v0, v1); break; case 2: seg<2>(row, c, v0, v1); break; case 3: seg<3>(row, c, v0, v1); break;
            case 4: seg<4>(row, c, v0, v1); break; case 5: seg<5>(row, c, v0, v1); break; case 6: seg<6>(row, c, v0, v1); break; case 7: seg<7>(row, c, v0, v1); break; default: seg<8>(row, c, v0, v1); break; }
    }
};
struct EStoreBf { bf16* O; int ld; __device__ __forceinline__ void operator()(int row, int c, f32x4 v0, f32x4 v1) const { st_bf8(O + (size_t)row * ld + c, v0, v1); } };
struct EResIn {
    const float *xp, *xs; float* X;
    __device__ __forceinline__ void operator()(int row, int c, f32x4 v0, f32x4 v1) const {
        const float* src = row < MP ? xp + (size_t)row * 1024 + c : xs + (size_t)(row - MP) * 1024 + c; float* d = X + (size_t)row * 1024 + c;
        *(f32x4*)d = *(const f32x4*)src + v0; *(f32x4*)(d + 4) = *(const f32x4*)(src + 4) + v1;
    }
};
struct ERelu2 {
    bf16* U;
    __device__ __forceinline__ void operator()(int row, int c, f32x4 v0, f32x4 v1) const {
        f32x4 s0, s1;
#pragma unroll
        for (int j = 0; j < 4; ++j) { const float a = fmaxf(v0[j], 0.f), b = fmaxf(v1[j], 0.f); s0[j] = a * a; s1[j] = b * b; }
        st_bf8(U + (size_t)row * DFF + c, s0, s1);
    }
};
struct EResX {
    float* X; bf16* XB;
    __device__ __forceinline__ void operator()(int row, int c, f32x4 v0, f32x4 v1) const {
        float* p = X + (size_t)row * 1024 + c; const f32x4 o0 = *(const f32x4*)p + v0, o1 = *(const f32x4*)(p + 4) + v1; *(f32x4*)p = o0; *(f32x4*)(p + 4) = o1;
        st_bf8(XB + (size_t)row * 1024 + c, o0, o1);
    }
};
struct EPle {
    float* X; const bf16* P;
    __device__ __forceinline__ void operator()(int row, int c, f32x4 v0, f32x4 v1) const {
        float* p = X + (size_t)row * 1024 + c; f32x4 p0, p1; ld_bf8(P + (size_t)row * 1024 + c, p0, p1); f32x4 o0 = *(const f32x4*)p, o1 = *(const f32x4*)(p + 4);
#pragma unroll
        for (int j = 0; j < 4; ++j) { o0[j] += sigmoidf_(v0[j]) * p0[j]; o1[j] += sigmoidf_(v1[j]) * p1[j]; }
        *(f32x4*)p = o0; *(f32x4*)(p + 4) = o1;
    }
};

enum { K_IN = 0, K_P = 1, K_MIXA = 2, K_MIXB = 3 };
struct EpiG1 {
    EIn e; EStoreBf ep;
    __device__ __forceinline__ void operator()(f32x4 (&acc)[2][2][4][2], const pg8::Unit& u, int wr, int wc, int fr, int fq) const {
        if (u.kind == K_P) { pg8::for_tile(acc, u, wr, wc, fr, fq, [&](int r, int c, f32x4& a, f32x4& b) { ep(r, c, a, b); }); return; }
        switch (EIn::seg_of(u.pn * 256)) {
            case 0: pg8::for_tile(acc, u, wr, wc, fr, fq, [&](int r, int c, f32x4& a, f32x4& b) { e.seg<0>(r, c, a, b); }); break;
            case 1: pg8::for_tile(acc, u, wr, wc, fr, fq, [&](int r, int c, f32x4& a, f32x4& b) { e.seg<1>(r, c, a, b); }); break;
            case 2: pg8::for_tile(acc, u, wr, wc, fr, fq, [&](int r, int c, f32x4& a, f32x4& b) { e.seg<2>(r, c, a, b); }); break;
            case 3: pg8::for_tile(acc, u, wr, wc, fr, fq, [&](int r, int c, f32x4& a, f32x4& b) { e.seg<3>(r, c, a, b); }); break;
            case 4: pg8::for_tile(acc, u, wr, wc, fr, fq, [&](int r, int c, f32x4& a, f32x4& b) { e.seg<4>(r, c, a, b); }); break;
            case 5: pg8::for_tile(acc, u, wr, wc, fr, fq, [&](int r, int c, f32x4& a, f32x4& b) { e.seg<5>(r, c, a, b); }); break;
            case 6: pg8::for_tile(acc, u, wr, wc, fr, fq, [&](int r, int c, f32x4& a, f32x4& b) { e.seg<6>(r, c, a, b); }); break;
            case 7: pg8::for_tile(acc, u, wr, wc, fr, fq, [&](int r, int c, f32x4& a, f32x4& b) { e.seg<7>(r, c, a, b); }); break;
            default: pg8::for_tile(acc, u, wr, wc, fr, fq, [&](int r, int c, f32x4& a, f32x4& b) { e.seg<8>(r, c, a, b); }); break;
        }
    }
};
struct SchedG1 {
    int G, c; const char *HN, *WIN, *PB, *WPL;
    __device__ __forceinline__ bool next(int i, pg8::Unit& u) const {
        constexpr int NMAIN = 64 * 38;
        long L = (long)i * G + c;
        if (L >= NMAIN && G == 256 && i == 10) L = (long)i * G + ((c + 128) & 255);
        if (L < NMAIN) { int pm, pn; pg8::tile_of((int)L, 64, 38, pm, pn); u.A = HN + (size_t)pm * 256 * 1024 * 2; u.B = WIN + (size_t)pn * 256 * 1024 * 2; u.lda = 1024; u.ldb = 1024; u.nt = 16; u.pm = pm; u.pn = pn; u.kind = K_IN; u.keep = 0; return true; }
        L -= NMAIN; if (L >= 256) return false;
        const int pm = (int)(L >> 2), pn = (int)(L & 3);
        u.A = PB + (size_t)pm * 256 * DPLE * 2; u.B = WPL + (size_t)pn * 256 * DPLE * 2; u.lda = DPLE; u.ldb = DPLE; u.nt = 4; u.pm = pm; u.pn = pn; u.kind = K_P; u.keep = 0; return true;
    }
};
template <class F> struct EpiSimple {
    F f;
    __device__ __forceinline__ void operator()(f32x4 (&acc)[2][2][4][2], const pg8::Unit& u, int wr, int wc, int fr, int fq) const {
        pg8::for_tile(acc, u, wr, wc, fr, fq, [&](int r, int c, f32x4& a, f32x4& b) { f(r, c, a, b); });
    }
};
struct SchedPlain {
    int G, c, nN, K; const char *A, *B;
    __device__ __forceinline__ bool next(int i, pg8::Unit& u) const {
        const long L = (long)i * G + c; if (L >= 64 * nN) return false;
        int pm, pn; pg8::tile_of((int)L, 64, nN, pm, pn);
        u.A = A + (size_t)pm * 256 * K * 2; u.B = B + (size_t)pn * 256 * K * 2; u.lda = K; u.ldb = K; u.nt = K / 64; u.pm = pm; u.pn = pn; u.kind = 0; u.keep = 0; return true;
    }
};
struct EpiMix {
    const bf16 *SGR, *SGA; bf16* MIX;
    __device__ __forceinline__ void operator()(f32x4 (&acc)[2][2][4][2], const pg8::Unit& u, int wr, int wc, int fr, int fq) const {
        if (u.kind == K_MIXA) pg8::for_tile(acc, u, wr, wc, fr, fq, [&](int r, int c, f32x4& a, f32x4& b) {
            f32x4 r0, r1, a0, a1; ld_bf8(SGR + (size_t)r * 1024 + c, r0, r1); ld_bf8(SGA + (size_t)r * 1024 + c, a0, a1);
#pragma unroll
            for (int j = 0; j < 4; ++j) { a[j] *= r0[j] / a0[j]; b[j] *= r1[j] / a1[j]; } });
        else pg8::for_tile(acc, u, wr, wc, fr, fq, [&](int r, int c, f32x4& a, f32x4& b) {
            f32x4 a0, a1; ld_bf8(SGA + (size_t)r * 1024 + c, a0, a1); st_bf8(MIX + (size_t)r * 1024 + c, a * a0, b * a1); });
    }
};
struct SchedMix {
    int G, c; const char *ARET, *WRB, *AATT, *WAB;
    __device__ __forceinline__ bool next(int i, pg8::Unit& u) const {
        const int tile = (i >> 1) * G + c; if (tile >= 256) return false;
        int pm, pn; pg8::tile_of(tile, 64, 4, pm, pn); u.pm = pm; u.pn = pn;
        if ((i & 1) == 0) { u.A = ARET + (size_t)pm * 256 * 1024 * 2; u.B = WRB + (size_t)pn * 256 * 1024 * 2; u.lda = 1024; u.ldb = 1024; u.nt = 16; u.kind = K_MIXA; u.keep = 1; }
        else { u.A = AATT + (size_t)pm * 256 * 512 * 2; u.B = WAB + (size_t)pn * 256 * 512 * 2; u.lda = 512; u.ldb = 512; u.nt = 8; u.kind = K_MIXB; u.keep = 0; }
        return true;
    }
};

template <bool PERM>
__device__ __forceinline__ void transpose_item(const float* __restrict__ W, int K, int N, bf16* __restrict__ WT, LAS float* scr, int item, int lane) {
    const int nblk = N / 32, kb = item / nblk, nb = item % nblk, k0 = 64 * kb, n0 = 32 * nb;
    int srcc = n0 + (lane & 31);
    if (PERM && n0 < 1024) srcc = (n0 & ~63) + ((n0 & 32) >> 1) + ((lane & 31) >> 1) + 32 * (lane & 1);
#pragma unroll 8
    for (int i = 0; i < 32; ++i) { const int kk = 2 * i + (lane >> 5); scr[kk * 33 + (lane & 31)] = W[(size_t)(k0 + kk) * N + srcc]; }
    asm volatile("s_waitcnt lgkmcnt(0)" ::: "memory");
    const int c = lane & 7;
#pragma unroll
    for (int j = 0; j < 4; ++j) { const int n = (lane >> 3) + 8 * j; const LAS float* s = scr + (8 * c) * 33 + n;
        u32x4 o; o.x = pk2(s[0 * 33], s[1 * 33]); o.y = pk2(s[2 * 33], s[3 * 33]); o.z = pk2(s[4 * 33], s[5 * 33]); o.w = pk2(s[6 * 33], s[7 * 33]);
        *(u32x4*)(WT + (size_t)(n0 + n) * K + k0 + 8 * c) = o; }
    asm volatile("s_waitcnt lgkmcnt(0)" ::: "memory");
}
__device__ __forceinline__ void rms_row_to_bf16(const float* __restrict__ xrow, const float* __restrict__ g, bf16* __restrict__ orow, int lane) {
    f32x4 v[4]; float s = 0.f;
#pragma unroll
    for (int j = 0; j < 4; ++j) { v[j] = *(const f32x4*)(xrow + 4 * lane + 256 * j); s += (v[j][0] * v[j][0] + v[j][1] * v[j][1]) + (v[j][2] * v[j][2] + v[j][3] * v[j][3]); }
    const float r = rsqrtf(wave_sum(s) * (1.f / 1024.f) + NORM_EPS);
#pragma unroll
    for (int j = 0; j < 4; ++j) { const f32x4 gg = *(const f32x4*)(g + 4 * lane + 256 * j); st_bf4(orow + 4 * lane + 256 * j, v[j] * r * gg); }
}

constexpr int NPHASE = 11;
__global__ void __launch_bounds__(NTHREADS, 2) fwd_kernel(Params p) {
    extern __shared__ __attribute__((aligned(16))) unsigned char lds_raw[];
    LAS unsigned char* lds = (LAS unsigned char*)lds_raw;
    cg::grid_group grid = cg::this_grid();
    const int tid = threadIdx.x, lane = tid & 63, wave = tid >> 6;
    const int G = gridDim.x, gw = blockIdx.x * NWAVES + wave, nw = G * NWAVES;
    const size_t gtid = (size_t)blockIdx.x * NTHREADS + tid, nthr = (size_t)G * NTHREADS;
    unsigned char* ws = p.ws; float* out = p.out;
    const f32x2* rope = (const f32x2*)(ws + WS_ROPE);
    float* bias2 = (float*)(ws + WS_BIAS);
    bf16* WIN = (bf16*)(ws + WS_WIN); bf16* WRB = (bf16*)(ws + WS_WRB); bf16* WAB = (bf16*)(ws + WS_WAB); bf16* WO = (bf16*)(ws + WS_WO);
    bf16* WU = (bf16*)(ws + WS_WU); bf16* WD = (bf16*)(ws + WS_WD); bf16* WPL = (bf16*)(ws + WS_WPL); bf16* WPG = (bf16*)(ws + WS_WPG);
    bf16* HN = (bf16*)(ws + WS_HN); bf16* ARET = HN; bf16* PB = (bf16*)(ws + WS_PB); bf16* P = (bf16*)(ws + WS_P);
    bf16* RQ = (bf16*)(ws + WS_RQ); bf16* AATT = RQ; bf16* RK = (bf16*)(ws + WS_RK); bf16* RV = (bf16*)(ws + WS_RV); bf16* MIX = RV;
    bf16* RG = (bf16*)(ws + WS_RG); bf16* H2 = RG; bf16* AQ = (bf16*)(ws + WS_AQ); bf16* AK = (bf16*)(ws + WS_AK); bf16* AV = (bf16*)(ws + WS_AV); bf16* U = AQ;
    bf16* SGR = (bf16*)(ws + WS_SGR); bf16* X2B = SGR; bf16* SGA = (bf16*)(ws + WS_SGA); bf16* OG = (bf16*)(ws + WS_OG); float* LSE = (float*)(ws + WS_LSE);
    float* X = out + O_Y;
    float* RO = out + O_Y;
    const int lo = p.ph_lo, hi = p.ph_hi;
#define IN(k) (lo <= (k) && (k) < hi)
#define SEAM(k) do { if (IN(k) && IN((k) + 1)) grid.sync(); } while (0)

    if (IN(0)) {
        LAS float* scr = (LAS float*)(lds + wave * 16384);
        constexpr int I_IN = 16 * (NIN / 32), I_RB = 16 * 32, I_AB = 8 * 32, I_O = 16 * 32, I_U = 16 * 128, I_D = 64 * 32, I_PL = 4 * 32, I_PG = 16 * 32;
        constexpr int NITEMS = I_IN + I_RB + I_AB + I_O + I_U + I_D + I_PL + I_PG;
        for (int it = gw; it < NITEMS; it += nw) {
            int r = it;
            if (r < I_IN) { transpose_item<true>(p.in[I_WIN], 1024, NIN, WIN, scr, r, lane); continue; } r -= I_IN;
            if (r < I_RB) { transpose_item<false>(p.in[I_WRB], 1024, 1024, WRB, scr, r, lane); continue; } r -= I_RB;
            if (r < I_AB) { transpose_item<false>(p.in[I_WAB], 512, 1024, WAB, scr, r, lane); continue; } r -= I_AB;
            if (r < I_O) { transpose_item<false>(p.in[I_WO], 1024, 1024, WO, scr, r, lane); continue; } r -= I_O;
            if (r < I_U) { transpose_item<false>(p.in[I_WU], 1024, DFF, WU, scr, r, lane); continue; } r -= I_U;
            if (r < I_D) { transpose_item<false>(p.in[I_WD], DFF, 1024, WD, scr, r, lane); continue; } r -= I_D;
            if (r < I_PL) { transpose_item<false>(p.in[I_WPL], DPLE, 1024, WPL, scr, r, lane); continue; } r -= I_PL;
            transpose_item<false>(p.in[I_WPG], 1024, 1024, WPG, scr, r, lane);
        }
        for (int m = gw; m < MT; m += nw) {
            const float* xr = m < MP ? p.in[I_XP] + (size_t)m * 1024 : p.in[I_XS] + (size_t)(m - MP) * 1024;
            rms_row_to_bf16(xr, p.in[I_LN1], HN + (size_t)m * 1024, lane);
            const float* pr = m < MP ? p.in[I_PP] + (size_t)m * DPLE : p.in[I_PS] + (size_t)(m - MP) * DPLE;
            st_bf4(PB + (size_t)m * DPLE + 4 * lane, *(const f32x4*)(pr + 4 * lane));
        }
        for (size_t i = gtid; i < (size_t)2049 * 32; i += nthr) {
            const int tp = (int)(i >> 5), j = (int)(i & 31);
            const float pos = tp < SEQ ? (float)tp : 16384.0f;
            const float inv = exp2f(-(float)j * (13.287712379549449f / 32.0f));
            const float ang = pos * inv;
            double rev = (double)ang * 0.15915494309189535; rev -= floor(rev);
            const float rr = (float)(rev * 6.283185307179586 - 3.141592653589793);
            float sn, cs; __sincosf(rr, &sn, &cs);
            ((f32x2*)(ws + WS_ROPE))[i] = (f32x2){-cs, -sn};
        }
        for (size_t i = gtid; i < 12 * 128; i += nthr) {
            const int gh = (int)(i >> 7), j = (int)(i & 127), g = gh >> 2;
            const int d = j * dil_of(g);
            int bkt;
            if (d < 16) bkt = d;
            else { const float lr = __logf((float)d / 16.0f) / 4.852030263919617f; bkt = 16 + (int)(lr * 16.0f); bkt = bkt < 31 ? bkt : 31; }
            bias2[i] = p.in[I_RELB][bkt * 12 + gh] * LOG2E;
        }
        for (int a = 0; a < 6; ++a) {
            const int g = a >> 1, isv = a & 1, W = win_of(g);
            const f32x4* src = (const f32x4*)p.in[I_CK128 + a]; f32x4* dst = (f32x4*)(out + okvs(g, isv));
            const size_t per = (size_t)(W - 1) * 128, tot = per * SB;
            for (size_t i = gtid; i < tot; i += nthr) { const size_t bs = i / per, r = i - bs * per; dst[bs * (size_t)W * 128 + r] = src[bs * (size_t)W * 128 + 128 + r]; }
        }
    }
    SEAM(0);

    if (IN(1)) {
        const EIn e{RQ, RK, RV, RG, AQ, AK, AV, SGR, SGA, rope, out}; const EStoreBf ep{P, 1024};
        { const EpiG1 E{e, ep}; const SchedG1 S{G, (int)blockIdx.x, (const char*)HN, (const char*)WIN, (const char*)PB, (const char*)WPL}; pg8::gemm_phase(lds, S, E); }
        const int s0 = (G == 256) ? (int)blockIdx.x - 128 : (int)blockIdx.x, sn = (G == 256) ? 128 : G;
        if (s0 >= 0) for (int t = s0; t < 168; t += sn) {
            if (t < 152) sample_tile(lds, HN + (size_t)MP * 1024, 1024, WIN, 1024, 1024, t, e);
            else sample_tile(lds, PB + (size_t)MP * DPLE, DPLE, WPL, DPLE, DPLE, t - 152, ep);
        }
    }
    SEAM(1);

    if (IN(2)) {
        for (size_t it = gtid; it < (size_t)NB * 8 * 128; it += nthr) {
            const int b = (int)(it >> 10), h = (int)(it >> 7) & 7, v = (int)(it & 127);
            const float gamma = 1.0f - exp2f(-5.0f - (float)h);
            float S[64];
#pragma unroll
            for (int k = 0; k < 64; ++k) S[k] = 0.f;
            for (int t = 0; t < SEQ; ++t) {
                const size_t row = (size_t)b * SEQ + t;
                const u32x4* kp = (const u32x4*)(RK + row * 512 + h * 64); const u32x4* qp = (const u32x4*)(RQ + row * 512 + h * 64);
                const float vv = bf2f(RV[row * 1024 + h * 128 + v]);
                float o = 0.f;
#pragma unroll
                for (int c8 = 0; c8 < 8; ++c8) {
                    const u32x4 kw = kp[c8], qw = qp[c8];
                    const unsigned kk[4] = {kw.x, kw.y, kw.z, kw.w}, qq[4] = {qw.x, qw.y, qw.z, qw.w};
#pragma unroll
                    for (int j = 0; j < 4; ++j) {
                        const int k0 = c8 * 8 + 2 * j;
                        S[k0] = gamma * S[k0] + bflo(kk[j]) * vv; o += bflo(qq[j]) * S[k0];
                        S[k0 + 1] = gamma * S[k0 + 1] + bfhi(kk[j]) * vv; o += bfhi(qq[j]) * S[k0 + 1];
                    }
                }
                RO[row * 1024 + h * 128 + v] = o;
            }
            float* so = out + O_STP + ((size_t)(b * 8 + h) * 64) * 128 + v;
#pragma unroll
            for (int k = 0; k < 64; ++k) so[(size_t)((k >> 1) + 32 * (k & 1)) * 128] = S[k];
        }
        for (size_t it = gtid; it < (size_t)SB * 8 * 128; it += nthr) {
            const int bs = (int)(it >> 10), h = (int)(it >> 7) & 7, v = (int)(it & 127);
            const float gamma = 1.0f - exp2f(-5.0f - (float)h);
            const size_t row = (size_t)MP + bs;
            const float vv = bf2f(RV[row * 1024 + h * 128 + v]);
            const float* si = p.in[I_STATE] + ((size_t)(bs * 8 + h) * 64) * 128 + v;
            float* so = out + O_STS + ((size_t)(bs * 8 + h) * 64) * 128 + v;
            float o = 0.f;
            for (int k = 0; k < 64; ++k) {
                const int ko = (k >> 1) + 32 * (k & 1);
                const float s = gamma * si[(size_t)ko * 128] + bf2f(RK[row * 512 + h * 64 + k]) * vv;
                o += bf2f(RQ[row * 512 + h * 64 + k]) * s;
                so[(size_t)ko * 128] = s;
            }
            RO[row * 1024 + h * 128 + v] = o;
        }
        LAS float* qs = (LAS float*)(lds + wave * 512);
        for (int it = gw; it < 3 * MP * 4; it += nw) {
            const int g = it / (MP * 4), rem = it - g * (MP * 4), row = rem >> 2, h = rem & 3, t = row & (SEQ - 1), dil = dil_of(g);
            const bf16* qp = AQ + (size_t)row * 1536 + g * 512 + h * 128;
            { const unsigned w = *(const unsigned*)(qp + 2 * lane); qs[2 * lane] = bflo(w); qs[2 * lane + 1] = bfhi(w); }
            asm volatile("s_waitcnt lgkmcnt(0)" ::: "memory");
            float s[2];
#pragma unroll
            for (int hh = 0; hh < 2; ++hh) {
                const int j = lane + 64 * hh; const int tk = t - j * dil;
                float acc = -INFINITY;
                if (tk >= 0) {
                    const u32x4* kp = (const u32x4*)(AK + (size_t)(row - j * dil) * 1536 + g * 512 + h * 128);
                    acc = 0.f;
#pragma unroll 4
                    for (int c8 = 0; c8 < 16; ++c8) {
                        const u32x4 kw = kp[c8]; const f32x4 q0 = *(const LAS f32x4*)(qs + c8 * 8), q1 = *(const LAS f32x4*)(qs + c8 * 8 + 4);
                        acc += bflo(kw.x) * q0[0] + bfhi(kw.x) * q0[1] + bflo(kw.y) * q0[2] + bfhi(kw.y) * q0[3]
                             + bflo(kw.z) * q1[0] + bfhi(kw.z) * q1[1] + bflo(kw.w) * q1[2] + bfhi(kw.w) * q1[3];
                    }
                    acc += bias2[(g * 4 + h) * 128 + j];
                }
                s[hh] = acc;
            }
            const float m = wave_max(fmaxf(s[0], s[1]));
            const float p0 = exp2f(s[0] - m), p1 = exp2f(s[1] - m);
            const float den = wave_sum(p0 + p1);
            float o0 = 0.f, o1 = 0.f;
            const int jmax = (t / dil) < 127 ? (t / dil) : 127;
            for (int j = 0; j <= jmax; ++j) {
                const float pj = __shfl(j < 64 ? p0 : p1, j & 63);
                const unsigned w = *(const unsigned*)(AV + (size_t)(row - j * dil) * 1536 + g * 512 + h * 128 + 2 * lane);
                o0 += pj * bflo(w); o1 += pj * bfhi(w);
            }
            const float inv = 1.0f / den;
            *(unsigned*)(OG + ((size_t)g * MPAD + row) * 512 + h * 128 + 2 * lane) = pk2(o0 * inv, o1 * inv);
            if (lane == 0) LSE[((size_t)g * MPAD + row) * 4 + h] = m + log2f(den);
            asm volatile("s_waitcnt lgkmcnt(0)" ::: "memory");
        }
        for (int it = gw; it < 3 * SB * 4; it += nw) {
            const int g = it / (SB * 4), rem = it - g * (SB * 4), bs = rem >> 2, h = rem & 3, dil = dil_of(g), W = win_of(g);
            const size_t row = (size_t)MP + bs;
            const float* ck = p.in[I_CK128 + 2 * g] + (size_t)bs * W * 512 + h * 128;
            const float* cv = p.in[I_CV128 + 2 * g] + (size_t)bs * W * 512 + h * 128;
            const bf16* qp = AQ + row * 1536 + g * 512 + h * 128;
            { const unsigned w = *(const unsigned*)(qp + 2 * lane); qs[2 * lane] = bflo(w); qs[2 * lane + 1] = bfhi(w); }
            asm volatile("s_waitcnt lgkmcnt(0)" ::: "memory");
            float s[2];
#pragma unroll
            for (int hh = 0; hh < 2; ++hh) {
                const int j = lane + 64 * hh;
                float acc = 0.f;
                if (j == 0) {
                    const bf16* kp = AK + row * 1536 + g * 512 + h * 128;
                    for (int e = 0; e < 128; ++e) acc += bf2f(kp[e]) * qs[e];
                } else {
                    const f32x4* kp = (const f32x4*)(ck + (size_t)(W - j * dil) * 512);
                    for (int c4 = 0; c4 < 32; ++c4) { const f32x4 kv = kp[c4]; const f32x4 q0 = *(const LAS f32x4*)(qs + c4 * 4); acc += kv[0] * q0[0] + kv[1] * q0[1] + kv[2] * q0[2] + kv[3] * q0[3]; }
                }
                s[hh] = acc + bias2[(g * 4 + h) * 128 + j];
            }
            const float m = wave_max(fmaxf(s[0], s[1]));
            const float p0 = exp2f(s[0] - m), p1 = exp2f(s[1] - m);
            const float den = wave_sum(p0 + p1);
            float o0 = 0.f, o1 = 0.f;
            for (int j = 0; j < 128; ++j) {
                const float pj = __shfl(j < 64 ? p0 : p1, j & 63);
                float v0, v1;
                if (j == 0) { const unsigned w = *(const unsigned*)(AV + row * 1536 + g * 512 + h * 128 + 2 * lane); v0 = bflo(w); v1 = bfhi(w); }
                else { const f32x2 vv = *(const f32x2*)(cv + (size_t)(W - j * dil) * 512 + 2 * lane); v0 = vv.x; v1 = vv.y; }
                o0 += pj * v0; o1 += pj * v1;
            }
            const float inv = 1.0f / den;
            *(unsigned*)(OG + ((size_t)g * MPAD + row) * 512 + h * 128 + 2 * lane) = pk2(o0 * inv, o1 * inv);
            if (lane == 0) LSE[((size_t)g * MPAD + row) * 4 + h] = m + log2f(den);
            asm volatile("s_waitcnt lgkmcnt(0)" ::: "memory");
        }
    }
    SEAM(2);

    if (IN(3)) {
        const float* gn = p.in[I_GN];
        for (int it = gw; it < MT * 8; it += nw) {
            const int row = it >> 3, h = it & 7;
            const size_t base = (size_t)row * 1024 + h * 128;
            const float x0 = RO[base + lane], x1 = RO[base + 64 + lane];
            const float mu = wave_sum(x0 + x1) * (1.f / 128.f);
            const float d0 = x0 - mu, d1 = x1 - mu;
            const float r = rsqrtf(wave_sum(d0 * d0 + d1 * d1) * (1.f / 128.f) + NORM_EPS);
            ARET[base + lane] = (bf16)f2bf(bf2f(RG[base + lane]) * d0 * r * gn[h * 128 + lane]);
            ARET[base + 64 + lane] = (bf16)f2bf(bf2f(RG[base + 64 + lane]) * d1 * r * gn[h * 128 + 64 + lane]);
        }
        for (int it = gw; it < MT * 4; it += nw) {
            const int row = it >> 2, h = it & 3;
            const float l0 = LSE[((size_t)0 * MPAD + row) * 4 + h], l1 = LSE[((size_t)1 * MPAD + row) * 4 + h], l2 = LSE[((size_t)2 * MPAD + row) * 4 + h];
            const float mx = fmaxf(l0, fmaxf(l1, l2));
            const float w0 = exp2f(l0 - mx), w1 = exp2f(l1 - mx), w2 = exp2f(l2 - mx), inv = 1.0f / (w0 + w1 + w2);
            const size_t off = (size_t)row * 512 + h * 128 + 2 * lane;
            const unsigned a = *(const unsigned*)(OG + (size_t)0 * MPAD * 512 + off), b = *(const unsigned*)(OG + (size_t)1 * MPAD * 512 + off), c = *(const unsigned*)(OG + (size_t)2 * MPAD * 512 + off);
            *(unsigned*)(AATT + off) = pk2((w0 * bflo(a) + w1 * bflo(b) + w2 * bflo(c)) * inv, (w0 * bfhi(a) + w1 * bfhi(b) + w2 * bfhi(c)) * inv);
        }
    }
    SEAM(3);

    if (IN(4)) {
        for (int t = blockIdx.x; t < 16; t += G) {
            f32x4 r0 = (f32x4){0.f, 0.f, 0.f, 0.f}, r1 = r0;
            sample_tile(lds, ARET + (size_t)MP * 1024, 1024, WRB, 1024, 1024, t, [&](int, int, f32x4 v0, f32x4 v1) { r0 = v0; r1 = v1; });
            sample_tile(lds, AATT + (size_t)MP * 512, 512, WAB, 512, 512, t, [&](int row, int c, f32x4 v0, f32x4 v1) {
                f32x4 g0, g1, a0, a1; ld_bf8(SGR + (size_t)row * 1024 + c, g0, g1); ld_bf8(SGA + (size_t)row * 1024 + c, a0, a1);
                st_bf8(MIX + (size_t)row * 1024 + c, g0 * r0 + a0 * v0, g1 * r1 + a1 * v1); });
        }
        const EpiMix E{SGR, SGA, MIX}; const SchedMix S{G, (int)blockIdx.x, (const char*)ARET, (const char*)WRB, (const char*)AATT, (const char*)WAB};
        pg8::gemm_phase(lds, S, E);
    }
    SEAM(4);
    if (IN(5)) {
        const EResIn e{p.in[I_XP], p.in[I_XS], X};
        for (int t = blockIdx.x; t < 16; t += G) sample_tile(lds, MIX + (size_t)MP * 1024, 1024, WO, 1024, 1024, t, e);
        const EpiSimple<EResIn> E{e}; const SchedPlain S{G, (int)blockIdx.x, 4, 1024, (const char*)MIX, (const char*)WO}; pg8::gemm_phase(lds, S, E);
    }
    SEAM(5);
    if (IN(6)) { for (int m = gw; m < MT; m += nw) rms_row_to_bf16(X + (size_t)m * 1024, p.in[I_LN2], H2 + (size_t)m * 1024, lane); }
    SEAM(6);
    if (IN(7)) {
        const ERelu2 e{U};
        for (int t = blockIdx.x; t < 64; t += G) sample_tile(lds, H2 + (size_t)MP * 1024, 1024, WU, 1024, 1024, t, e);
        const EpiSimple<ERelu2> E{e}; const SchedPlain S{G, (int)blockIdx.x, 16, 1024, (const char*)H2, (const char*)WU}; pg8::gemm_phase(lds, S, E);
    }
    SEAM(7);
    if (IN(8)) {
        const EResX e{X, X2B};
        for (int t = blockIdx.x; t < 16; t += G) sample_tile(lds, U + (size_t)MP * DFF, DFF, WD, DFF, DFF, t, e);
        const EpiSimple<EResX> E{e}; const SchedPlain S{G, (int)blockIdx.x, 4, DFF, (const char*)U, (const char*)WD}; pg8::gemm_phase(lds, S, E);
    }
    SEAM(8);
    if (IN(9)) {
        const EPle e{X, P};
        for (int t = blockIdx.x; t < 16; t += G) sample_tile(lds, X2B + (size_t)MP * 1024, 1024, WPG, 1024, 1024, t, e);
        const EpiSimple<EPle> E{e}; const SchedPlain S{G, (int)blockIdx.x, 4, 1024, (const char*)X2B, (const char*)WPG}; pg8::gemm_phase(lds, S, E);
    }
    SEAM(9);
    if (IN(10)) {
        const float* g = p.in[I_LNF];
        for (int m = gw; m < MT; m += nw) {
            float* xr = X + (size_t)m * 1024;
            f32x4 v[4]; float s = 0.f;
#pragma unroll
            for (int j = 0; j < 4; ++j) { v[j] = *(const f32x4*)(xr + 4 * lane + 256 * j); s += (v[j][0] * v[j][0] + v[j][1] * v[j][1]) + (v[j][2] * v[j][2] + v[j][3] * v[j][3]); }
            const float r = rsqrtf(wave_sum(s) * (1.f / 1024.f) + NORM_EPS);
#pragma unroll
            for (int j = 0; j < 4; ++j) { const f32x4 gg = *(const f32x4*)(g + 4 * lane + 256 * j); *(f32x4*)(xr + 4 * lane + 256 * j) = v[j] * r * gg; }
        }
    }
#undef IN
#undef SEAM
}

#ifndef MK_N_LAUNCHES
#define MK_N_LAUNCHES 1
#endif
extern "C" void kernel_launch(void* const* d_in, const int* in_sizes, int n_in, void* d_out, int out_size, void* d_ws, size_t ws_size, hipStream_t stream) {
    static int grid = 0;
    if (grid == 0) {
        if (n_in != 24 || (size_t)out_size != O_END || ws_size < WS_END) { fprintf(stderr, "kernel_launch: unexpected problem shape (n_in %d out %d ws %zu)\n", n_in, out_size, ws_size); grid = -1; return; }
        int dev = 0, cus = 0, per_cu = 0;
        if (hipGetDevice(&dev) != hipSuccess || hipDeviceGetAttribute(&cus, hipDeviceAttributeMultiprocessorCount, dev) != hipSuccess) { grid = -1; return; }
        if (hipFuncSetAttribute((const void*)fwd_kernel, hipFuncAttributeMaxDynamicSharedMemorySize, LDS_BYTES) != hipSuccess) { fprintf(stderr, "kernel_launch: hipFuncSetAttribute failed\n"); grid = -1; return; }
        if (hipOccupancyMaxActiveBlocksPerMultiprocessor(&per_cu, (const void*)fwd_kernel, NTHREADS, LDS_BYTES) != hipSuccess || per_cu < 1) { fprintf(stderr, "kernel_launch: occupancy query failed (%d)\n", per_cu); (void)hipGetLastError(); per_cu = 1; }
        grid = cus * (per_cu < 1 ? 1 : (per_cu > 1 ? 1 : per_cu));
    }
    if (grid < 0) return;
    (void)hipMemsetAsync((char*)d_ws + WS_CTL, 0, CTL_ZERO_BYTES, stream);
    Params p{};
    for (int i = 0; i < 24; ++i) p.in[i] = (const float*)d_in[i];
    p.out = (float*)d_out; p.ws = (unsigned char*)d_ws;
#if MK_N_LAUNCHES == 1
    p.ph_lo = 0; p.ph_hi = NPHASE;
    void* args[] = {&p};
    hipError_t e = hipLaunchCooperativeKernel((const void*)fwd_kernel, dim3(grid), dim3(NTHREADS), args, LDS_BYTES, stream);
    if (e != hipSuccess) fprintf(stderr, "kernel_launch: cooperative launch failed: %s (grid %d)\n", hipGetErrorString(e), grid);
#else
    for (int k = 0; k < NPHASE; ++k) { p.ph_lo = k; p.ph_hi = k + 1; hipLaunchKernelGGL(fwd_kernel, dim3(grid), dim3(NTHREADS), LDS_BYTES, stream, p); }
#endif
}
```

```cpp
#include <hip/hip_runtime.h>
#include <hip/hip_cooperative_groups.h>
#include <cstdio>
#include <cstdint>
namespace cg = cooperative_groups;

#define LAS __attribute__((address_space(3)))
typedef unsigned short bf16;
typedef short bf16x8 __attribute__((ext_vector_type(8)));
typedef float f32x4 __attribute__((ext_vector_type(4)));
typedef float f32x2 __attribute__((ext_vector_type(2)));
typedef unsigned u32x4 __attribute__((ext_vector_type(4)));
typedef unsigned u32x2 __attribute__((ext_vector_type(2)));
typedef float f32x2_t_ __attribute__((ext_vector_type(2)));
typedef float f32x16 __attribute__((ext_vector_type(16)));

constexpr int D = 1024, NB = 8, SEQ = 2048, MP = NB * SEQ, SB = 32, MT = MP + SB, MPAD = 16640;
constexpr int NIN = 9728, DFF = 4096, DPLE = 256;
constexpr int NWAVES = 8, NTHREADS = NWAVES * 64;
constexpr int LDS_BYTES = 147456;
constexpr float NORM_EPS = 1e-6f;
constexpr float LOG2E = 1.4426950408889634f;
constexpr float QSCALE = 0.08838834764831845f * LOG2E;

constexpr size_t O_Y = 0;
constexpr size_t O_STP = (size_t)MT * 1024;
constexpr size_t O_KVP0 = O_STP + 524288;
constexpr size_t O_STS = O_KVP0 + 2 * 524288 + 2 * 2097152 + 2 * 8388608;
constexpr size_t O_KVS0 = O_STS + 2097152;
constexpr size_t O_END = O_KVS0 + 2 * 2097152 + 2 * 8388608 + 2 * 33554432;
static_assert(O_END == 129531904, "d_out size");
__host__ __device__ constexpr int win_of(int g) { return g == 0 ? 128 : (g == 1 ? 512 : 2048); }
__host__ __device__ constexpr int dil_of(int g) { return g == 0 ? 1 : (g == 1 ? 4 : 16); }
__host__ __device__ constexpr size_t okvp(int g, int isv) {
    return O_KVP0 + (g == 0 ? 0 : (g == 1 ? 2 * 524288 : 2 * 524288 + 2 * 2097152)) + (size_t)isv * (size_t)NB * win_of(g) * 512;
}
__host__ __device__ constexpr size_t okvs(int g, int isv) {
    return O_KVS0 + (g == 0 ? 0 : (g == 1 ? 2 * 2097152 : 2 * 2097152 + 2 * 8388608)) + (size_t)isv * (size_t)SB * win_of(g) * 512;
}

constexpr size_t MiB = 1u << 20;
constexpr size_t WS_CTL = 0, CTL_ZERO_BYTES = 1 * MiB;
constexpr size_t WS_ROPE = 1 * MiB;
constexpr size_t WS_BIAS = 1 * MiB + 640 * 1024;
constexpr size_t WS_DEC = 1 * MiB + 704 * 1024;
constexpr size_t WS_WIN = 2 * MiB;
constexpr size_t WS_WRB = 21 * MiB;
constexpr size_t WS_WAB = 23 * MiB;
constexpr size_t WS_WO = 24 * MiB;
constexpr size_t WS_WU = 26 * MiB;
constexpr size_t WS_WD = 34 * MiB;
constexpr size_t WS_WPL = 42 * MiB;
constexpr size_t WS_WPG = 43 * MiB;
constexpr size_t WS_RVS = 45 * MiB;
constexpr size_t WS_AVS = 45 * MiB + 64 * 1024;
constexpr size_t WS_ROS = 45 * MiB + 160 * 1024;
constexpr size_t WS_HN = 46 * MiB;
constexpr size_t WS_PB = 79 * MiB;
constexpr size_t WS_P = 88 * MiB;
constexpr size_t WS_RQ = 121 * MiB;
constexpr size_t WS_RK = 138 * MiB;
constexpr size_t WS_RVT = 155 * MiB;
constexpr size_t WS_RG = 188 * MiB;
constexpr size_t WS_AQ = 221 * MiB;
constexpr size_t WS_AK = 270 * MiB;
constexpr size_t WS_AVT = 319 * MiB;
constexpr size_t WS_SGR = 367 * MiB;
constexpr size_t WS_SGA = 400 * MiB;
constexpr size_t WS_OG = 433 * MiB;
constexpr size_t WS_LSE = 482 * MiB;
constexpr size_t WS_KT = 483 * MiB;
constexpr size_t WS_END = 499 * MiB;
static_assert(WS_AQ + (size_t)MT * 4096 * 2 <= WS_SGR, "U overlay");
static_assert((size_t)MT * 1024 * 2 <= 33 * MiB && (size_t)MT * 512 * 2 <= 17 * MiB && (size_t)MT * 1536 * 2 <= 49 * MiB, "slots");

__device__ __forceinline__ unsigned f2bf(float f) { unsigned u = __float_as_uint(f); return (u + 0x7fffu + ((u >> 16) & 1u)) >> 16; }
__device__ __forceinline__ float bf2f(unsigned b) { return __uint_as_float(b << 16); }
typedef __bf16 bf16x2_t __attribute__((ext_vector_type(2)));
__device__ __forceinline__ unsigned pk2(float lo, float hi) { const f32x2_t_ v = {lo, hi}; const bf16x2_t b = __builtin_convertvector(v, bf16x2_t); return __builtin_bit_cast(unsigned, b); }
__device__ __forceinline__ float bflo(unsigned w) { return __uint_as_float(w << 16); }
__device__ __forceinline__ float bfhi(unsigned w) { return __uint_as_float(w & 0xffff0000u); }
__device__ __forceinline__ float wave_sum(float v) {
#pragma unroll
    for (int o = 1; o < 64; o <<= 1) v += __shfl_xor(v, o);
    return v;
}
__device__ __forceinline__ float wave_max(float v) {
#pragma unroll
    for (int o = 1; o < 64; o <<= 1) v = fmaxf(v, __shfl_xor(v, o));
    return v;
}
__device__ __forceinline__ float sigmoidf_(float v) { return 1.0f / (1.0f + __expf(-v)); }
__device__ __forceinline__ void st_bf4(bf16* p, f32x4 v) { u32x2 w; w.x = pk2(v[0], v[1]); w.y = pk2(v[2], v[3]); *(u32x2*)p = w; }
__device__ __forceinline__ f32x4 ld_bf4(const bf16* p) { const u32x2 w = *(const u32x2*)p; return (f32x4){bflo(w.x), bfhi(w.x), bflo(w.y), bfhi(w.y)}; }

struct Params {
    const float* in[24];
    float* out;
    unsigned char* ws;
    int ph_lo, ph_hi;
};
enum { I_XP = 0, I_XS, I_STATE, I_CK128, I_CV128, I_CK512, I_CV512, I_CK2K, I_CV2K, I_PP, I_PS, I_LN1, I_WIN, I_GN, I_WRB, I_WAB, I_WO, I_LN2, I_WU, I_WD, I_WPL, I_WPG, I_RELB, I_LNF };

__device__ __forceinline__ void st_bf8(bf16* p, f32x4 a, f32x4 b) { u32x4 w; w.x = pk2(a[0], a[1]); w.y = pk2(a[2], a[3]); w.z = pk2(b[0], b[1]); w.w = pk2(b[2], b[3]); *(u32x4*)p = w; }
__device__ __forceinline__ void ld_bf8(const bf16* p, f32x4& a, f32x4& b) { const u32x4 w = *(const u32x4*)p; a = (f32x4){bflo(w.x), bfhi(w.x), bflo(w.y), bfhi(w.y)}; b = (f32x4){bflo(w.z), bfhi(w.z), bflo(w.w), bfhi(w.w)}; }

namespace pg8 {
typedef bf16 bf16_t;
constexpr int BM = 256, BK = 64, HALF = 128, HTB = HALF * BK * 2, STAGE_BYTES = 8 * HTB, NXCD = 8, WGM = 8;
__host__ __device__ __forceinline__ int lds_byte(int r, int c) { const int st = (r >> 4) * 2 + (c >> 5), rr = r & 15, cc = c & 31, ob = rr * 64 + cc * 2; return st * 1024 + (ob ^ (((ob >> 9) & 1) << 5)); }
__host__ __device__ __forceinline__ void stage_rc(int b, int& R, int& C) { const int st = b / 1024, sb = b % 1024, swz = sb ^ (((sb >> 9) & 1) << 5); R = (st >> 1) * 16 + swz / 64; C = (st & 1) * 32 + (swz % 64) / 2; }
__host__ __device__ __forceinline__ int perm32(int rho) { const int n = rho >> 4, i = rho & 15; return 8 * (i >> 2) + 4 * n + (i & 3); }
struct Unit { const char* A; const char* B; int lda, ldb, nt, pm, pn, kind, keep; };
__device__ __forceinline__ void tile_of(int L, int nM, int nN, int& pm, int& pn) {
    const int nwg = nM * nN; int wgid = L; { const int q = nwg / NXCD, r = nwg % NXCD, xcd = wgid % NXCD, off = wgid / NXCD; wgid = (xcd < r ? xcd * (q + 1) : r * (q + 1) + (xcd - r) * q) + off; }
    const int nig = WGM * nN, gid = wgid / nig, fm = gid * WGM, gsz = (nM - fm) < WGM ? (nM - fm) : WGM;
    pm = fm + ((wgid % nig) % gsz); pn = (wgid % nig) / gsz;
}
template <class F> __device__ __forceinline__ void for_tile(f32x4 (&acc)[2][2][4][2], const Unit& u, int wr, int wc, int fr, int fq, const F& f) {
#pragma unroll
    for (int ai = 0; ai < 2; ++ai)
#pragma unroll
        for (int m = 0; m < 4; ++m) { const int row = u.pm * BM + ai * HALF + wr * 64 + m * 16 + fr;
#pragma unroll
            for (int bj = 0; bj < 2; ++bj) f(row, u.pn * BM + bj * HALF + wc * 32 + 8 * fq, acc[ai][bj][m][0], acc[ai][bj][m][1]); }
}
template <class Epi, class Sched>
__device__ __forceinline__ void gemm_phase(LAS unsigned char* lds, const Sched& S, const Epi& E) {
    const int tid = threadIdx.x, wid = __builtin_amdgcn_readfirstlane(tid >> 6), lane = tid & 63, wr = wid >> 2, wc = wid & 3, fr = lane & 15, fq = lane >> 4;
    unsigned RA[2], RB[2], CC[2];
#pragma unroll
    for (int i = 0; i < 2; ++i) { int R, C; stage_rc(tid * 16 + i * 8192, R, C); RA[i] = 2u * (unsigned)R; RB[i] = 2u * (unsigned)((R & ~31) + perm32(R & 31)); CC[i] = 2u * (unsigned)C; }
    const size_t kstep = (size_t)(BK * 2);
    const unsigned ldsw = (unsigned)wid * 1024u;
    const int aoff = lds_byte(wr * 64 + fr, fq * 8), boff = lds_byte(wc * 32 + fr, fq * 8);
#define PG8_SA(b, h) (((b) * 2 + (h)) * HTB)
#define PG8_SB(b, h) ((4 + (b) * 2 + (h)) * HTB)
#define PG8_STAGE(bufoff, gbase, RR, ld) do { _Pragma("unroll") for (int _i = 0; _i < 2; ++_i) \
        __builtin_amdgcn_global_load_lds((const unsigned*)((const char*)(gbase) + (RR[_i] * (unsigned)(ld) + CC[_i])), (LAS unsigned*)(lds + (bufoff) + ldsw + _i * 8192), 16, 0, 0); } while (0)
#define PG8_LDA(dst, b, h) do { _Pragma("unroll") for (int m = 0; m < 4; ++m) _Pragma("unroll") for (int k = 0; k < 2; ++k) dst[m][k] = *(const LAS bf16x8*)(lds + PG8_SA(b, h) + aoff + m * 2048 + k * 1024); } while (0)
#define PG8_LDB(dst, b, h) do { _Pragma("unroll") for (int n = 0; n < 2; ++n) _Pragma("unroll") for (int k = 0; k < 2; ++k) dst[n][k] = *(const LAS bf16x8*)(lds + PG8_SB(b, h) + boff + n * 2048 + k * 1024); } while (0)
#define PG8_MMA(ai, bj, At, Bt) do { __builtin_amdgcn_s_setprio(1); _Pragma("unroll") for (int m = 0; m < 4; ++m) _Pragma("unroll") for (int n = 0; n < 2; ++n) _Pragma("unroll") for (int k = 0; k < 2; ++k) \
        acc[ai][bj][m][n] = __builtin_amdgcn_mfma_f32_16x16x32_bf16(Bt[n][k], At[m][k], acc[ai][bj][m][n], 0, 0, 0); __builtin_amdgcn_s_setprio(0); } while (0)
#define PG8_WAIT_V(n) asm volatile("s_waitcnt vmcnt(" #n ")" ::: "memory")
#define PG8_WAIT_L(n) asm volatile("s_waitcnt lgkmcnt(" #n ")" ::: "memory")
#define PG8_BAR __builtin_amdgcn_s_barrier()
#define PG8_SCHED __builtin_amdgcn_sched_barrier(0)
    Unit cur, nxt; int ui = 0;
    if (!S.next(0, cur)) return;
    f32x4 acc[2][2][4][2];
#pragma unroll
    for (int a = 0; a < 2; ++a)
#pragma unroll
        for (int b = 0; b < 2; ++b)
#pragma unroll
            for (int m = 0; m < 4; ++m)
#pragma unroll
                for (int n = 0; n < 2; ++n) acc[a][b][m][n] = (f32x4){0.f, 0.f, 0.f, 0.f};
    bf16x8 At[4][2], B0[2][2], B1[2][2];
    int ldAc = cur.lda, ldBc = cur.ldb;
    const char* cA = cur.A; const char* cB = cur.B;
#define HA(ld) ((size_t)HALF * 2 * (size_t)(ld))
    PG8_STAGE(PG8_SB(0, 0), cB, RB, ldBc); PG8_STAGE(PG8_SB(0, 1), cB + HA(ldBc), RB, ldBc); PG8_STAGE(PG8_SA(0, 0), cA, RA, ldAc); PG8_STAGE(PG8_SA(0, 1), cA + HA(ldAc), RA, ldAc);
    if (wr == 1) PG8_BAR;
    PG8_WAIT_V(2); PG8_BAR;
    PG8_STAGE(PG8_SB(1, 0), cB + kstep, RB, ldBc); PG8_STAGE(PG8_SA(1, 0), cA + kstep, RA, ldAc); PG8_STAGE(PG8_SB(1, 1), cB + HA(ldBc) + kstep, RB, ldBc);
    PG8_WAIT_V(6); PG8_BAR;
    for (;;) {
        const bool has_next = S.next(ui + 1, nxt);
        const char* nA = cA; const char* nB = cB; int ldAn = ldAc, ldBn = ldBc;
        if (has_next) { nA = nxt.A; nB = nxt.B; ldAn = nxt.lda; ldBn = nxt.ldb; }
        const int nt = cur.nt;
        for (int t = 0; t < nt; t += 2) {
            const bool last = (t == nt - 2);
            const char* a1 = cA + (size_t)(t + 1) * kstep;
            const char* a2 = last ? nA : cA + (size_t)(t + 2) * kstep; const char* b2 = last ? nB : cB + (size_t)(t + 2) * kstep;
            const char* a3 = a2 + kstep; const char* b3 = b2 + kstep;
            const int ldA2 = last ? ldAn : ldAc, ldB2 = last ? ldBn : ldBc;
            PG8_LDB(B0, 0, 0); PG8_LDB(B1, 0, 1); PG8_SCHED; PG8_LDA(At, 0, 0); PG8_STAGE(PG8_SA(1, 1), a1 + HA(ldAc), RA, ldAc);
            PG8_WAIT_V(8); PG8_WAIT_L(0); PG8_BAR; PG8_MMA(0, 0, At, B0); PG8_MMA(0, 1, At, B1); PG8_BAR; PG8_SCHED;
            PG8_LDA(At, 0, 1); PG8_STAGE(PG8_SB(0, 0), b2, RB, ldB2); PG8_STAGE(PG8_SB(0, 1), b2 + HA(ldB2), RB, ldB2); PG8_STAGE(PG8_SA(0, 0), a2, RA, ldA2);
            PG8_WAIT_V(8); PG8_WAIT_L(0); PG8_BAR; PG8_MMA(1, 0, At, B0); PG8_MMA(1, 1, At, B1); PG8_BAR; PG8_SCHED;
            PG8_LDB(B0, 1, 0); PG8_LDB(B1, 1, 1); PG8_SCHED; PG8_LDA(At, 1, 0); PG8_STAGE(PG8_SA(0, 1), a2 + HA(ldA2), RA, ldA2);
            PG8_WAIT_V(8); PG8_WAIT_L(0); PG8_BAR; PG8_MMA(0, 0, At, B0); PG8_MMA(0, 1, At, B1); PG8_BAR; PG8_SCHED;
            PG8_LDA(At, 1, 1); PG8_STAGE(PG8_SB(1, 0), b3, RB, ldB2); PG8_STAGE(PG8_SB(1, 1), b3 + HA(ldB2), RB, ldB2); PG8_STAGE(PG8_SA(1, 0), a3, RA, ldA2);
            PG8_WAIT_V(8); PG8_WAIT_L(0); PG8_BAR; PG8_MMA(1, 0, At, B0); PG8_MMA(1, 1, At, B1); PG8_BAR; PG8_SCHED;
        }
        if (wr == 0) PG8_BAR;
        E(acc, cur, wr, wc, fr, fq);
        if (!has_next) break;
        if (!cur.keep) {
#pragma unroll
            for (int a = 0; a < 2; ++a)
#pragma unroll
                for (int b = 0; b < 2; ++b)
#pragma unroll
                    for (int m = 0; m < 4; ++m)
#pragma unroll
                        for (int n = 0; n < 2; ++n) acc[a][b][m][n] = (f32x4){0.f, 0.f, 0.f, 0.f};
        }
        cur = nxt; cA = nA; cB = nB; ldAc = ldAn; ldBc = ldBn; ++ui;
        if (wr == 1) PG8_BAR;
    }
    PG8_WAIT_V(0);
    PG8_BAR;
#undef PG8_SA
#undef PG8_SB
#undef PG8_STAGE
#undef PG8_LDA
#undef PG8_LDB
#undef PG8_MMA
#undef PG8_WAIT_V
#undef PG8_WAIT_L
#undef PG8_BAR
#undef PG8_SCHED
#undef HA
}
}

template <class F>
__device__ __forceinline__ void sample_tile(LAS unsigned char* lds, const bf16* __restrict__ A, int lda, const bf16* __restrict__ Bt, int ldb, int K, int tile, const F& f) {
    const int tid = threadIdx.x, lane = tid & 63, wave = tid >> 6, fr = lane & 15, fq = lane >> 4;
    f32x4 acc[2][4];
#pragma unroll
    for (int a = 0; a < 2; ++a)
#pragma unroll
        for (int b = 0; b < 4; ++b) acc[a][b] = (f32x4){0.f, 0.f, 0.f, 0.f};
    const int kw = K / 8;
    const bf16* ap = A + (size_t)fr * lda + wave * kw + fq * 8;
    const bf16* bp = Bt + (size_t)(tile * 64 + fr) * ldb + wave * kw + fq * 8;
    for (int k0 = 0; k0 < kw; k0 += 32) {
        bf16x8 a[2], b[4];
#pragma unroll
        for (int mi = 0; mi < 2; ++mi) a[mi] = *(const bf16x8*)(ap + (size_t)mi * 16 * lda + k0);
#pragma unroll
        for (int ni = 0; ni < 4; ++ni) b[ni] = *(const bf16x8*)(bp + (size_t)ni * 16 * ldb + k0);
#pragma unroll
        for (int mi = 0; mi < 2; ++mi)
#pragma unroll
            for (int ni = 0; ni < 4; ++ni) acc[mi][ni] = __builtin_amdgcn_mfma_f32_16x16x32_bf16(b[ni], a[mi], acc[mi][ni], 0, 0, 0);
    }
    LAS float* part = (LAS float*)lds;
#pragma unroll
    for (int mi = 0; mi < 2; ++mi)
#pragma unroll
        for (int ni = 0; ni < 4; ++ni) *(LAS f32x4*)(part + ((size_t)wave * 32 + mi * 16 + fr) * 68 + ni * 16 + fq * 4) = acc[mi][ni];
    __syncthreads();
    if (tid < 256) {
        const int row = tid >> 3, cg = (tid & 7) * 8;
        f32x4 v0 = (f32x4){0.f, 0.f, 0.f, 0.f}, v1 = v0;
#pragma unroll
        for (int w = 0; w < 8; ++w) { v0 += *(const LAS f32x4*)(part + ((size_t)w * 32 + row) * 68 + cg); v1 += *(const LAS f32x4*)(part + ((size_t)w * 32 + row) * 68 + cg + 4); }
        f(MP + row, tile * 64 + cg, v0, v1);
    }
    __syncthreads();
}

struct EIn {
    bf16 *RQ, *RK, *KT, *RVT, *RVS, *RG, *AQ, *AK, *AVT, *AVS, *SGR, *SGA; const f32x2* rope; const f32x2* dec; float* out;
    template <int SEG> __device__ __forceinline__ void seg(int row, int c, f32x4 v0, f32x4 v1) const {
        if (SEG == 0 || SEG == 1) {
            const int cc = c & 511, h = cc >> 6, tp = row < MP ? (row & (SEQ - 1)) : SEQ, i0 = (cc & 63) >> 1;
            const f32x4 r0 = *(const f32x4*)(rope + tp * 32 + i0), r1 = *(const f32x4*)(rope + tp * 32 + i0 + 2);
            const f32x2 dd = dec[h * 128 + (row < MP ? (row & 127) : 0)];
            const float sc = SEG == 1 ? 0.125f * dd.y : dd.x;
            f32x4 o0, o1;
            o0[0] = v0[0] * r0[0] - v0[1] * r0[1]; o0[1] = v0[0] * r0[1] + v0[1] * r0[0]; o0[2] = v0[2] * r0[2] - v0[3] * r0[3]; o0[3] = v0[2] * r0[3] + v0[3] * r0[2];
            o1[0] = v1[0] * r1[0] - v1[1] * r1[1]; o1[1] = v1[0] * r1[1] + v1[1] * r1[0]; o1[2] = v1[2] * r1[2] - v1[3] * r1[3]; o1[3] = v1[2] * r1[3] + v1[3] * r1[2];
            o0 *= sc; o1 *= sc;
            st_bf8((SEG == 1 ? RK : RQ) + (size_t)row * 512 + cc, o0, o1);
            if (SEG == 1 && row < MP) {
                bf16* d = KT + ((size_t)((row >> 11) * 8 + h) * 64 + (cc & 63)) * SEQ + (row & (SEQ - 1));
#pragma unroll
                for (int j = 0; j < 4; ++j) { d[(size_t)j * SEQ] = (bf16)f2bf(o0[j]); d[(size_t)(j + 4) * SEQ] = (bf16)f2bf(o1[j]); }
            }
        } else if (SEG == 2) {
            const int cc = c - 1024;
            if (row < MP) {
                bf16* d = RVT + ((size_t)((row >> 11) * 8 + (cc >> 7)) * 128 + (cc & 127)) * SEQ + (row & (SEQ - 1));
#pragma unroll
                for (int j = 0; j < 4; ++j) { d[(size_t)j * SEQ] = (bf16)f2bf(v0[j]); d[(size_t)(j + 4) * SEQ] = (bf16)f2bf(v1[j]); }
            } else st_bf8(RVS + (size_t)(row - MP) * 1024 + cc, v0, v1);
        } else if (SEG == 3) {
            f32x4 s0, s1;
#pragma unroll
            for (int j = 0; j < 4; ++j) { s0[j] = v0[j] * sigmoidf_(v0[j]); s1[j] = v1[j] * sigmoidf_(v1[j]); }
            st_bf8(RG + (size_t)row * 1024 + (c - 2048), s0, s1);
        } else if (SEG == 4) {
            st_bf8(AQ + (size_t)row * 1536 + (c - 3072), v0 * QSCALE, v1 * QSCALE);
        } else if (SEG == 5 || SEG == 6) {
            const int isv = SEG == 6; const int cc = c - (isv ? 6144 : 4608); const int g = cc >> 9, hc = cc & 511;
            const int W = win_of(g);
            float* dst = nullptr;
            if (row < MP) { const int t = row & (SEQ - 1), b = row >> 11; if (t >= SEQ - W) dst = out + okvp(g, isv) + ((size_t)(b * W + t - (SEQ - W)) * 512 + hc); }
            else { const int bs = row - MP; dst = out + okvs(g, isv) + ((size_t)(bs * W + (W - 1)) * 512 + hc); }
            if (dst) { *(f32x4*)dst = v0; *(f32x4*)(dst + 4) = v1; }
            if (!isv) st_bf8(AK + (size_t)row * 1536 + cc, v0, v1);
            else if (row < MP) {
                const int t = row & (SEQ - 1), b = row >> 11, sh = 2 * g;
                bf16* d = AVT + ((size_t)((b * 3 + g) * 4 + (hc >> 7)) * 128 + (hc & 127)) * SEQ + (size_t)(t & ((1 << sh) - 1)) * (SEQ >> sh) + (t >> sh);
#pragma unroll
                for (int j = 0; j < 4; ++j) { d[(size_t)j * SEQ] = (bf16)f2bf(v0[j]); d[(size_t)(j + 4) * SEQ] = (bf16)f2bf(v1[j]); }
            } else st_bf8(AVS + (size_t)(row - MP) * 1536 + cc, v0, v1);
        } else {
            f32x4 s0, s1;
#pragma unroll
            for (int j = 0; j < 4; ++j) { s0[j] = sigmoidf_(v0[j]); s1[j] = sigmoidf_(v1[j]); }
            st_bf8((SEG == 8 ? SGA : SGR) + (size_t)row * 1024 + (c - (SEG == 8 ? 8704 : 7680)), s0, s1);
        }
    }
    __device__ __forceinline__ static int seg_of(int c) { return c < 512 ? 0 : c < 1024 ? 1 : c < 2048 ? 2 : c < 3072 ? 3 : c < 4608 ? 4 : c < 6144 ? 5 : c < 7680 ? 6 : c < 8704 ? 7 : 8; }
    __device__ __forceinline__ void operator()(int row, int c, f32x4 v0, f32x4 v1) const {
        switch (seg_of(c)) { case 0: seg<0>(row, c, v0, v1); break; case 1: seg<1>(row, c, v0, v1); break; case 2: seg<2>(row, c, v0, v1); break; case 3: seg<3>(row, c, v0, v1); break;
            case 4: seg<4>(row, c, v0, v1); break; case 5: seg<5>(row, c, v0, v1); break; case 6: seg<6>(row, c, v0, v1); break; case 7: seg<7>(row, c, v0, v1); break; default: seg<8>(row, c, v0, v1); break; }
    }
};
struct EStoreBf { bf16* O; int ld; __device__ __forceinline__ void operator()(int row, int c, f32x4 v0, f32x4 v1) const { st_bf8(O + (size_t)row * ld + c, v0, v1); } };
struct EResIn {
    const float *xp, *xs; float* X;
    __device__ __forceinline__ void operator()(int row, int c, f32x4 v0, f32x4 v1) const {
        const float* src = row < MP ? xp + (size_t)row * 1024 + c : xs + (size_t)(row - MP) * 1024 + c; float* d = X + (size_t)row * 1024 + c;
        *(f32x4*)d = *(const f32x4*)src + v0; *(f32x4*)(d + 4) = *(const f32x4*)(src + 4) + v1;
    }
};
struct ERelu2 {
    bf16* U;
    __device__ __forceinline__ void operator()(int row, int c, f32x4 v0, f32x4 v1) const {
        f32x4 s0, s1;
#pragma unroll
        for (int j = 0; j < 4; ++j) { const float a = fmaxf(v0[j], 0.f), b = fmaxf(v1[j], 0.f); s0[j] = a * a; s1[j] = b * b; }
        st_bf8(U + (size_t)row * DFF + c, s0, s1);
    }
};
struct EResX {
    float* X; bf16* XB;
    __device__ __forceinline__ void operator()(int row, int c, f32x4 v0, f32x4 v1) const {
        float* p = X + (size_t)row * 1024 + c; const f32x4 o0 = *(const f32x4*)p + v0, o1 = *(const f32x4*)(p + 4) + v1; *(f32x4*)p = o0; *(f32x4*)(p + 4) = o1;
        st_bf8(XB + (size_t)row * 1024 + c, o0, o1);
    }
};
struct EPle {
    float* X; const bf16* P;
    __device__ __forceinline__ void operator()(int row, int c, f32x4 v0, f32x4 v1) const {
        float* p = X + (size_t)row * 1024 + c; f32x4 p0, p1; ld_bf8(P + (size_t)row * 1024 + c, p0, p1); f32x4 o0 = *(const f32x4*)p, o1 = *(const f32x4*)(p + 4);
#pragma unroll
        for (int j = 0; j < 4; ++j) { o0[j] += sigmoidf_(v0[j]) * p0[j]; o1[j] += sigmoidf_(v1[j]) * p1[j]; }
        *(f32x4*)p = o0; *(f32x4*)(p + 4) = o1;
    }
};

enum { K_IN = 0, K_P = 1, K_MIXA = 2, K_MIXB = 3 };
struct EpiG1 {
    EIn e; EStoreBf ep;
    __device__ __forceinline__ void operator()(f32x4 (&acc)[2][2][4][2], const pg8::Unit& u, int wr, int wc, int fr, int fq) const {
        if (u.kind == K_P) { pg8::for_tile(acc, u, wr, wc, fr, fq, [&](int r, int c, f32x4& a, f32x4& b) { ep(r, c, a, b); }); return; }
        switch (EIn::seg_of(u.pn * 256)) {
            case 0: pg8::for_tile(acc, u, wr, wc, fr, fq, [&](int r, int c, f32x4& a, f32x4& b) { e.seg<0>(r, c, a, b); }); break;
            case 1: pg8::for_tile(acc, u, wr, wc, fr, fq, [&](int r, int c, f32x4& a, f32x4& b) { e.seg<1>(r, c, a, b); }); break;
            case 2: pg8::for_tile(acc, u, wr, wc, fr, fq, [&](int r, int c, f32x4& a, f32x4& b) { e.seg<2>(r, c, a, b); }); break;
            case 3: pg8::for_tile(acc, u, wr, wc, fr, fq, [&](int r, int c, f32x4& a, f32x4& b) { e.seg<3>(r, c, a, b); }); break;
            case 4: pg8::for_tile(acc, u, wr, wc, fr, fq, [&](int r, int c, f32x4& a, f32x4& b) { e.seg<4>(r, c, a, b); }); break;
            case 5: pg8::for_tile(acc, u, wr, wc, fr, fq, [&](int r, int c, f32x4& a, f32x4& b) { e.seg<5>(r, c, a, b); }); break;
            case 6: pg8::for_tile(acc, u, wr, wc, fr, fq, [&](int r, int c, f32x4& a, f32x4& b) { e.seg<6>(r, c, a, b); }); break;
            case 7: pg8::for_tile(acc, u, wr, wc, fr, fq, [&](int r, int c, f32x4& a, f32x4& b) { e.seg<7>(r, c, a, b); }); break;
            default: pg8::for_tile(acc, u, wr, wc, fr, fq, [&](int r, int c, f32x4& a, f32x4& b) { e.seg<8>(r, c, a, b); }); break;
        }
    }
};
struct SchedG1 {
    int G, c; const char *HN, *WIN, *PB, *WPL;
    __device__ __forceinline__ bool next(int i, pg8::Unit& u) const {
        constexpr int NMAIN = 64 * 38;
        long L = (long)i * G + c;
        if (L >= NMAIN && G == 256 && i == 10) L = (long)i * G + ((c + 128) & 255);
        if (L < NMAIN) { int pm, pn; pg8::tile_of((int)L, 64, 38, pm, pn); u.A = HN + (size_t)pm * 256 * 1024 * 2; u.B = WIN + (size_t)pn * 256 * 1024 * 2; u.lda = 1024; u.ldb = 1024; u.nt = 16; u.pm = pm; u.pn = pn; u.kind = K_IN; u.keep = 0; return true; }
        L -= NMAIN; if (L >= 256) return false;
        const int pm = (int)(L >> 2), pn = (int)(L & 3);
        u.A = PB + (size_t)pm * 256 * DPLE * 2; u.B = WPL + (size_t)pn * 256 * DPLE * 2; u.lda = DPLE; u.ldb = DPLE; u.nt = 4; u.pm = pm; u.pn = pn; u.kind = K_P; u.keep = 0; return true;
    }
};
template <class F> struct EpiSimple {
    F f;
    __device__ __forceinline__ void operator()(f32x4 (&acc)[2][2][4][2], const pg8::Unit& u, int wr, int wc, int fr, int fq) const {
        pg8::for_tile(acc, u, wr, wc, fr, fq, [&](int r, int c, f32x4& a, f32x4& b) { f(r, c, a, b); });
    }
};
struct SchedPlain {
    int G, c, nN, K; const char *A, *B;
    __device__ __forceinline__ bool next(int i, pg8::Unit& u) const {
        const long L = (long)i * G + c; if (L >= 64 * nN) return false;
        int pm, pn; pg8::tile_of((int)L, 64, nN, pm, pn);
        u.A = A + (size_t)pm * 256 * K * 2; u.B = B + (size_t)pn * 256 * K * 2; u.lda = K; u.ldb = K; u.nt = K / 64; u.pm = pm; u.pn = pn; u.kind = 0; u.keep = 0; return true;
    }
};
struct EpiMix {
    const bf16 *SGR, *SGA; bf16* MIX;
    __device__ __forceinline__ void operator()(f32x4 (&acc)[2][2][4][2], const pg8::Unit& u, int wr, int wc, int fr, int fq) const {
        if (u.kind == K_MIXA) pg8::for_tile(acc, u, wr, wc, fr, fq, [&](int r, int c, f32x4& a, f32x4& b) {
            f32x4 r0, r1, a0, a1; ld_bf8(SGR + (size_t)r * 1024 + c, r0, r1); ld_bf8(SGA + (size_t)r * 1024 + c, a0, a1);
#pragma unroll
            for (int j = 0; j < 4; ++j) { a[j] *= r0[j] / a0[j]; b[j] *= r1[j] / a1[j]; } });
        else pg8::for_tile(acc, u, wr, wc, fr, fq, [&](int r, int c, f32x4& a, f32x4& b) {
            f32x4 a0, a1; ld_bf8(SGA + (size_t)r * 1024 + c, a0, a1); st_bf8(MIX + (size_t)r * 1024 + c, a * a0, b * a1); });
    }
};
struct SchedMix {
    int G, c; const char *ARET, *WRB, *AATT, *WAB;
    __device__ __forceinline__ bool next(int i, pg8::Unit& u) const {
        const int tile = (i >> 1) * G + c; if (tile >= 256) return false;
        int pm, pn; pg8::tile_of(tile, 64, 4, pm, pn); u.pm = pm; u.pn = pn;
        if ((i & 1) == 0) { u.A = ARET + (size_t)pm * 256 * 1024 * 2; u.B = WRB + (size_t)pn * 256 * 1024 * 2; u.lda = 1024; u.ldb = 1024; u.nt = 16; u.kind = K_MIXA; u.keep = 1; }
        else { u.A = AATT + (size_t)pm * 256 * 512 * 2; u.B = WAB + (size_t)pn * 256 * 512 * 2; u.lda = 512; u.ldb = 512; u.nt = 8; u.kind = K_MIXB; u.keep = 0; }
        return true;
    }
};

#define MFMA32(a, b, c) __builtin_amdgcn_mfma_f32_32x32x16_bf16((a), (b), (c), 0, 0, 0)
__device__ __forceinline__ bf16x8 pack8(const float* v) { u32x4 w; w.x = pk2(v[0], v[1]); w.y = pk2(v[2], v[3]); w.z = pk2(v[4], v[5]); w.w = pk2(v[6], v[7]); return __builtin_bit_cast(bf16x8, w); }
__device__ __forceinline__ bf16x8 ld_2x4(const bf16* p) { const u32x2 lo = *(const u32x2*)p, hi = *(const u32x2*)(p + 8); u32x4 w; w.x = lo.x; w.y = lo.y; w.z = hi.x; w.w = hi.y; return __builtin_bit_cast(bf16x8, w); }

__device__ __forceinline__ void attn_tile(int item, const bf16* __restrict__ AQ, const bf16* __restrict__ AK, const bf16* __restrict__ AVT, bf16* __restrict__ OG, float* __restrict__ LSE, const LAS float* biasl, int lane) {
    const int q32 = item & 3, idx16 = (item >> 2) & 15, h = (item >> 6) & 3, gb = item >> 8, b = gb & 7, g = gb >> 3;
    const int sh = 2 * g, dil = 1 << sh, L = SEQ >> sh, nbs = 4 - sh;
    const int s = idx16 >> nbs, q0 = (idx16 & ((1 << nbs) - 1)) * 128 + q32 * 32;
    const int r = lane & 31, hh = lane >> 5;
    const size_t rowbase = (size_t)b * SEQ + s;
    const int colq = g * 512 + h * 128 + hh * 8;
    bf16x8 qf[8];
    { const bf16* qp = AQ + (rowbase + (size_t)dil * (q0 + r)) * 1536 + colq;
#pragma unroll
      for (int ks = 0; ks < 8; ++ks) qf[ks] = *(const bf16x8*)(qp + ks * 16); }
    f32x16 O[4];
#pragma unroll
    for (int dt = 0; dt < 4; ++dt)
#pragma unroll
        for (int q = 0; q < 16; ++q) O[dt][q] = 0.f;
    float m = -INFINITY, l = 0.f;
    const LAS float* bl = biasl + (g * 4 + h) * 128;
    const bf16* vbase = AVT + ((size_t)((b * 3 + g) * 4 + h) * 128 + r) * SEQ + (size_t)s * L + 4 * hh;
    for (int kb = 0; kb < 5; ++kb) {
        const int kbase = q0 - 128 + 32 * kb;
        if (kbase < 0) continue;
        const bf16* kp = AK + (rowbase + (size_t)dil * (kbase + r)) * 1536 + colq;
        f32x16 S;
#pragma unroll
        for (int q = 0; q < 16; ++q) S[q] = 0.f;
#pragma unroll
        for (int ks = 0; ks < 8; ++ks) { const bf16x8 kf = *(const bf16x8*)(kp + ks * 16); S = MFMA32(kf, qf[ks], S); }
        const int jd0 = q0 + r - kbase - 4 * hh;
        float sv[16]; float mx = -INFINITY;
#pragma unroll
        for (int q = 0; q < 16; ++q) { const int jd = jd0 - ((q & 3) + 8 * (q >> 2)); const bool ok = (unsigned)jd <= 127u; const float bv = bl[ok ? jd : 0]; sv[q] = ok ? S[q] + bv : -INFINITY; mx = fmaxf(mx, sv[q]); }
        mx = fmaxf(mx, __shfl_xor(mx, 32));
        const float mn = fmaxf(m, mx), ms = (mn == -INFINITY) ? 0.f : mn;
        const float alpha = exp2f(m - ms);
        float rs = 0.f;
#pragma unroll
        for (int q = 0; q < 16; ++q) { sv[q] = exp2f(sv[q] - ms); rs += sv[q]; }
        rs += __shfl_xor(rs, 32);
        l = l * alpha + rs; m = mn;
#pragma unroll
        for (int dt = 0; dt < 4; ++dt) O[dt] *= alpha;
        const bf16x8 pb0 = pack8(sv), pb1 = pack8(sv + 8);
#pragma unroll
        for (int dt = 0; dt < 4; ++dt) {
            const bf16* vp = vbase + (size_t)dt * 32 * SEQ + kbase;
            O[dt] = MFMA32(ld_2x4(vp), pb0, O[dt]);
            O[dt] = MFMA32(ld_2x4(vp + 16), pb1, O[dt]);
        }
    }
    const float inv = 1.0f / l;
    const size_t row = rowbase + (size_t)dil * (q0 + r);
    bf16* op = OG + ((size_t)g * MT + row) * 512 + h * 128 + 4 * hh;
#pragma unroll
    for (int dt = 0; dt < 4; ++dt)
#pragma unroll
        for (int rg = 0; rg < 4; ++rg) st_bf4(op + dt * 32 + 8 * rg, (f32x4){O[dt][4 * rg] * inv, O[dt][4 * rg + 1] * inv, O[dt][4 * rg + 2] * inv, O[dt][4 * rg + 3] * inv});
    if (hh == 0) LSE[((size_t)g * MT + row) * 4 + h] = m + log2f(l);
}

__device__ __forceinline__ void ret_kv_tile(int item, const bf16* __restrict__ KT, const bf16* __restrict__ RVT, float* __restrict__ KV, const f32x2* __restrict__ dec, int lane) {
    const int vt = item & 3, c = (item >> 2) & 15, bh = item >> 6, h = bh & 7, r = lane & 31, hh = lane >> 5;
    const bf16* ka = KT + ((size_t)bh * 64 + r) * SEQ + c * 128 + hh * 8;
    const bf16* vb = RVT + ((size_t)bh * 128 + vt * 32 + r) * SEQ + c * 128 + hh * 8;
    f32x16 D0, D1;
#pragma unroll
    for (int q = 0; q < 16; ++q) { D0[q] = 0.f; D1[q] = 0.f; }
#pragma unroll
    for (int s = 0; s < 8; ++s) {
        const bf16x8 a0 = *(const bf16x8*)(ka + 16 * s), a1 = *(const bf16x8*)(ka + (size_t)32 * SEQ + 16 * s), bv = *(const bf16x8*)(vb + 16 * s);
        D0 = MFMA32(a0, bv, D0); D1 = MFMA32(a1, bv, D1);
    }
    const float g127 = dec[h * 128 + 127].x;
    float* o = KV + ((size_t)(bh * 16 + c) * 64) * 128 + vt * 32 + r;
#pragma unroll
    for (int q = 0; q < 16; ++q) { const int pq = (q & 3) + 8 * (q >> 2) + 4 * hh; o[(size_t)pq * 128] = D0[q] * g127; o[(size_t)(32 + pq) * 128] = D1[q] * g127; }
}

__device__ __forceinline__ void ret_out_tile(int item, const bf16* __restrict__ RQ, const bf16* __restrict__ RK, const bf16* __restrict__ RVT, const bf16* __restrict__ ST,
                                             const bf16* __restrict__ RG, const float* __restrict__ gn, bf16* __restrict__ ARET, int lane) {
    const int qb = item & 3, c = (item >> 2) & 15, bh = item >> 6, b = bh >> 3, h = bh & 7, r = lane & 31, hh = lane >> 5;
    const size_t row = (size_t)b * SEQ + c * 128 + qb * 32 + r;
    bf16x8 qf[4];
    { const bf16* qp = RQ + row * 512 + h * 64 + hh * 8;
#pragma unroll
      for (int ks = 0; ks < 4; ++ks) qf[ks] = *(const bf16x8*)(qp + ks * 16); }
    f32x16 O[4];
#pragma unroll
    for (int vt = 0; vt < 4; ++vt)
#pragma unroll
        for (int q = 0; q < 16; ++q) O[vt][q] = 0.f;
    const bf16* vbase = RVT + ((size_t)bh * 128 + r) * SEQ + c * 128 + 4 * hh;
    for (int kb = 0; kb <= qb; ++kb) {
        const bf16* kp = RK + ((size_t)b * SEQ + c * 128 + kb * 32 + r) * 512 + h * 64 + hh * 8;
        f32x16 X;
#pragma unroll
        for (int q = 0; q < 16; ++q) X[q] = 0.f;
#pragma unroll
        for (int ks = 0; ks < 4; ++ks) { const bf16x8 kf = *(const bf16x8*)(kp + ks * 16); X = MFMA32(kf, qf[ks], X); }
        float xv[16];
#pragma unroll
        for (int q = 0; q < 16; ++q) { const int kk = (q & 3) + 8 * (q >> 2) + 4 * hh; xv[q] = (kb == qb && kk > r) ? 0.f : X[q]; }
        const bf16x8 pb0 = pack8(xv), pb1 = pack8(xv + 8);
#pragma unroll
        for (int vt = 0; vt < 4; ++vt) {
            const bf16* vp = vbase + (size_t)vt * 32 * SEQ + kb * 32;
            O[vt] = MFMA32(ld_2x4(vp), pb0, O[vt]);
            O[vt] = MFMA32(ld_2x4(vp + 16), pb1, O[vt]);
        }
    }
    if (c > 0) {
        const bf16* sp = ST + (((size_t)bh * 16 + c) * 128 + r) * 64 + hh * 8;
#pragma unroll
        for (int ks = 0; ks < 4; ++ks)
#pragma unroll
            for (int vt = 0; vt < 4; ++vt) { const bf16x8 sf = *(const bf16x8*)(sp + (size_t)vt * 32 * 64 + ks * 16); O[vt] = MFMA32(sf, qf[ks], O[vt]); }
    }
    float sum = 0.f;
#pragma unroll
    for (int vt = 0; vt < 4; ++vt)
#pragma unroll
        for (int q = 0; q < 16; ++q) sum += O[vt][q];
    sum += __shfl_xor(sum, 32);
    const float mu = sum * (1.f / 128.f);
    float sq = 0.f;
#pragma unroll
    for (int vt = 0; vt < 4; ++vt)
#pragma unroll
        for (int q = 0; q < 16; ++q) { const float d = O[vt][q] - mu; sq += d * d; }
    sq += __shfl_xor(sq, 32);
    const float rstd = rsqrtf(sq * (1.f / 128.f) + NORM_EPS);
    const size_t ob = row * 1024 + h * 128 + 4 * hh;
#pragma unroll
    for (int vt = 0; vt < 4; ++vt)
#pragma unroll
        for (int rg = 0; rg < 4; ++rg) {
            const int vo = vt * 32 + 8 * rg;
            const f32x4 gate = ld_bf4(RG + ob + vo), gg = *(const f32x4*)(gn + h * 128 + 4 * hh + vo);
            f32x4 o;
#pragma unroll
            for (int j = 0; j < 4; ++j) o[j] = gate[j] * (O[vt][4 * rg + j] - mu) * rstd * gg[j];
            st_bf4(ARET + ob + vo, o);
        }
}

template <bool PERM>
__device__ __forceinline__ void transpose_item(const float* __restrict__ W, int K, int N, bf16* __restrict__ WT, LAS float* scr, int item, int lane) {
    const int nblk = N / 32, kb = item / nblk, nb = item % nblk, k0 = 64 * kb, n0 = 32 * nb;
    int srcc = n0 + (lane & 31);
    if (PERM && n0 < 1024) srcc = (n0 & ~63) + ((n0 & 32) >> 1) + ((lane & 31) >> 1) + 32 * (lane & 1);
#pragma unroll 8
    for (int i = 0; i < 32; ++i) { const int kk = 2 * i + (lane >> 5); scr[kk * 33 + (lane & 31)] = W[(size_t)(k0 + kk) * N + srcc]; }
    asm volatile("s_waitcnt lgkmcnt(0)" ::: "memory");
    const int c = lane & 7;
#pragma unroll
    for (int j = 0; j < 4; ++j) { const int n = (lane >> 3) + 8 * j; const LAS float* s = scr + (8 * c) * 33 + n;
        u32x4 o; o.x = pk2(s[0 * 33], s[1 * 33]); o.y = pk2(s[2 * 33], s[3 * 33]); o.z = pk2(s[4 * 33], s[5 * 33]); o.w = pk2(s[6 * 33], s[7 * 33]);
        *(u32x4*)(WT + (size_t)(n0 + n) * K + k0 + 8 * c) = o; }
    asm volatile("s_waitcnt lgkmcnt(0)" ::: "memory");
}
__device__ __forceinline__ void rms_row_to_bf16(const float* __restrict__ xrow, const float* __restrict__ g, bf16* __restrict__ orow, int lane) {
    f32x4 v[4]; float s = 0.f;
#pragma unroll
    for (int j = 0; j < 4; ++j) { v[j] = *(const f32x4*)(xrow + 4 * lane + 256 * j); s += (v[j][0] * v[j][0] + v[j][1] * v[j][1]) + (v[j][2] * v[j][2] + v[j][3] * v[j][3]); }
    const float r = rsqrtf(wave_sum(s) * (1.f / 1024.f) + NORM_EPS);
#pragma unroll
    for (int j = 0; j < 4; ++j) { const f32x4 gg = *(const f32x4*)(g + 4 * lane + 256 * j); st_bf4(orow + 4 * lane + 256 * j, v[j] * r * gg); }
}

constexpr int NPHASE = 12;
__global__ void __launch_bounds__(NTHREADS, 2) fwd_kernel(Params p) {
    extern __shared__ __attribute__((aligned(16))) unsigned char lds_raw[];
    LAS unsigned char* lds = (LAS unsigned char*)lds_raw;
    cg::grid_group grid = cg::this_grid();
    const int G = gridDim.x, nw = G * NWAVES;
    const size_t nthr = (size_t)G * NTHREADS;
#define PHASE_IDS int tid = threadIdx.x; asm volatile("" : "+v"(tid)); const int lane = tid & 63, wave = tid >> 6, gw = blockIdx.x * NWAVES + wave; const size_t gtid = (size_t)blockIdx.x * NTHREADS + tid; (void)lane; (void)wave; (void)gw; (void)gtid;
    unsigned char* ws = p.ws; float* out = p.out;
    const f32x2* rope = (const f32x2*)(ws + WS_ROPE);
    float* bias2 = (float*)(ws + WS_BIAS);
    const f32x2* dec = (const f32x2*)(ws + WS_DEC);
    bf16* WIN = (bf16*)(ws + WS_WIN); bf16* WRB = (bf16*)(ws + WS_WRB); bf16* WAB = (bf16*)(ws + WS_WAB); bf16* WO = (bf16*)(ws + WS_WO);
    bf16* WU = (bf16*)(ws + WS_WU); bf16* WD = (bf16*)(ws + WS_WD); bf16* WPL = (bf16*)(ws + WS_WPL); bf16* WPG = (bf16*)(ws + WS_WPG);
    bf16* HN = (bf16*)(ws + WS_HN); float* KV = (float*)(ws + WS_HN); bf16* ARET = HN; bf16* PB = (bf16*)(ws + WS_PB); bf16* P = (bf16*)(ws + WS_P);
    bf16* RQ = (bf16*)(ws + WS_RQ); bf16* RK = (bf16*)(ws + WS_RK); bf16* RVT = (bf16*)(ws + WS_RVT); bf16* MIX = RVT; bf16* KT = (bf16*)(ws + WS_KT);
    bf16* RVS = (bf16*)(ws + WS_RVS); bf16* AVS = (bf16*)(ws + WS_AVS); float* ROS = (float*)(ws + WS_ROS);
    bf16* RG = (bf16*)(ws + WS_RG); bf16* H2 = RG; bf16* AQ = (bf16*)(ws + WS_AQ); bf16* ST = AQ; bf16* AK = (bf16*)(ws + WS_AK); bf16* AATT = AK; bf16* AVT = (bf16*)(ws + WS_AVT); bf16* U = AQ;
    bf16* SGR = (bf16*)(ws + WS_SGR); bf16* X2B = SGR; bf16* SGA = (bf16*)(ws + WS_SGA); bf16* OG = (bf16*)(ws + WS_OG); float* LSE = (float*)(ws + WS_LSE);
    float* X = out + O_Y;
    const int lo = p.ph_lo, hi = p.ph_hi;
#define IN(k) (lo <= (k) && (k) < hi)
#define SEAM(k) do { if (IN(k) && IN((k) + 1)) grid.sync(); } while (0)

    if (IN(0)) { PHASE_IDS
        LAS float* scr = (LAS float*)(lds + wave * 16384);
        constexpr int I_IN = 16 * (NIN / 32), I_RB = 16 * 32, I_AB = 8 * 32, I_O = 16 * 32, I_U = 16 * 128, I_D = 64 * 32, I_PL = 4 * 32, I_PG = 16 * 32;
        constexpr int NITEMS = I_IN + I_RB + I_AB + I_O + I_U + I_D + I_PL + I_PG;
        for (int it = gw; it < NITEMS; it += nw) {
            int r = it;
            if (r < I_IN) { transpose_item<true>(p.in[I_WIN], 1024, NIN, WIN, scr, r, lane); continue; } r -= I_IN;
            if (r < I_RB) { transpose_item<false>(p.in[I_WRB], 1024, 1024, WRB, scr, r, lane); continue; } r -= I_RB;
            if (r < I_AB) { transpose_item<false>(p.in[I_WAB], 512, 1024, WAB, scr, r, lane); continue; } r -= I_AB;
            if (r < I_O) { transpose_item<false>(p.in[I_WO], 1024, 1024, WO, scr, r, lane); continue; } r -= I_O;
            if (r < I_U) { transpose_item<false>(p.in[I_WU], 1024, DFF, WU, scr, r, lane); continue; } r -= I_U;
            if (r < I_D) { transpose_item<false>(p.in[I_WD], DFF, 1024, WD, scr, r, lane); continue; } r -= I_D;
            if (r < I_PL) { transpose_item<false>(p.in[I_WPL], DPLE, 1024, WPL, scr, r, lane); continue; } r -= I_PL;
            transpose_item<false>(p.in[I_WPG], 1024, 1024, WPG, scr, r, lane);
        }
        for (int m = gw; m < MT; m += nw) {
            const float* xr = m < MP ? p.in[I_XP] + (size_t)m * 1024 : p.in[I_XS] + (size_t)(m - MP) * 1024;
            rms_row_to_bf16(xr, p.in[I_LN1], HN + (size_t)m * 1024, lane);
            const float* pr = m < MP ? p.in[I_PP] + (size_t)m * DPLE : p.in[I_PS] + (size_t)(m - MP) * DPLE;
            st_bf4(PB + (size_t)m * DPLE + 4 * lane, *(const f32x4*)(pr + 4 * lane));
        }
        for (size_t i = gtid; i < (size_t)2049 * 32; i += nthr) {
            const int tp = (int)(i >> 5), j = (int)(i & 31);
            const float pos = tp < SEQ ? (float)tp : 16384.0f;
            const float inv = exp2f(-(float)j * (13.287712379549449f / 32.0f));
            const float ang = pos * inv;
            double rev = (double)ang * 0.15915494309189535; rev -= floor(rev);
            const float rr = (float)(rev * 6.283185307179586 - 3.141592653589793);
            float sn, cs; __sincosf(rr, &sn, &cs);
            ((f32x2*)(ws + WS_ROPE))[i] = (f32x2){-cs, -sn};
        }
        for (size_t i = gtid; i < 12 * 128; i += nthr) {
            const int gh = (int)(i >> 7), j = (int)(i & 127), g = gh >> 2;
            const int d = j * dil_of(g);
            int bkt;
            if (d < 16) bkt = d;
            else { const float lr = logf((float)d / 16.0f) / 4.852030263919617f; bkt = 16 + (int)(lr * 16.0f); bkt = bkt < 31 ? bkt : 31; }
            bias2[i] = p.in[I_RELB][bkt * 12 + gh] * LOG2E;
        }
        for (size_t i = gtid; i < 8 * 128; i += nthr) {
            const int h = (int)(i >> 7), j = (int)(i & 127);
            const float lg = log2f(1.0f - exp2f(-5.0f - (float)h));
            ((f32x2*)(ws + WS_DEC))[i] = (f32x2){exp2f((float)j * lg), exp2f(-(float)j * lg)};
        }
        for (int a = 0; a < 6; ++a) {
            const int g = a >> 1, isv = a & 1, W = win_of(g);
            const f32x4* src = (const f32x4*)p.in[I_CK128 + a]; f32x4* dst = (f32x4*)(out + okvs(g, isv));
            const size_t per = (size_t)(W - 1) * 128, tot = per * SB;
            for (size_t i = gtid; i < tot; i += nthr) { const size_t bs = i / per, r = i - bs * per; dst[bs * (size_t)W * 128 + r] = src[bs * (size_t)W * 128 + 128 + r]; }
        }
    }
    SEAM(0);

    if (IN(1)) { PHASE_IDS
        const EIn e{RQ, RK, KT, RVT, RVS, RG, AQ, AK, AVT, AVS, SGR, SGA, rope, dec, out}; const EStoreBf ep{P, 1024};
        { const EpiG1 E{e, ep}; const SchedG1 S{G, (int)blockIdx.x, (const char*)HN, (const char*)WIN, (const char*)PB, (const char*)WPL}; pg8::gemm_phase(lds, S, E); }
        const int s0 = (G == 256) ? (int)blockIdx.x - 128 : (int)blockIdx.x, sn = (G == 256) ? 128 : G;
        if (s0 >= 0) for (int t = s0; t < 168; t += sn) {
            if (t < 152) sample_tile(lds, HN + (size_t)MP * 1024, 1024, WIN, 1024, 1024, t, e);
            else sample_tile(lds, PB + (size_t)MP * DPLE, DPLE, WPL, DPLE, DPLE, t - 152, ep);
        }
    }
    SEAM(1);

    if (IN(2)) { PHASE_IDS
        LAS float* biasl = (LAS float*)lds;
        for (int i = tid; i < 12 * 128; i += NTHREADS) biasl[i] = bias2[i];
        __syncthreads();
        for (int it = gw; it < 3 * NB * 4 * 16 * 4; it += nw) attn_tile(it, AQ, AK, AVT, OG, LSE, biasl, lane);
        for (int it = gw; it < NB * 8 * 16 * 4; it += nw) ret_kv_tile(it, KT, RVT, KV, dec, lane);
        for (size_t it = gtid; it < (size_t)SB * 8 * 128; it += nthr) {
            const int bs = (int)(it >> 10), h = (int)(it >> 7) & 7, v = (int)(it & 127);
            const float gamma = 1.0f - exp2f(-5.0f - (float)h);
            const size_t row = (size_t)MP + bs;
            const float vv = bf2f(RVS[(size_t)bs * 1024 + h * 128 + v]);
            const float* si = p.in[I_STATE] + ((size_t)(bs * 8 + h) * 64) * 128 + v;
            float* so = out + O_STS + ((size_t)(bs * 8 + h) * 64) * 128 + v;
            float o = 0.f;
            for (int k = 0; k < 64; ++k) {
                const int ko = (k >> 1) + 32 * (k & 1);
                const float s = gamma * si[(size_t)ko * 128] + bf2f(RK[row * 512 + h * 64 + k]) * vv;
                o += bf2f(RQ[row * 512 + h * 64 + k]) * s;
                so[(size_t)ko * 128] = s;
            }
            ROS[(size_t)bs * 1024 + h * 128 + v] = o;
        }
        LAS float* qs = (LAS float*)(lds + 8192 + wave * 512);
        for (int it = gw; it < 3 * SB * 4; it += nw) {
            const int g = it / (SB * 4), rem = it - g * (SB * 4), bs = rem >> 2, h = rem & 3, dil = dil_of(g), W = win_of(g);
            const size_t row = (size_t)MP + bs;
            const float* ck = p.in[I_CK128 + 2 * g] + (size_t)bs * W * 512 + h * 128;
            const float* cv = p.in[I_CV128 + 2 * g] + (size_t)bs * W * 512 + h * 128;
            const bf16* qp = AQ + row * 1536 + g * 512 + h * 128;
            { const unsigned w = *(const unsigned*)(qp + 2 * lane); qs[2 * lane] = bflo(w); qs[2 * lane + 1] = bfhi(w); }
            asm volatile("s_waitcnt lgkmcnt(0)" ::: "memory");
            float s[2];
#pragma unroll
            for (int hh = 0; hh < 2; ++hh) {
                const int j = lane + 64 * hh;
                float acc = 0.f;
                if (j == 0) {
                    const bf16* kp = AK + row * 1536 + g * 512 + h * 128;
                    for (int e = 0; e < 128; ++e) acc += bf2f(kp[e]) * qs[e];
                } else {
                    const f32x4* kp = (const f32x4*)(ck + (size_t)(W - j * dil) * 512);
                    for (int c4 = 0; c4 < 32; ++c4) { const f32x4 kv = kp[c4]; const f32x4 q0 = *(const LAS f32x4*)(qs + c4 * 4); acc += kv[0] * q0[0] + kv[1] * q0[1] + kv[2] * q0[2] + kv[3] * q0[3]; }
                }
                s[hh] = acc + biasl[(g * 4 + h) * 128 + j];
            }
            const float m = wave_max(fmaxf(s[0], s[1]));
            const float p0 = exp2f(s[0] - m), p1 = exp2f(s[1] - m);
            const float den = wave_sum(p0 + p1);
            float o0 = 0.f, o1 = 0.f;
            for (int j = 0; j < 128; ++j) {
                const float pj = __shfl(j < 64 ? p0 : p1, j & 63);
                float v0, v1;
                if (j == 0) { const unsigned w = *(const unsigned*)(AVS + (size_t)bs * 1536 + g * 512 + h * 128 + 2 * lane); v0 = bflo(w); v1 = bfhi(w); }
                else { const f32x2 vv = *(const f32x2*)(cv + (size_t)(W - j * dil) * 512 + 2 * lane); v0 = vv.x; v1 = vv.y; }
                o0 += pj * v0; o1 += pj * v1;
            }
            const float inv = 1.0f / den;
            *(unsigned*)(OG + ((size_t)g * MT + row) * 512 + h * 128 + 2 * lane) = pk2(o0 * inv, o1 * inv);
            if (lane == 0) LSE[((size_t)g * MT + row) * 4 + h] = m + log2f(den);
            asm volatile("s_waitcnt lgkmcnt(0)" ::: "memory");
        }
    }
    SEAM(2);

    if (IN(3)) { PHASE_IDS
        for (int it = gw; it < MT * 4; it += nw) {
            const int row = it >> 2, h = it & 3;
            const float l0 = LSE[((size_t)0 * MT + row) * 4 + h], l1 = LSE[((size_t)1 * MT + row) * 4 + h], l2 = LSE[((size_t)2 * MT + row) * 4 + h];
            const float mx = fmaxf(l0, fmaxf(l1, l2));
            const float w0 = exp2f(l0 - mx), w1 = exp2f(l1 - mx), w2 = exp2f(l2 - mx), inv = 1.0f / (w0 + w1 + w2);
            const size_t off = (size_t)row * 512 + h * 128 + 2 * lane;
            const unsigned a = *(const unsigned*)(OG + (size_t)0 * MT * 512 + off), b = *(const unsigned*)(OG + (size_t)1 * MT * 512 + off), c = *(const unsigned*)(OG + (size_t)2 * MT * 512 + off);
            *(unsigned*)(AATT + off) = pk2((w0 * bflo(a) + w1 * bflo(b) + w2 * bflo(c)) * inv, (w0 * bfhi(a) + w1 * bfhi(b) + w2 * bfhi(c)) * inv);
        }
        for (size_t it = gtid; it < (size_t)64 * 8 * 128; it += nthr) {
            const int v = (int)(it & 127), pc = (int)(it >> 7) & 7, bh = (int)(it >> 10), h = bh & 7;
            const float gamma = dec[h * 128 + 1].x, g128 = dec[h * 128 + 127].x * gamma;
            float S[8];
#pragma unroll
            for (int j = 0; j < 8; ++j) S[j] = 0.f;
            for (int c = 0; c < 16; ++c) {
                const float* kvp = KV + ((size_t)(bh * 16 + c) * 64 + pc * 8) * 128 + v;
#pragma unroll
                for (int j = 0; j < 8; ++j) S[j] = g128 * S[j] + kvp[(size_t)j * 128];
                if (c < 15) st_bf8(ST + (((size_t)bh * 16 + (c + 1)) * 128 + v) * 64 + pc * 8, (f32x4){gamma * S[0], gamma * S[1], gamma * S[2], gamma * S[3]}, (f32x4){gamma * S[4], gamma * S[5], gamma * S[6], gamma * S[7]});
            }
            float* so = out + O_STP + ((size_t)bh * 64) * 128 + v;
#pragma unroll
            for (int j = 0; j < 8; ++j) { const int pq = pc * 8 + j; so[(size_t)((pq >> 1) + 32 * (pq & 1)) * 128] = S[j]; }
        }
    }
    SEAM(3);

    if (IN(4)) { PHASE_IDS
        for (int it = gw; it < NB * 8 * 16 * 4; it += nw) ret_out_tile(it, RQ, RK, RVT, ST, RG, p.in[I_GN], ARET, lane);
        const float* gn = p.in[I_GN];
        for (int it = gw; it < SB * 8; it += nw) {
            const int bs = it >> 3, h = it & 7;
            const size_t base = (size_t)(MP + bs) * 1024 + h * 128, sb = (size_t)bs * 1024 + h * 128;
            const float x0 = ROS[sb + lane], x1 = ROS[sb + 64 + lane];
            const float mu = wave_sum(x0 + x1) * (1.f / 128.f);
            const float d0 = x0 - mu, d1 = x1 - mu;
            const float r = rsqrtf(wave_sum(d0 * d0 + d1 * d1) * (1.f / 128.f) + NORM_EPS);
            ARET[base + lane] = (bf16)f2bf(bf2f(RG[base + lane]) * d0 * r * gn[h * 128 + lane]);
            ARET[base + 64 + lane] = (bf16)f2bf(bf2f(RG[base + 64 + lane]) * d1 * r * gn[h * 128 + 64 + lane]);
        }
    }
    SEAM(4);

    if (IN(5)) {
        for (int t = blockIdx.x; t < 16; t += G) {
            f32x4 r0 = (f32x4){0.f, 0.f, 0.f, 0.f}, r1 = r0;
            sample_tile(lds, ARET + (size_t)MP * 1024, 1024, WRB, 1024, 1024, t, [&](int, int, f32x4 v0, f32x4 v1) { r0 = v0; r1 = v1; });
            sample_tile(lds, AATT + (size_t)MP * 512, 512, WAB, 512, 512, t, [&](int row, int c, f32x4 v0, f32x4 v1) {
                f32x4 g0, g1, a0, a1; ld_bf8(SGR + (size_t)row * 1024 + c, g0, g1); ld_bf8(SGA + (size_t)row * 1024 + c, a0, a1);
                st_bf8(MIX + (size_t)row * 1024 + c, g0 * r0 + a0 * v0, g1 * r1 + a1 * v1); });
        }
        const EpiMix E{SGR, SGA, MIX}; const SchedMix S{G, (int)blockIdx.x, (const char*)ARET, (const char*)WRB, (const char*)AATT, (const char*)WAB};
        pg8::gemm_phase(lds, S, E);
    }
    SEAM(5);
    if (IN(6)) {
        const EResIn e{p.in[I_XP], p.in[I_XS], X};
        for (int t = blockIdx.x; t < 16; t += G) sample_tile(lds, MIX + (size_t)MP * 1024, 1024, WO, 1024, 1024, t, e);
        const EpiSimple<EResIn> E{e}; const SchedPlain S{G, (int)blockIdx.x, 4, 1024, (const char*)MIX, (const char*)WO}; pg8::gemm_phase(lds, S, E);
    }
    SEAM(6);
    if (IN(7)) { PHASE_IDS for (int m = gw; m < MT; m += nw) rms_row_to_bf16(X + (size_t)m * 1024, p.in[I_LN2], H2 + (size_t)m * 1024, lane); }
    SEAM(7);
    if (IN(8)) {
        const ERelu2 e{U};
        for (int t = blockIdx.x; t < 64; t += G) sample_tile(lds, H2 + (size_t)MP * 1024, 1024, WU, 1024, 1024, t, e);
        const EpiSimple<ERelu2> E{e}; const SchedPlain S{G, (int)blockIdx.x, 16, 1024, (const char*)H2, (const char*)WU}; pg8::gemm_phase(lds, S, E);
    }
    SEAM(8);
    if (IN(9)) {
        const EResX e{X, X2B};
        for (int t = blockIdx.x; t < 16; t += G) sample_tile(lds, U + (size_t)MP * DFF, DFF, WD, DFF, DFF, t, e);
        const EpiSimple<EResX> E{e}; const SchedPlain S{G, (int)blockIdx.x, 4, DFF, (const char*)U, (const char*)WD}; pg8::gemm_phase(lds, S, E);
    }
    SEAM(9);
    if (IN(10)) {
        const EPle e{X, P};
        for (int t = blockIdx.x; t < 16; t += G) sample_tile(lds, X2B + (size_t)MP * 1024, 1024, WPG, 1024, 1024, t, e);
        const EpiSimple<EPle> E{e}; const SchedPlain S{G, (int)blockIdx.x, 4, 1024, (const char*)X2B, (const char*)WPG}; pg8::gemm_phase(lds, S, E);
    }
    SEAM(10);
    if (IN(11)) { PHASE_IDS
        const float* g = p.in[I_LNF];
        for (int m = gw; m < MT; m += nw) {
            float* xr = X + (size_t)m * 1024;
            f32x4 v[4]; float s = 0.f;
#pragma unroll
            for (int j = 0; j < 4; ++j) { v[j] = *(const f32x4*)(xr + 4 * lane + 256 * j); s += (v[j][0] * v[j][0] + v[j][1] * v[j][1]) + (v[j][2] * v[j][2] + v[j][3] * v[j][3]); }
            const float r = rsqrtf(wave_sum(s) * (1.f / 1024.f) + NORM_EPS);
#pragma unroll
            for (int j = 0; j < 4; ++j) { const f32x4 gg = *(const f32x4*)(g + 4 * lane + 256 * j); *(f32x4*)(xr + 4 * lane + 256 * j) = v[j] * r * gg; }
        }
    }
#undef IN
#undef SEAM
}

#ifndef MK_N_LAUNCHES
#define MK_N_LAUNCHES 1
#endif
extern "C" void kernel_launch(void* const* d_in, const int* in_sizes, int n_in, void* d_out, int out_size, void* d_ws, size_t ws_size, hipStream_t stream) {
    static int grid = 0;
    if (grid == 0) {
        if (n_in != 24 || (size_t)out_size != O_END || ws_size < WS_END) { fprintf(stderr, "kernel_launch: unexpected problem shape (n_in %d out %d ws %zu)\n", n_in, out_size, ws_size); grid = -1; return; }
        int dev = 0, cus = 0, per_cu = 0;
        if (hipGetDevice(&dev) != hipSuccess || hipDeviceGetAttribute(&cus, hipDeviceAttributeMultiprocessorCount, dev) != hipSuccess) { grid = -1; return; }
        if (hipFuncSetAttribute((const void*)fwd_kernel, hipFuncAttributeMaxDynamicSharedMemorySize, LDS_BYTES) != hipSuccess) { fprintf(stderr, "kernel_launch: hipFuncSetAttribute failed\n"); grid = -1; return; }
        if (hipOccupancyMaxActiveBlocksPerMultiprocessor(&per_cu, (const void*)fwd_kernel, NTHREADS, LDS_BYTES) != hipSuccess || per_cu < 1) { fprintf(stderr, "kernel_launch: occupancy query failed (%d)\n", per_cu); (void)hipGetLastError(); per_cu = 1; }
        grid = cus * (per_cu < 1 ? 1 : (per_cu > 1 ? 1 : per_cu));
    }
    if (grid < 0) return;
    (void)hipMemsetAsync((char*)d_ws + WS_CTL, 0, CTL_ZERO_BYTES, stream);
    Params p{};
    for (int i = 0; i < 24; ++i) p.in[i] = (const float*)d_in[i];
    p.out = (float*)d_out; p.ws = (unsigned char*)d_ws;
#if MK_N_LAUNCHES == 1
    p.ph_lo = 0; p.ph_hi = NPHASE;
    void* args[] = {&p};
    hipError_t e = hipLaunchCooperativeKernel((const void*)fwd_kernel, dim3(grid), dim3(NTHREADS), args, LDS_BYTES, stream);
    if (e != hipSuccess) fprintf(stderr, "kernel_launch: cooperative launch failed: %s (grid %d)\n", hipGetErrorString(e), grid);
#else
    for (int k = 0; k < NPHASE; ++k) { p.ph_lo = k; p.ph_hi = k + 1; hipLaunchKernelGGL(fwd_kernel, dim3(grid), dim3(NTHREADS), LDS_BYTES, stream, p); }
#endif
}
```

```cpp
#include <hip/hip_runtime.h>
#include <cstdio>
#include <cstdint>

#define LAS __attribute__((address_space(3)))
typedef unsigned short bf16;
typedef short bf16x8 __attribute__((ext_vector_type(8)));
typedef float f32x4 __attribute__((ext_vector_type(4)));
typedef float f32x2 __attribute__((ext_vector_type(2)));
typedef unsigned u32x4 __attribute__((ext_vector_type(4)));
typedef unsigned u32x2 __attribute__((ext_vector_type(2)));
typedef float f32x2_t_ __attribute__((ext_vector_type(2)));
typedef float f32x16 __attribute__((ext_vector_type(16)));

constexpr int D = 1024, NB = 8, SEQ = 2048, MP = NB * SEQ, SB = 32, MT = MP + SB, MPAD = 16640;
constexpr int NIN = 9728, DFF = 4096, DPLE = 256;
constexpr int NWAVES = 8, NTHREADS = NWAVES * 64;
constexpr int LDS_BYTES = 147456;
constexpr float NORM_EPS = 1e-6f;
constexpr float LOG2E = 1.4426950408889634f;
constexpr float QSCALE = 0.08838834764831845f * LOG2E;

constexpr size_t O_Y = 0;
constexpr size_t O_STP = (size_t)MT * 1024;
constexpr size_t O_KVP0 = O_STP + 524288;
constexpr size_t O_STS = O_KVP0 + 2 * 524288 + 2 * 2097152 + 2 * 8388608;
constexpr size_t O_KVS0 = O_STS + 2097152;
constexpr size_t O_END = O_KVS0 + 2 * 2097152 + 2 * 8388608 + 2 * 33554432;
static_assert(O_END == 129531904, "d_out size");
__host__ __device__ constexpr int win_of(int g) { return g == 0 ? 128 : (g == 1 ? 512 : 2048); }
__host__ __device__ constexpr int dil_of(int g) { return g == 0 ? 1 : (g == 1 ? 4 : 16); }
__host__ __device__ constexpr size_t okvp(int g, int isv) {
    return O_KVP0 + (g == 0 ? 0 : (g == 1 ? 2 * 524288 : 2 * 524288 + 2 * 2097152)) + (size_t)isv * (size_t)NB * win_of(g) * 512;
}
__host__ __device__ constexpr size_t okvs(int g, int isv) {
    return O_KVS0 + (g == 0 ? 0 : (g == 1 ? 2 * 2097152 : 2 * 2097152 + 2 * 8388608)) + (size_t)isv * (size_t)SB * win_of(g) * 512;
}

constexpr size_t MiB = 1u << 20;
constexpr size_t WS_CTL = 0, CTL_ZERO_BYTES = 1 * MiB;
constexpr size_t WS_ROPE = 1 * MiB;
constexpr size_t WS_BIAS = 1 * MiB + 640 * 1024;
constexpr size_t WS_DEC = 1 * MiB + 704 * 1024;
constexpr size_t WS_WIN = 2 * MiB;
constexpr size_t WS_WRB = 21 * MiB;
constexpr size_t WS_WAB = 23 * MiB;
constexpr size_t WS_WO = 24 * MiB;
constexpr size_t WS_WU = 26 * MiB;
constexpr size_t WS_WD = 34 * MiB;
constexpr size_t WS_WPL = 42 * MiB;
constexpr size_t WS_WPG = 43 * MiB;
constexpr size_t WS_RVS = 45 * MiB;
constexpr size_t WS_AVS = 45 * MiB + 64 * 1024;
constexpr size_t WS_ROS = 45 * MiB + 160 * 1024;
constexpr size_t WS_HN = 46 * MiB;
constexpr size_t WS_PB = 79 * MiB;
constexpr size_t WS_P = 88 * MiB;
constexpr size_t WS_RQ = 121 * MiB;
constexpr size_t WS_RK = 138 * MiB;
constexpr size_t WS_RVT = 155 * MiB;
constexpr size_t WS_RG = 188 * MiB;
constexpr size_t WS_AQ = 221 * MiB;
constexpr size_t WS_AK = 270 * MiB;
constexpr size_t WS_AVT = 319 * MiB;
constexpr size_t WS_SGR = 367 * MiB;
constexpr size_t WS_SGA = 400 * MiB;
constexpr size_t WS_OG = 433 * MiB;
constexpr size_t WS_LSE = 482 * MiB;
constexpr size_t WS_KT = 483 * MiB;
constexpr size_t WS_END = 499 * MiB;
static_assert(WS_AQ + (size_t)MT * 4096 * 2 <= WS_SGR, "U overlay");
static_assert((size_t)MT * 1024 * 2 <= 33 * MiB && (size_t)MT * 512 * 2 <= 17 * MiB && (size_t)MT * 1536 * 2 <= 49 * MiB, "slots");

__device__ __forceinline__ unsigned f2bf(float f) { unsigned u = __float_as_uint(f); return (u + 0x7fffu + ((u >> 16) & 1u)) >> 16; }
__device__ __forceinline__ float bf2f(unsigned b) { return __uint_as_float(b << 16); }
typedef __bf16 bf16x2_t __attribute__((ext_vector_type(2)));
__device__ __forceinline__ unsigned pk2(float lo, float hi) { const f32x2_t_ v = {lo, hi}; const bf16x2_t b = __builtin_convertvector(v, bf16x2_t); return __builtin_bit_cast(unsigned, b); }
__device__ __forceinline__ float bflo(unsigned w) { return __uint_as_float(w << 16); }
__device__ __forceinline__ float bfhi(unsigned w) { return __uint_as_float(w & 0xffff0000u); }
__device__ __forceinline__ float wave_sum(float v) {
#pragma unroll
    for (int o = 1; o < 64; o <<= 1) v += __shfl_xor(v, o);
    return v;
}
__device__ __forceinline__ float wave_max(float v) {
#pragma unroll
    for (int o = 1; o < 64; o <<= 1) v = fmaxf(v, __shfl_xor(v, o));
    return v;
}
__device__ __forceinline__ float sigmoidf_(float v) { return 1.0f / (1.0f + __expf(-v)); }
__device__ __forceinline__ void st_bf4(bf16* p, f32x4 v) { u32x2 w; w.x = pk2(v[0], v[1]); w.y = pk2(v[2], v[3]); *(u32x2*)p = w; }
__device__ __forceinline__ f32x4 ld_bf4(const bf16* p) { const u32x2 w = *(const u32x2*)p; return (f32x4){bflo(w.x), bfhi(w.x), bflo(w.y), bfhi(w.y)}; }

struct Params {
    const float* in[24];
    float* out;
    unsigned char* ws;
    int ph_lo, ph_hi;
};
enum { I_XP = 0, I_XS, I_STATE, I_CK128, I_CV128, I_CK512, I_CV512, I_CK2K, I_CV2K, I_PP, I_PS, I_LN1, I_WIN, I_GN, I_WRB, I_WAB, I_WO, I_LN2, I_WU, I_WD, I_WPL, I_WPG, I_RELB, I_LNF };

__device__ __forceinline__ void st_bf8(bf16* p, f32x4 a, f32x4 b) { u32x4 w; w.x = pk2(a[0], a[1]); w.y = pk2(a[2], a[3]); w.z = pk2(b[0], b[1]); w.w = pk2(b[2], b[3]); *(u32x4*)p = w; }
__device__ __forceinline__ void ld_bf8(const bf16* p, f32x4& a, f32x4& b) { const u32x4 w = *(const u32x4*)p; a = (f32x4){bflo(w.x), bfhi(w.x), bflo(w.y), bfhi(w.y)}; b = (f32x4){bflo(w.z), bfhi(w.z), bflo(w.w), bfhi(w.w)}; }

namespace pg8 {
typedef bf16 bf16_t;
constexpr int BM = 256, BK = 64, HALF = 128, HTB = HALF * BK * 2, STAGE_BYTES = 8 * HTB, NXCD = 8, WGM = 8;
__host__ __device__ __forceinline__ int lds_byte(int r, int c) { const int st = (r >> 4) * 2 + (c >> 5), rr = r & 15, cc = c & 31, ob = rr * 64 + cc * 2; return st * 1024 + (ob ^ (((ob >> 9) & 1) << 5)); }
__host__ __device__ __forceinline__ void stage_rc(int b, int& R, int& C) { const int st = b / 1024, sb = b % 1024, swz = sb ^ (((sb >> 9) & 1) << 5); R = (st >> 1) * 16 + swz / 64; C = (st & 1) * 32 + (swz % 64) / 2; }
__host__ __device__ __forceinline__ int perm32(int rho) { const int n = rho >> 4, i = rho & 15; return 8 * (i >> 2) + 4 * n + (i & 3); }
struct Unit { const char* A; const char* B; int lda, ldb, nt, pm, pn, kind, keep; };
__device__ __forceinline__ void tile_of(int L, int nM, int nN, int& pm, int& pn) {
    const int nwg = nM * nN; int wgid = L; { const int q = nwg / NXCD, r = nwg % NXCD, xcd = wgid % NXCD, off = wgid / NXCD; wgid = (xcd < r ? xcd * (q + 1) : r * (q + 1) + (xcd - r) * q) + off; }
    const int nig = WGM * nN, gid = wgid / nig, fm = gid * WGM, gsz = (nM - fm) < WGM ? (nM - fm) : WGM;
    pm = fm + ((wgid % nig) % gsz); pn = (wgid % nig) / gsz;
}
template <class F> __device__ __forceinline__ void for_tile(f32x4 (&acc)[2][2][4][2], const Unit& u, int wr, int wc, int fr, int fq, const F& f) {
#pragma unroll
    for (int ai = 0; ai < 2; ++ai)
#pragma unroll
        for (int m = 0; m < 4; ++m) { const int row = u.pm * BM + ai * HALF + wr * 64 + m * 16 + fr;
#pragma unroll
            for (int bj = 0; bj < 2; ++bj) f(row, u.pn * BM + bj * HALF + wc * 32 + 8 * fq, acc[ai][bj][m][0], acc[ai][bj][m][1]); }
}
template <class Epi, class Sched>
__device__ __forceinline__ void gemm_phase(LAS unsigned char* lds, const Sched& S, const Epi& E) {
    const int tid = threadIdx.x, wid = __builtin_amdgcn_readfirstlane(tid >> 6), lane = tid & 63, wr = wid >> 2, wc = wid & 3, fr = lane & 15, fq = lane >> 4;
    unsigned RA[2], RB[2], CC[2];
#pragma unroll
    for (int i = 0; i < 2; ++i) { int R, C; stage_rc(tid * 16 + i * 8192, R, C); RA[i] = 2u * (unsigned)R; RB[i] = 2u * (unsigned)((R & ~31) + perm32(R & 31)); CC[i] = 2u * (unsigned)C; }
    const size_t kstep = (size_t)(BK * 2);
    const unsigned ldsw = (unsigned)wid * 1024u;
    const int aoff = lds_byte(wr * 64 + fr, fq * 8), boff = lds_byte(wc * 32 + fr, fq * 8);
#define PG8_SA(b, h) (((b) * 2 + (h)) * HTB)
#define PG8_SB(b, h) ((4 + (b) * 2 + (h)) * HTB)
#define PG8_STAGE(bufoff, gbase, RR, ld) do { _Pragma("unroll") for (int _i = 0; _i < 2; ++_i) \
        __builtin_amdgcn_global_load_lds((const unsigned*)((const char*)(gbase) + (RR[_i] * (unsigned)(ld) + CC[_i])), (LAS unsigned*)(lds + (bufoff) + ldsw + _i * 8192), 16, 0, 0); } while (0)
#define PG8_LDA(dst, b, h) do { _Pragma("unroll") for (int m = 0; m < 4; ++m) _Pragma("unroll") for (int k = 0; k < 2; ++k) dst[m][k] = *(const LAS bf16x8*)(lds + PG8_SA(b, h) + aoff + m * 2048 + k * 1024); } while (0)
#define PG8_LDB(dst, b, h) do { _Pragma("unroll") for (int n = 0; n < 2; ++n) _Pragma("unroll") for (int k = 0; k < 2; ++k) dst[n][k] = *(const LAS bf16x8*)(lds + PG8_SB(b, h) + boff + n * 2048 + k * 1024); } while (0)
#define PG8_MMA(ai, bj, At, Bt) do { __builtin_amdgcn_s_setprio(1); _Pragma("unroll") for (int m = 0; m < 4; ++m) _Pragma("unroll") for (int n = 0; n < 2; ++n) _Pragma("unroll") for (int k = 0; k < 2; ++k) \
        acc[ai][bj][m][n] = __builtin_amdgcn_mfma_f32_16x16x32_bf16(Bt[n][k], At[m][k], acc[ai][bj][m][n], 0, 0, 0); __builtin_amdgcn_s_setprio(0); } while (0)
#define PG8_WAIT_V(n) asm volatile("s_waitcnt vmcnt(" #n ")" ::: "memory")
#define PG8_WAIT_L(n) asm volatile("s_waitcnt lgkmcnt(" #n ")" ::: "memory")
#define PG8_BAR __builtin_amdgcn_s_barrier()
#define PG8_SCHED __builtin_amdgcn_sched_barrier(0)
    Unit cur, nxt; int ui = 0;
    if (!S.next(0, cur)) return;
    f32x4 acc[2][2][4][2];
#pragma unroll
    for (int a = 0; a < 2; ++a)
#pragma unroll
        for (int b = 0; b < 2; ++b)
#pragma unroll
            for (int m = 0; m < 4; ++m)
#pragma unroll
                for (int n = 0; n < 2; ++n) acc[a][b][m][n] = (f32x4){0.f, 0.f, 0.f, 0.f};
    bf16x8 At[4][2], B0[2][2], B1[2][2];
    int ldAc = cur.lda, ldBc = cur.ldb;
    const char* cA = cur.A; const char* cB = cur.B;
#define HA(ld) ((size_t)HALF * 2 * (size_t)(ld))
    PG8_STAGE(PG8_SB(0, 0), cB, RB, ldBc); PG8_STAGE(PG8_SB(0, 1), cB + HA(ldBc), RB, ldBc); PG8_STAGE(PG8_SA(0, 0), cA, RA, ldAc); PG8_STAGE(PG8_SA(0, 1), cA + HA(ldAc), RA, ldAc);
    if (wr == 1) PG8_BAR;
    PG8_WAIT_V(2); PG8_BAR;
    PG8_STAGE(PG8_SB(1, 0), cB + kstep, RB, ldBc); PG8_STAGE(PG8_SA(1, 0), cA + kstep, RA, ldAc); PG8_STAGE(PG8_SB(1, 1), cB + HA(ldBc) + kstep, RB, ldBc);
    PG8_WAIT_V(6); PG8_BAR;
    for (;;) {
        const bool has_next = S.next(ui + 1, nxt);
        const char* nA = cA; const char* nB = cB; int ldAn = ldAc, ldBn = ldBc;
        if (has_next) { nA = nxt.A; nB = nxt.B; ldAn = nxt.lda; ldBn = nxt.ldb; }
        const int nt = cur.nt;
        for (int t = 0; t < nt; t += 2) {
            const bool last = (t == nt - 2);
            const char* a1 = cA + (size_t)(t + 1) * kstep;
            const char* a2 = last ? nA : cA + (size_t)(t + 2) * kstep; const char* b2 = last ? nB : cB + (size_t)(t + 2) * kstep;
            const char* a3 = a2 + kstep; const char* b3 = b2 + kstep;
            const int ldA2 = last ? ldAn : ldAc, ldB2 = last ? ldBn : ldBc;
            PG8_LDB(B0, 0, 0); PG8_LDB(B1, 0, 1); PG8_SCHED; PG8_LDA(At, 0, 0); PG8_STAGE(PG8_SA(1, 1), a1 + HA(ldAc), RA, ldAc);
            PG8_WAIT_V(8); PG8_WAIT_L(0); PG8_BAR; PG8_MMA(0, 0, At, B0); PG8_MMA(0, 1, At, B1); PG8_BAR; PG8_SCHED;
            PG8_LDA(At, 0, 1); PG8_STAGE(PG8_SB(0, 0), b2, RB, ldB2); PG8_STAGE(PG8_SB(0, 1), b2 + HA(ldB2), RB, ldB2); PG8_STAGE(PG8_SA(0, 0), a2, RA, ldA2);
            PG8_WAIT_V(8); PG8_WAIT_L(0); PG8_BAR; PG8_MMA(1, 0, At, B0); PG8_MMA(1, 1, At, B1); PG8_BAR; PG8_SCHED;
            PG8_LDB(B0, 1, 0); PG8_LDB(B1, 1, 1); PG8_SCHED; PG8_LDA(At, 1, 0); PG8_STAGE(PG8_SA(0, 1), a2 + HA(ldA2), RA, ldA2);
            PG8_WAIT_V(8); PG8_WAIT_L(0); PG8_BAR; PG8_MMA(0, 0, At, B0); PG8_MMA(0, 1, At, B1); PG8_BAR; PG8_SCHED;
            PG8_LDA(At, 1, 1); PG8_STAGE(PG8_SB(1, 0), b3, RB, ldB2); PG8_STAGE(PG8_SB(1, 1), b3 + HA(ldB2), RB, ldB2); PG8_STAGE(PG8_SA(1, 0), a3, RA, ldA2);
            PG8_WAIT_V(8); PG8_WAIT_L(0); PG8_BAR; PG8_MMA(1, 0, At, B0); PG8_MMA(1, 1, At, B1); PG8_BAR; PG8_SCHED;
        }
        if (wr == 0) PG8_BAR;
        E(acc, cur, wr, wc, fr, fq);
        if (!has_next) break;
        if (!cur.keep) {
#pragma unroll
            for (int a = 0; a < 2; ++a)
#pragma unroll
                for (int b = 0; b < 2; ++b)
#pragma unroll
                    for (int m = 0; m < 4; ++m)
#pragma unroll
                        for (int n = 0; n < 2; ++n) acc[a][b][m][n] = (f32x4){0.f, 0.f, 0.f, 0.f};
        }
        cur = nxt; cA = nA; cB = nB; ldAc = ldAn; ldBc = ldBn; ++ui;
        if (wr == 1) PG8_BAR;
    }
    PG8_WAIT_V(0);
    PG8_BAR;
#undef PG8_SA
#undef PG8_SB
#undef PG8_STAGE
#undef PG8_LDA
#undef PG8_LDB
#undef PG8_MMA
#undef PG8_WAIT_V
#undef PG8_WAIT_L
#undef PG8_BAR
#undef PG8_SCHED
#undef HA
}
}

template <class F>
__device__ __forceinline__ void sample_tile(LAS unsigned char* lds, const bf16* __restrict__ A, int lda, const bf16* __restrict__ Bt, int ldb, int K, int tile, const F& f) {
    const int tid = threadIdx.x, lane = tid & 63, wave = tid >> 6, fr = lane & 15, fq = lane >> 4;
    f32x4 acc[2][4];
#pragma unroll
    for (int a = 0; a < 2; ++a)
#pragma unroll
        for (int b = 0; b < 4; ++b) acc[a][b] = (f32x4){0.f, 0.f, 0.f, 0.f};
    const int kw = K / 8;
    const bf16* ap = A + (size_t)fr * lda + wave * kw + fq * 8;
    const bf16* bp = Bt + (size_t)(tile * 64 + fr) * ldb + wave * kw + fq * 8;
    for (int k0 = 0; k0 < kw; k0 += 32) {
        bf16x8 a[2], b[4];
#pragma unroll
        for (int mi = 0; mi < 2; ++mi) a[mi] = *(const bf16x8*)(ap + (size_t)mi * 16 * lda + k0);
#pragma unroll
        for (int ni = 0; ni < 4; ++ni) b[ni] = *(const bf16x8*)(bp + (size_t)ni * 16 * ldb + k0);
#pragma unroll
        for (int mi = 0; mi < 2; ++mi)
#pragma unroll
            for (int ni = 0; ni < 4; ++ni) acc[mi][ni] = __builtin_amdgcn_mfma_f32_16x16x32_bf16(b[ni], a[mi], acc[mi][ni], 0, 0, 0);
    }
    LAS float* part = (LAS float*)lds;
#pragma unroll
    for (int mi = 0; mi < 2; ++mi)
#pragma unroll
        for (int ni = 0; ni < 4; ++ni) *(LAS f32x4*)(part + ((size_t)wave * 32 + mi * 16 + fr) * 68 + ni * 16 + fq * 4) = acc[mi][ni];
    __syncthreads();
    if (tid < 256) {
        const int row = tid >> 3, cg = (tid & 7) * 8;
        f32x4 v0 = (f32x4){0.f, 0.f, 0.f, 0.f}, v1 = v0;
#pragma unroll
        for (int w = 0; w < 8; ++w) { v0 += *(const LAS f32x4*)(part + ((size_t)w * 32 + row) * 68 + cg); v1 += *(const LAS f32x4*)(part + ((size_t)w * 32 + row) * 68 + cg + 4); }
        f(MP + row, tile * 64 + cg, v0, v1);
    }
    __syncthreads();
}

struct EIn {
    bf16 *RQ, *RK, *KT, *RVT, *RVS, *RG, *AQ, *AK, *AVT, *AVS, *SGR, *SGA; const f32x2* rope; const f32x2* dec; float* out;
    template <int SEG> __device__ __forceinline__ void seg(int row, int c, f32x4 v0, f32x4 v1) const {
        if (SEG == 0 || SEG == 1) {
            const int cc = c & 511, h = cc >> 6, tp = row < MP ? (row & (SEQ - 1)) : SEQ, i0 = (cc & 63) >> 1;
            const f32x4 r0 = *(const f32x4*)(rope + tp * 32 + i0), r1 = *(const f32x4*)(rope + tp * 32 + i0 + 2);
            const f32x2 dd = dec[h * 128 + (row < MP ? (row & 127) : 0)];
            const float sc = SEG == 1 ? 0.125f * dd.y : dd.x;
            f32x4 o0, o1;
            o0[0] = v0[0] * r0[0] - v0[1] * r0[1]; o0[1] = v0[0] * r0[1] + v0[1] * r0[0]; o0[2] = v0[2] * r0[2] - v0[3] * r0[3]; o0[3] = v0[2] * r0[3] + v0[3] * r0[2];
            o1[0] = v1[0] * r1[0] - v1[1] * r1[1]; o1[1] = v1[0] * r1[1] + v1[1] * r1[0]; o1[2] = v1[2] * r1[2] - v1[3] * r1[3]; o1[3] = v1[2] * r1[3] + v1[3] * r1[2];
            o0 *= sc; o1 *= sc;
            st_bf8((SEG == 1 ? RK : RQ) + (size_t)row * 512 + cc, o0, o1);
            if (SEG == 1 && row < MP) {
                bf16* d = KT + ((size_t)((row >> 11) * 8 + h) * 64 + (cc & 63)) * SEQ + (row & (SEQ - 1));
#pragma unroll
                for (int j = 0; j < 4; ++j) { d[(size_t)j * SEQ] = (bf16)f2bf(o0[j]); d[(size_t)(j + 4) * SEQ] = (bf16)f2bf(o1[j]); }
            }
        } else if (SEG == 2) {
            const int cc = c - 1024;
            if (row < MP) {
                bf16* d = RVT + ((size_t)((row >> 11) * 8 + (cc >> 7)) * 128 + (cc & 127)) * SEQ + (row & (SEQ - 1));
#pragma unroll
                for (int j = 0; j < 4; ++j) { d[(size_t)j * SEQ] = (bf16)f2bf(v0[j]); d[(size_t)(j + 4) * SEQ] = (bf16)f2bf(v1[j]); }
            } else st_bf8(RVS + (size_t)(row - MP) * 1024 + cc, v0, v1);
        } else if (SEG == 3) {
            f32x4 s0, s1;
#pragma unroll
            for (int j = 0; j < 4; ++j) { s0[j] = v0[j] * sigmoidf_(v0[j]); s1[j] = v1[j] * sigmoidf_(v1[j]); }
            st_bf8(RG + (size_t)row * 1024 + (c - 2048), s0, s1);
        } else if (SEG == 4) {
            st_bf8(AQ + (size_t)row * 1536 + (c - 3072), v0 * QSCALE, v1 * QSCALE);
        } else if (SEG == 5 || SEG == 6) {
            const int isv = SEG == 6; const int cc = c - (isv ? 6144 : 4608); const int g = cc >> 9, hc = cc & 511;
            const int W = win_of(g);
            float* dst = nullptr;
            if (row < MP) { const int t = row & (SEQ - 1), b = row >> 11; if (t >= SEQ - W) dst = out + okvp(g, isv) + ((size_t)(b * W + t - (SEQ - W)) * 512 + hc); }
            else { const int bs = row - MP; dst = out + okvs(g, isv) + ((size_t)(bs * W + (W - 1)) * 512 + hc); }
            if (dst) { *(f32x4*)dst = v0; *(f32x4*)(dst + 4) = v1; }
            if (!isv) st_bf8(AK + (size_t)row * 1536 + cc, v0, v1);
            else if (row < MP) {
                const int t = row & (SEQ - 1), b = row >> 11, sh = 2 * g;
                bf16* d = AVT + ((size_t)((b * 3 + g) * 4 + (hc >> 7)) * 128 + (hc & 127)) * SEQ + (size_t)(t & ((1 << sh) - 1)) * (SEQ >> sh) + (t >> sh);
#pragma unroll
                for (int j = 0; j < 4; ++j) { d[(size_t)j * SEQ] = (bf16)f2bf(v0[j]); d[(size_t)(j + 4) * SEQ] = (bf16)f2bf(v1[j]); }
            } else st_bf8(AVS + (size_t)(row - MP) * 1536 + cc, v0, v1);
        } else {
            f32x4 s0, s1;
#pragma unroll
            for (int j = 0; j < 4; ++j) { s0[j] = sigmoidf_(v0[j]); s1[j] = sigmoidf_(v1[j]); }
            st_bf8((SEG == 8 ? SGA : SGR) + (size_t)row * 1024 + (c - (SEG == 8 ? 8704 : 7680)), s0, s1);
        }
    }
    __device__ __forceinline__ static int seg_of(int c) { return c < 512 ? 0 : c < 1024 ? 1 : c < 2048 ? 2 : c < 3072 ? 3 : c < 4608 ? 4 : c < 6144 ? 5 : c < 7680 ? 6 : c < 8704 ? 7 : 8; }
    __device__ __forceinline__ void operator()(int row, int c, f32x4 v0, f32x4 v1) const {
        switch (seg_of(c)) { case 0: seg<0>(row, c, v0, v1); break; case 1: seg<1>(row, c, v0, v1); break; case 2: seg<2>(row, c, v0, v1); break; case 3: seg<3>(row, c, v0, v1); break;
            case 4: seg<4>(row, c, v0, v1); break; case 5: seg<5>(row, c, v0, v1); break; case 6: seg<6>(row, c, v0, v1); break; case 7: seg<7>(row, c, v0, v1); break; default: seg<8>(row, c, v0, v1); break; }
    }
};
struct EStoreBf { bf16* O; int ld; __device__ __forceinline__ void operator()(int row, int c, f32x4 v0, f32x4 v1) const { st_bf8(O + (size_t)row * ld + c, v0, v1); } };
struct EResIn {
    const float *xp, *xs; float* X;
    __device__ __forceinline__ void operator()(int row, int c, f32x4 v0, f32x4 v1) const {
        const float* src = row < MP ? xp + (size_t)row * 1024 + c : xs + (size_t)(row - MP) * 1024 + c; float* d = X + (size_t)row * 1024 + c;
        *(f32x4*)d = *(const f32x4*)src + v0; *(f32x4*)(d + 4) = *(const f32x4*)(src + 4) + v1;
    }
};
struct ERelu2 {
    bf16* U;
    __device__ __forceinline__ void operator()(int row, int c, f32x4 v0, f32x4 v1) const {
        f32x4 s0, s1;
#pragma unroll
        for (int j = 0; j < 4; ++j) { const float a = fmaxf(v0[j], 0.f), b = fmaxf(v1[j], 0.f); s0[j] = a * a; s1[j] = b * b; }
        st_bf8(U + (size_t)row * DFF + c, s0, s1);
    }
};
struct EResX {
    float* X; bf16* XB;
    __device__ __forceinline__ void operator()(int row, int c, f32x4 v0, f32x4 v1) const {
        float* p = X + (size_t)row * 1024 + c; const f32x4 o0 = *(const f32x4*)p + v0, o1 = *(const f32x4*)(p + 4) + v1; *(f32x4*)p = o0; *(f32x4*)(p + 4) = o1;
        st_bf8(XB + (size_t)row * 1024 + c, o0, o1);
    }
};
struct EPle {
    float* X; const bf16* P;
    __device__ __forceinline__ void operator()(int row, int c, f32x4 v0, f32x4 v1) const {
        float* p = X + (size_t)row * 1024 + c; f32x4 p0, p1; ld_bf8(P + (size_t)row * 1024 + c, p0, p1); f32x4 o0 = *(const f32x4*)p, o1 = *(const f32x4*)(p + 4);
#pragma unroll
        for (int j = 0; j < 4; ++j) { o0[j] += sigmoidf_(v0[j]) * p0[j]; o1[j] += sigmoidf_(v1[j]) * p1[j]; }
        *(f32x4*)p = o0; *(f32x4*)(p + 4) = o1;
    }
};

enum { K_IN = 0, K_P = 1, K_MIXA = 2, K_MIXB = 3 };
struct EpiG1 {
    EIn e; EStoreBf ep;
    __device__ __forceinline__ void operator()(f32x4 (&acc)[2][2][4][2], const pg8::Unit& u, int wr, int wc, int fr, int fq) const {
        if (u.kind == K_P) { pg8::for_tile(acc, u, wr, wc, fr, fq, [&](int r, int c, f32x4& a, f32x4& b) { ep(r, c, a, b); }); return; }
        switch (EIn::seg_of(u.pn * 256)) {
            case 0: pg8::for_tile(acc, u, wr, wc, fr, fq, [&](int r, int c, f32x4& a, f32x4& b) { e.seg<0>(r, c, a, b); }); break;
            case 1: pg8::for_tile(acc, u, wr, wc, fr, fq, [&](int r, int c, f32x4& a, f32x4& b) { e.seg<1>(r, c, a, b); }); break;
            case 2: pg8::for_tile(acc, u, wr, wc, fr, fq, [&](int r, int c, f32x4& a, f32x4& b) { e.seg<2>(r, c, a, b); }); break;
            case 3: pg8::for_tile(acc, u, wr, wc, fr, fq, [&](int r, int c, f32x4& a, f32x4& b) { e.seg<3>(r, c, a, b); }); break;
            case 4: pg8::for_tile(acc, u, wr, wc, fr, fq, [&](int r, int c, f32x4& a, f32x4& b) { e.seg<4>(r, c, a, b); }); break;
            case 5: pg8::for_tile(acc, u, wr, wc, fr, fq, [&](int r, int c, f32x4& a, f32x4& b) { e.seg<5>(r, c, a, b); }); break;
            case 6: pg8::for_tile(acc, u, wr, wc, fr, fq, [&](int r, int c, f32x4& a, f32x4& b) { e.seg<6>(r, c, a, b); }); break;
            case 7: pg8::for_tile(acc, u, wr, wc, fr, fq, [&](int r, int c, f32x4& a, f32x4& b) { e.seg<7>(r, c, a, b); }); break;
            default: pg8::for_tile(acc, u, wr, wc, fr, fq, [&](int r, int c, f32x4& a, f32x4& b) { e.seg<8>(r, c, a, b); }); break;
        }
    }
};
struct SchedG1 {
    int G, c; const char *HN, *WIN, *PB, *WPL;
    __device__ __forceinline__ bool next(int i, pg8::Unit& u) const {
        constexpr int NMAIN = 64 * 38;
        long L = (long)i * G + c;
        if (L >= NMAIN && G == 256 && i == 10) L = (long)i * G + ((c + 128) & 255);
        if (L < NMAIN) { int pm, pn; pg8::tile_of((int)L, 64, 38, pm, pn); u.A = HN + (size_t)pm * 256 * 1024 * 2; u.B = WIN + (size_t)pn * 256 * 1024 * 2; u.lda = 1024; u.ldb = 1024; u.nt = 16; u.pm = pm; u.pn = pn; u.kind = K_IN; u.keep = 0; return true; }
        L -= NMAIN; if (L >= 256) return false;
        const int pm = (int)(L >> 2), pn = (int)(L & 3);
        u.A = PB + (size_t)pm * 256 * DPLE * 2; u.B = WPL + (size_t)pn * 256 * DPLE * 2; u.lda = DPLE; u.ldb = DPLE; u.nt = 4; u.pm = pm; u.pn = pn; u.kind = K_P; u.keep = 0; return true;
    }
};
template <class F> struct EpiSimple {
    F f;
    __device__ __forceinline__ void operator()(f32x4 (&acc)[2][2][4][2], const pg8::Unit& u, int wr, int wc, int fr, int fq) const {
        pg8::for_tile(acc, u, wr, wc, fr, fq, [&](int r, int c, f32x4& a, f32x4& b) { f(r, c, a, b); });
    }
};
struct SchedPlain {
    int G, c, nN, K; const char *A, *B;
    __device__ __forceinline__ bool next(int i, pg8::Unit& u) const {
        const long L = (long)i * G + c; if (L >= 64 * nN) return false;
        int pm, pn; pg8::tile_of((int)L, 64, nN, pm, pn);
        u.A = A + (size_t)pm * 256 * K * 2; u.B = B + (size_t)pn * 256 * K * 2; u.lda = K; u.ldb = K; u.nt = K / 64; u.pm = pm; u.pn = pn; u.kind = 0; u.keep = 0; return true;
    }
};
struct EpiMix {
    const bf16 *SGR, *SGA; bf16* MIX;
    __device__ __forceinline__ void operator()(f32x4 (&acc)[2][2][4][2], const pg8::Unit& u, int wr, int wc, int fr, int fq) const {
        if (u.kind == K_MIXA) pg8::for_tile(acc, u, wr, wc, fr, fq, [&](int r, int c, f32x4& a, f32x4& b) {
            f32x4 r0, r1, a0, a1; ld_bf8(SGR + (size_t)r * 1024 + c, r0, r1); ld_bf8(SGA + (size_t)r * 1024 + c, a0, a1);
#pragma unroll
            for (int j = 0; j < 4; ++j) { a[j] *= r0[j] / a0[j]; b[j] *= r1[j] / a1[j]; } });
        else pg8::for_tile(acc, u, wr, wc, fr, fq, [&](int r, int c, f32x4& a, f32x4& b) {
            f32x4 a0, a1; ld_bf8(SGA + (size_t)r * 1024 + c, a0, a1); st_bf8(MIX + (size_t)r * 1024 + c, a * a0, b * a1); });
    }
};
struct SchedMix {
    int G, c; const char *ARET, *WRB, *AATT, *WAB;
    __device__ __forceinline__ bool next(int i, pg8::Unit& u) const {
        const int tile = (i >> 1) * G + c; if (tile >= 256) return false;
        int pm, pn; pg8::tile_of(tile, 64, 4, pm, pn); u.pm = pm; u.pn = pn;
        if ((i & 1) == 0) { u.A = ARET + (size_t)pm * 256 * 1024 * 2; u.B = WRB + (size_t)pn * 256 * 1024 * 2; u.lda = 1024; u.ldb = 1024; u.nt = 16; u.kind = K_MIXA; u.keep = 1; }
        else { u.A = AATT + (size_t)pm * 256 * 512 * 2; u.B = WAB + (size_t)pn * 256 * 512 * 2; u.lda = 512; u.ldb = 512; u.nt = 8; u.kind = K_MIXB; u.keep = 0; }
        return true;
    }
};

#define MFMA32(a, b, c) __builtin_amdgcn_mfma_f32_32x32x16_bf16((a), (b), (c), 0, 0, 0)
__device__ __forceinline__ bf16x8 pack8(const float* v) { u32x4 w; w.x = pk2(v[0], v[1]); w.y = pk2(v[2], v[3]); w.z = pk2(v[4], v[5]); w.w = pk2(v[6], v[7]); return __builtin_bit_cast(bf16x8, w); }
__device__ __forceinline__ bf16x8 ld_2x4(const bf16* p) { const u32x2 lo = *(const u32x2*)p, hi = *(const u32x2*)(p + 8); u32x4 w; w.x = lo.x; w.y = lo.y; w.z = hi.x; w.w = hi.y; return __builtin_bit_cast(bf16x8, w); }

__device__ __forceinline__ void attn_tile(int item, const bf16* __restrict__ AQ, const bf16* __restrict__ AK, const bf16* __restrict__ AVT, bf16* __restrict__ OG, float* __restrict__ LSE, const LAS float* biasl, int lane) {
    const int q32 = item & 3, idx16 = (item >> 2) & 15, h = (item >> 6) & 3, gb = item >> 8, b = gb & 7, g = gb >> 3;
    const int sh = 2 * g, dil = 1 << sh, L = SEQ >> sh, nbs = 4 - sh;
    const int s = idx16 >> nbs, q0 = (idx16 & ((1 << nbs) - 1)) * 128 + q32 * 32;
    const int r = lane & 31, hh = lane >> 5;
    const size_t rowbase = (size_t)b * SEQ + s;
    const int colq = g * 512 + h * 128 + hh * 8;
    bf16x8 qf[8];
    { const bf16* qp = AQ + (rowbase + (size_t)dil * (q0 + r)) * 1536 + colq;
#pragma unroll
      for (int ks = 0; ks < 8; ++ks) qf[ks] = *(const bf16x8*)(qp + ks * 16); }
    f32x16 O[4];
#pragma unroll
    for (int dt = 0; dt < 4; ++dt)
#pragma unroll
        for (int q = 0; q < 16; ++q) O[dt][q] = 0.f;
    float m = -INFINITY, l = 0.f;
    const LAS float* bl = biasl + (g * 4 + h) * 128;
    const bf16* vbase = AVT + ((size_t)((b * 3 + g) * 4 + h) * 128 + r) * SEQ + (size_t)s * L + 4 * hh;
    for (int kb = 0; kb < 5; ++kb) {
        const int kbase = q0 - 128 + 32 * kb;
        if (kbase < 0) continue;
        const bf16* kp = AK + (rowbase + (size_t)dil * (kbase + r)) * 1536 + colq;
        f32x16 S;
#pragma unroll
        for (int q = 0; q < 16; ++q) S[q] = 0.f;
#pragma unroll
        for (int ks = 0; ks < 8; ++ks) { const bf16x8 kf = *(const bf16x8*)(kp + ks * 16); S = MFMA32(kf, qf[ks], S); }
        const int jd0 = q0 + r - kbase - 4 * hh;
        float sv[16]; float mx = -INFINITY;
#pragma unroll
        for (int q = 0; q < 16; ++q) { const int jd = jd0 - ((q & 3) + 8 * (q >> 2)); const bool ok = (unsigned)jd <= 127u; const float bv = bl[ok ? jd : 0]; sv[q] = ok ? S[q] + bv : -INFINITY; mx = fmaxf(mx, sv[q]); }
        mx = fmaxf(mx, __shfl_xor(mx, 32));
        const float mn = fmaxf(m, mx), ms = (mn == -INFINITY) ? 0.f : mn;
        const float alpha = exp2f(m - ms);
        float rs = 0.f;
#pragma unroll
        for (int q = 0; q < 16; ++q) { sv[q] = exp2f(sv[q] - ms); rs += sv[q]; }
        rs += __shfl_xor(rs, 32);
        l = l * alpha + rs; m = mn;
#pragma unroll
        for (int dt = 0; dt < 4; ++dt) O[dt] *= alpha;
        const bf16x8 pb0 = pack8(sv), pb1 = pack8(sv + 8);
#pragma unroll
        for (int dt = 0; dt < 4; ++dt) {
            const bf16* vp = vbase + (size_t)dt * 32 * SEQ + kbase;
            O[dt] = MFMA32(ld_2x4(vp), pb0, O[dt]);
            O[dt] = MFMA32(ld_2x4(vp + 16), pb1, O[dt]);
        }
    }
    const float inv = 1.0f / l;
    const size_t row = rowbase + (size_t)dil * (q0 + r);
    bf16* op = OG + ((size_t)g * MT + row) * 512 + h * 128 + 4 * hh;
#pragma unroll
    for (int dt = 0; dt < 4; ++dt)
#pragma unroll
        for (int rg = 0; rg < 4; ++rg) st_bf4(op + dt * 32 + 8 * rg, (f32x4){O[dt][4 * rg] * inv, O[dt][4 * rg + 1] * inv, O[dt][4 * rg + 2] * inv, O[dt][4 * rg + 3] * inv});
    if (hh == 0) LSE[((size_t)g * MT + row) * 4 + h] = m + log2f(l);
}

__device__ __forceinline__ void ret_kv_tile(int item, const bf16* __restrict__ KT, const bf16* __restrict__ RVT, float* __restrict__ KV, const f32x2* __restrict__ dec, int lane) {
    const int vt = item & 3, c = (item >> 2) & 15, bh = item >> 6, h = bh & 7, r = lane & 31, hh = lane >> 5;
    const bf16* ka = KT + ((size_t)bh * 64 + r) * SEQ + c * 128 + hh * 8;
    const bf16* vb = RVT + ((size_t)bh * 128 + vt * 32 + r) * SEQ + c * 128 + hh * 8;
    f32x16 D0, D1;
#pragma unroll
    for (int q = 0; q < 16; ++q) { D0[q] = 0.f; D1[q] = 0.f; }
#pragma unroll
    for (int s = 0; s < 8; ++s) {
        const bf16x8 a0 = *(const bf16x8*)(ka + 16 * s), a1 = *(const bf16x8*)(ka + (size_t)32 * SEQ + 16 * s), bv = *(const bf16x8*)(vb + 16 * s);
        D0 = MFMA32(a0, bv, D0); D1 = MFMA32(a1, bv, D1);
    }
    const float g127 = dec[h * 128 + 127].x;
    float* o = KV + ((size_t)(bh * 16 + c) * 64) * 128 + vt * 32 + r;
#pragma unroll
    for (int q = 0; q < 16; ++q) { const int pq = (q & 3) + 8 * (q >> 2) + 4 * hh; o[(size_t)pq * 128] = D0[q] * g127; o[(size_t)(32 + pq) * 128] = D1[q] * g127; }
}

__device__ __forceinline__ void ret_out_tile(int item, const bf16* __restrict__ RQ, const bf16* __restrict__ RK, const bf16* __restrict__ RVT, const bf16* __restrict__ ST,
                                             const bf16* __restrict__ RG, const float* __restrict__ gn, bf16* __restrict__ ARET, int lane) {
    const int qb = item & 3, c = (item >> 2) & 15, bh = item >> 6, b = bh >> 3, h = bh & 7, r = lane & 31, hh = lane >> 5;
    const size_t row = (size_t)b * SEQ + c * 128 + qb * 32 + r;
    bf16x8 qf[4];
    { const bf16* qp = RQ + row * 512 + h * 64 + hh * 8;
#pragma unroll
      for (int ks = 0; ks < 4; ++ks) qf[ks] = *(const bf16x8*)(qp + ks * 16); }
    f32x16 O[4];
#pragma unroll
    for (int vt = 0; vt < 4; ++vt)
#pragma unroll
        for (int q = 0; q < 16; ++q) O[vt][q] = 0.f;
    const bf16* vbase = RVT + ((size_t)bh * 128 + r) * SEQ + c * 128 + 4 * hh;
    for (int kb = 0; kb <= qb; ++kb) {
        const bf16* kp = RK + ((size_t)b * SEQ + c * 128 + kb * 32 + r) * 512 + h * 64 + hh * 8;
        f32x16 X;
#pragma unroll
        for (int q = 0; q < 16; ++q) X[q] = 0.f;
#pragma unroll
        for (int ks = 0; ks < 4; ++ks) { const bf16x8 kf = *(const bf16x8*)(kp + ks * 16); X = MFMA32(kf, qf[ks], X); }
        float xv[16];
#pragma unroll
        for (int q = 0; q < 16; ++q) { const int kk = (q & 3) + 8 * (q >> 2) + 4 * hh; xv[q] = (kb == qb && kk > r) ? 0.f : X[q]; }
        const bf16x8 pb0 = pack8(xv), pb1 = pack8(xv + 8);
#pragma unroll
        for (int vt = 0; vt < 4; ++vt) {
            const bf16* vp = vbase + (size_t)vt * 32 * SEQ + kb * 32;
            O[vt] = MFMA32(ld_2x4(vp), pb0, O[vt]);
            O[vt] = MFMA32(ld_2x4(vp + 16), pb1, O[vt]);
        }
    }
    if (c > 0) {
        const bf16* sp = ST + (((size_t)bh * 16 + c) * 128 + r) * 64 + hh * 8;
#pragma unroll
        for (int ks = 0; ks < 4; ++ks)
#pragma unroll
            for (int vt = 0; vt < 4; ++vt) { const bf16x8 sf = *(const bf16x8*)(sp + (size_t)vt * 32 * 64 + ks * 16); O[vt] = MFMA32(sf, qf[ks], O[vt]); }
    }
    float sum = 0.f;
#pragma unroll
    for (int vt = 0; vt < 4; ++vt)
#pragma unroll
        for (int q = 0; q < 16; ++q) sum += O[vt][q];
    sum += __shfl_xor(sum, 32);
    const float mu = sum * (1.f / 128.f);
    float sq = 0.f;
#pragma unroll
    for (int vt = 0; vt < 4; ++vt)
#pragma unroll
        for (int q = 0; q < 16; ++q) { const float d = O[vt][q] - mu; sq += d * d; }
    sq += __shfl_xor(sq, 32);
    const float rstd = rsqrtf(sq * (1.f / 128.f) + NORM_EPS);
    const size_t ob = row * 1024 + h * 128 + 4 * hh;
#pragma unroll
    for (int vt = 0; vt < 4; ++vt)
#pragma unroll
        for (int rg = 0; rg < 4; ++rg) {
            const int vo = vt * 32 + 8 * rg;
            const f32x4 gate = ld_bf4(RG + ob + vo), gg = *(const f32x4*)(gn + h * 128 + 4 * hh + vo);
            f32x4 o;
#pragma unroll
            for (int j = 0; j < 4; ++j) o[j] = gate[j] * (O[vt][4 * rg + j] - mu) * rstd * gg[j];
            st_bf4(ARET + ob + vo, o);
        }
}

template <bool PERM>
__device__ __forceinline__ void transpose_item(const float* __restrict__ W, int K, int N, bf16* __restrict__ WT, LAS float* scr, int item, int lane) {
    const int nblk = N / 32, kb = item / nblk, nb = item % nblk, k0 = 64 * kb, n0 = 32 * nb;
    int srcc = n0 + (lane & 31);
    if (PERM && n0 < 1024) srcc = (n0 & ~63) + ((n0 & 32) >> 1) + ((lane & 31) >> 1) + 32 * (lane & 1);
#pragma unroll 8
    for (int i = 0; i < 32; ++i) { const int kk = 2 * i + (lane >> 5); scr[kk * 33 + (lane & 31)] = W[(size_t)(k0 + kk) * N + srcc]; }
    asm volatile("s_waitcnt lgkmcnt(0)" ::: "memory");
    const int c = lane & 7;
#pragma unroll
    for (int j = 0; j < 4; ++j) { const int n = (lane >> 3) + 8 * j; const LAS float* s = scr + (8 * c) * 33 + n;
        u32x4 o; o.x = pk2(s[0 * 33], s[1 * 33]); o.y = pk2(s[2 * 33], s[3 * 33]); o.z = pk2(s[4 * 33], s[5 * 33]); o.w = pk2(s[6 * 33], s[7 * 33]);
        *(u32x4*)(WT + (size_t)(n0 + n) * K + k0 + 8 * c) = o; }
    asm volatile("s_waitcnt lgkmcnt(0)" ::: "memory");
}
__device__ __forceinline__ void rms_row_to_bf16(const float* __restrict__ xrow, const float* __restrict__ g, bf16* __restrict__ orow, int lane) {
    f32x4 v[4]; float s = 0.f;
#pragma unroll
    for (int j = 0; j < 4; ++j) { v[j] = *(const f32x4*)(xrow + 4 * lane + 256 * j); s += (v[j][0] * v[j][0] + v[j][1] * v[j][1]) + (v[j][2] * v[j][2] + v[j][3] * v[j][3]); }
    const float r = rsqrtf(wave_sum(s) * (1.f / 1024.f) + NORM_EPS);
#pragma unroll
    for (int j = 0; j < 4; ++j) { const f32x4 gg = *(const f32x4*)(g + 4 * lane + 256 * j); st_bf4(orow + 4 * lane + 256 * j, v[j] * r * gg); }
}

#define XB_TMO      128
#define XB_XCNT(j)  (256  + 64 * (j))
#define XB_XSUB(j)  (1280 + 64 * (j))
#define XB_XGEN(j)  (2304 + 64 * (j))
#define XB_TOP      3328
#define XB_TOPGEN   3392
#define XCD_BAR_WORDS 3456
#define XB_SPIN_CAP (1u << 18)
__device__ __forceinline__ unsigned xb_ld(unsigned* p)              { return __hip_atomic_load(p, __ATOMIC_RELAXED, __HIP_MEMORY_SCOPE_AGENT); }
__device__ __forceinline__ unsigned xb_add(unsigned* p, unsigned v) { return __hip_atomic_fetch_add(p, v, __ATOMIC_RELAXED, __HIP_MEMORY_SCOPE_AGENT); }
__device__ __forceinline__ unsigned xb_xcc_id() { return (unsigned)__builtin_amdgcn_s_getreg((3 << 11) | 20) & 0xFu; }
#define XB_SPIN(cond, bar) do { unsigned _sp = 0; while (cond) { __builtin_amdgcn_s_sleep(1); \
    if ((++_sp & 255u) == 0u) { if (xb_ld(&(bar)[XB_TMO])) break; if (_sp > XB_SPIN_CAP) { atomicAdd(&(bar)[XB_TMO], 1u); break; } } } } while (0)
struct XcdBarrier { unsigned* bar; unsigned x; volatile LAS unsigned* st; };
__device__ __forceinline__ XcdBarrier xcd_barrier_post(unsigned* bar, volatile LAS unsigned* st) {
    XcdBarrier b; b.bar = bar; b.x = xb_xcc_id(); b.st = st;
    if (threadIdx.x == 0) (void)xb_add(&bar[XB_XCNT(b.x)], 1u);
    return b;
}
__device__ __forceinline__ void xcd_barrier_complete(unsigned* bar, unsigned x, unsigned& nloc, unsigned& nx) {
    const unsigned G = gridDim.x * gridDim.y * gridDim.z;
    unsigned sum, cnt, mine, sp = 0u;
    for (;;) {
        sum = 0u; cnt = 0u; mine = 0u;
#pragma unroll
        for (unsigned j = 0; j < 16; ++j) { const unsigned c = xb_ld(&bar[XB_XCNT(j)]); sum += c; cnt += (c > 0u) ? 1u : 0u; mine = (j == x) ? c : mine; }
        if (sum == G) break;
        __builtin_amdgcn_s_sleep(1);
        if ((++sp & 255u) == 0u) { if (xb_ld(&bar[XB_TMO])) break; if (sp > XB_SPIN_CAP) { atomicAdd(&bar[XB_TMO], 1u); break; } }
    }
    nloc = mine > 0u ? mine : 1u; nx = cnt > 0u ? cnt : 1u;
}
__device__ __forceinline__ void xcd_barrier(const XcdBarrier& b) {
    asm volatile("s_waitcnt vmcnt(0)" ::: "memory");
    __syncthreads();
    if (threadIdx.x == 0) {
        unsigned* bar = b.bar;
        __builtin_amdgcn_s_waitcnt(0);
        unsigned nloc = b.st[0], nx = b.st[1];
        if (nloc == 0u) { xcd_barrier_complete(bar, b.x, nloc, nx); b.st[0] = nloc; b.st[1] = nx; }
        const unsigned old = xb_add(&bar[XB_XSUB(b.x)], 1u);
        const unsigned gen = old / nloc;
        if (old + 1u == (gen + 1u) * nloc) {
            __builtin_amdgcn_fence(__ATOMIC_RELEASE, "agent");
            asm volatile("s_waitcnt vmcnt(0)" ::: "memory");
            const unsigned og = xb_add(&bar[XB_TOP], 1u);
            const unsigned tg = og / nx;
            if (og + 1u == (tg + 1u) * nx) xb_add(&bar[XB_TOPGEN], 1u);
            else XB_SPIN(xb_ld(&bar[XB_TOPGEN]) == tg, bar);
            __builtin_amdgcn_fence(__ATOMIC_ACQUIRE, "agent");
            xb_add(&bar[XB_XGEN(b.x)], 1u);
            asm volatile("s_waitcnt vmcnt(0)" ::: "memory");
        } else {
            XB_SPIN(xb_ld(&bar[XB_XGEN(b.x)]) == gen, bar);
            __builtin_amdgcn_fence(__ATOMIC_ACQUIRE, "agent");
            asm volatile("s_waitcnt vmcnt(0)" ::: "memory");
        }
    }
    __syncthreads();
}

constexpr int NPHASE = 12;
__global__ void __launch_bounds__(NTHREADS, 2) fwd_kernel(Params p) {
    extern __shared__ __attribute__((aligned(16))) unsigned char lds_raw[];
    LAS unsigned char* lds = (LAS unsigned char*)lds_raw;
    volatile LAS unsigned* bst = (volatile LAS unsigned*)(lds + 131072 + 1024);
    if (threadIdx.x == 0) { bst[0] = 0u; bst[1] = 0u; bst[2] = 0u; bst[3] = 0u; }
    __syncthreads();
    const XcdBarrier gbar = xcd_barrier_post((unsigned*)(p.ws + WS_CTL) + 4096, bst);
    const int G = gridDim.x, nw = G * NWAVES;
    const size_t nthr = (size_t)G * NTHREADS;
#define PHASE_IDS int tid = threadIdx.x; asm volatile("" : "+v"(tid)); const int lane = tid & 63, wave = tid >> 6, gw = blockIdx.x * NWAVES + wave; const size_t gtid = (size_t)blockIdx.x * NTHREADS + tid; (void)lane; (void)wave; (void)gw; (void)gtid;
    unsigned char* ws = p.ws; float* out = p.out;
    const f32x2* rope = (const f32x2*)(ws + WS_ROPE);
    float* bias2 = (float*)(ws + WS_BIAS);
    const f32x2* dec = (const f32x2*)(ws + WS_DEC);
    bf16* WIN = (bf16*)(ws + WS_WIN); bf16* WRB = (bf16*)(ws + WS_WRB); bf16* WAB = (bf16*)(ws + WS_WAB); bf16* WO = (bf16*)(ws + WS_WO);
    bf16* WU = (bf16*)(ws + WS_WU); bf16* WD = (bf16*)(ws + WS_WD); bf16* WPL = (bf16*)(ws + WS_WPL); bf16* WPG = (bf16*)(ws + WS_WPG);
    bf16* HN = (bf16*)(ws + WS_HN); float* KV = (float*)(ws + WS_HN); bf16* ARET = HN; bf16* PB = (bf16*)(ws + WS_PB); bf16* P = (bf16*)(ws + WS_P);
    bf16* RQ = (bf16*)(ws + WS_RQ); bf16* RK = (bf16*)(ws + WS_RK); bf16* RVT = (bf16*)(ws + WS_RVT); bf16* MIX = RVT; bf16* KT = (bf16*)(ws + WS_KT);
    bf16* RVS = (bf16*)(ws + WS_RVS); bf16* AVS = (bf16*)(ws + WS_AVS); float* ROS = (float*)(ws + WS_ROS);
    bf16* RG = (bf16*)(ws + WS_RG); bf16* H2 = RG; bf16* AQ = (bf16*)(ws + WS_AQ); bf16* ST = AQ; bf16* AK = (bf16*)(ws + WS_AK); bf16* AATT = AK; bf16* AVT = (bf16*)(ws + WS_AVT); bf16* U = AQ;
    bf16* SGR = (bf16*)(ws + WS_SGR); bf16* X2B = SGR; bf16* SGA = (bf16*)(ws + WS_SGA); bf16* OG = (bf16*)(ws + WS_OG); float* LSE = (float*)(ws + WS_LSE);
    float* X = out + O_Y;
    const int lo = p.ph_lo, hi = p.ph_hi;
#define IN(k) (lo <= (k) && (k) < hi)
#define SEAM(k) do { if (IN(k) && IN((k) + 1)) xcd_barrier(gbar); } while (0)

    if (IN(0)) { PHASE_IDS
        LAS float* scr = (LAS float*)(lds + wave * 16384);
        constexpr int I_IN = 16 * (NIN / 32), I_RB = 16 * 32, I_AB = 8 * 32, I_O = 16 * 32, I_U = 16 * 128, I_D = 64 * 32, I_PL = 4 * 32, I_PG = 16 * 32;
        constexpr int NITEMS = I_IN + I_RB + I_AB + I_O + I_U + I_D + I_PL + I_PG;
        for (int it = gw; it < NITEMS; it += nw) {
            int r = it;
            if (r < I_IN) { transpose_item<true>(p.in[I_WIN], 1024, NIN, WIN, scr, r, lane); continue; } r -= I_IN;
            if (r < I_RB) { transpose_item<false>(p.in[I_WRB], 1024, 1024, WRB, scr, r, lane); continue; } r -= I_RB;
            if (r < I_AB) { transpose_item<false>(p.in[I_WAB], 512, 1024, WAB, scr, r, lane); continue; } r -= I_AB;
            if (r < I_O) { transpose_item<false>(p.in[I_WO], 1024, 1024, WO, scr, r, lane); continue; } r -= I_O;
            if (r < I_U) { transpose_item<false>(p.in[I_WU], 1024, DFF, WU, scr, r, lane); continue; } r -= I_U;
            if (r < I_D) { transpose_item<false>(p.in[I_WD], DFF, 1024, WD, scr, r, lane); continue; } r -= I_D;
            if (r < I_PL) { transpose_item<false>(p.in[I_WPL], DPLE, 1024, WPL, scr, r, lane); continue; } r -= I_PL;
            transpose_item<false>(p.in[I_WPG], 1024, 1024, WPG, scr, r, lane);
        }
        for (int m = gw; m < MT; m += nw) {
            const float* xr = m < MP ? p.in[I_XP] + (size_t)m * 1024 : p.in[I_XS] + (size_t)(m - MP) * 1024;
            rms_row_to_bf16(xr, p.in[I_LN1], HN + (size_t)m * 1024, lane);
            const float* pr = m < MP ? p.in[I_PP] + (size_t)m * DPLE : p.in[I_PS] + (size_t)(m - MP) * DPLE;
            st_bf4(PB + (size_t)m * DPLE + 4 * lane, *(const f32x4*)(pr + 4 * lane));
        }
        for (size_t i = gtid; i < (size_t)2049 * 32; i += nthr) {
            const int tp = (int)(i >> 5), j = (int)(i & 31);
            const float pos = tp < SEQ ? (float)tp : 16384.0f;
            const float inv = exp2f(-(float)j * (13.287712379549449f / 32.0f));
            const float ang = pos * inv;
            double rev = (double)ang * 0.15915494309189535; rev -= floor(rev);
            const float rr = (float)(rev * 6.283185307179586 - 3.141592653589793);
            float sn, cs; __sincosf(rr, &sn, &cs);
            ((f32x2*)(ws + WS_ROPE))[i] = (f32x2){-cs, -sn};
        }
        for (size_t i = gtid; i < 12 * 128; i += nthr) {
            const int gh = (int)(i >> 7), j = (int)(i & 127), g = gh >> 2;
            const int d = j * dil_of(g);
            int bkt;
            if (d < 16) bkt = d;
            else { const float lr = logf((float)d / 16.0f) / 4.852030263919617f; bkt = 16 + (int)(lr * 16.0f); bkt = bkt < 31 ? bkt : 31; }
            bias2[i] = p.in[I_RELB][bkt * 12 + gh] * LOG2E;
        }
        for (size_t i = gtid; i < 8 * 128; i += nthr) {
            const int h = (int)(i >> 7), j = (int)(i & 127);
            const float lg = log2f(1.0f - exp2f(-5.0f - (float)h));
            ((f32x2*)(ws + WS_DEC))[i] = (f32x2){exp2f((float)j * lg), exp2f(-(float)j * lg)};
        }
        for (int a = 0; a < 6; ++a) {
            const int g = a >> 1, isv = a & 1, W = win_of(g);
            const f32x4* src = (const f32x4*)p.in[I_CK128 + a]; f32x4* dst = (f32x4*)(out + okvs(g, isv));
            const size_t per = (size_t)(W - 1) * 128, tot = per * SB;
            for (size_t i = gtid; i < tot; i += nthr) { const size_t bs = i / per, r = i - bs * per; dst[bs * (size_t)W * 128 + r] = src[bs * (size_t)W * 128 + 128 + r]; }
        }
    }
    SEAM(0);

    if (IN(1)) { PHASE_IDS
        const EIn e{RQ, RK, KT, RVT, RVS, RG, AQ, AK, AVT, AVS, SGR, SGA, rope, dec, out}; const EStoreBf ep{P, 1024};
        { const EpiG1 E{e, ep}; const SchedG1 S{G, (int)blockIdx.x, (const char*)HN, (const char*)WIN, (const char*)PB, (const char*)WPL}; pg8::gemm_phase(lds, S, E); }
        const int s0 = (G == 256) ? (int)blockIdx.x - 128 : (int)blockIdx.x, sn = (G == 256) ? 128 : G;
        if (s0 >= 0) for (int t = s0; t < 168; t += sn) {
            if (t < 152) sample_tile(lds, HN + (size_t)MP * 1024, 1024, WIN, 1024, 1024, t, e);
            else sample_tile(lds, PB + (size_t)MP * DPLE, DPLE, WPL, DPLE, DPLE, t - 152, ep);
        }
    }
    SEAM(1);

    if (IN(2)) { PHASE_IDS
        LAS float* biasl = (LAS float*)lds;
        for (int i = tid; i < 12 * 128; i += NTHREADS) biasl[i] = bias2[i];
        __syncthreads();
        for (int it = gw; it < 3 * NB * 4 * 16 * 4; it += nw) attn_tile(it, AQ, AK, AVT, OG, LSE, biasl, lane);
        for (int it = gw; it < NB * 8 * 16 * 4; it += nw) ret_kv_tile(it, KT, RVT, KV, dec, lane);
        for (size_t it = gtid; it < (size_t)SB * 8 * 128; it += nthr) {
            const int bs = (int)(it >> 10), h = (int)(it >> 7) & 7, v = (int)(it & 127);
            const float gamma = 1.0f - exp2f(-5.0f - (float)h);
            const size_t row = (size_t)MP + bs;
            const float vv = bf2f(RVS[(size_t)bs * 1024 + h * 128 + v]);
            const float* si = p.in[I_STATE] + ((size_t)(bs * 8 + h) * 64) * 128 + v;
            float* so = out + O_STS + ((size_t)(bs * 8 + h) * 64) * 128 + v;
            float o = 0.f;
#pragma unroll 16
            for (int k = 0; k < 64; ++k) {
                const int ko = (k >> 1) + 32 * (k & 1);
                const float s = gamma * si[(size_t)ko * 128] + bf2f(RK[row * 512 + h * 64 + k]) * vv;
                o += bf2f(RQ[row * 512 + h * 64 + k]) * s;
                so[(size_t)ko * 128] = s;
            }
            ROS[(size_t)bs * 1024 + h * 128 + v] = o;
        }
        LAS float* qs = (LAS float*)(lds + 8192 + wave * 512);
        for (int it = gw; it < 3 * SB * 4; it += nw) {
            const int g = it / (SB * 4), rem = it - g * (SB * 4), bs = rem >> 2, h = rem & 3, dil = dil_of(g), W = win_of(g);
            const size_t row = (size_t)MP + bs;
            const float* ck = p.in[I_CK128 + 2 * g] + (size_t)bs * W * 512 + h * 128;
            const float* cv = p.in[I_CV128 + 2 * g] + (size_t)bs * W * 512 + h * 128;
            const bf16* qp = AQ + row * 1536 + g * 512 + h * 128;
            { const unsigned w = *(const unsigned*)(qp + 2 * lane); qs[2 * lane] = bflo(w); qs[2 * lane + 1] = bfhi(w); }
            asm volatile("s_waitcnt lgkmcnt(0)" ::: "memory");
            float s[2];
#pragma unroll
            for (int hh = 0; hh < 2; ++hh) {
                const int j = lane + 64 * hh;
                float acc = 0.f;
                if (j == 0) {
                    const bf16* kp = AK + row * 1536 + g * 512 + h * 128;
#pragma unroll 8
                    for (int e = 0; e < 128; e += 2) { const unsigned w = *(const unsigned*)(kp + e); acc += bflo(w) * qs[e] + bfhi(w) * qs[e + 1]; }
                } else {
                    const f32x4* kp = (const f32x4*)(ck + (size_t)(W - j * dil) * 512);
#pragma unroll 8
                    for (int c4 = 0; c4 < 32; ++c4) { const f32x4 kv = kp[c4]; const f32x4 q0 = *(const LAS f32x4*)(qs + c4 * 4); acc += kv[0] * q0[0] + kv[1] * q0[1] + kv[2] * q0[2] + kv[3] * q0[3]; }
                }
                s[hh] = acc + biasl[(g * 4 + h) * 128 + j];
            }
            const float m = wave_max(fmaxf(s[0], s[1]));
            const float p0 = exp2f(s[0] - m), p1 = exp2f(s[1] - m);
            const float den = wave_sum(p0 + p1);
            float o0, o1;
            { const unsigned w = *(const unsigned*)(AVS + (size_t)bs * 1536 + g * 512 + h * 128 + 2 * lane); const float pj = __shfl(p0, 0); o0 = pj * bflo(w); o1 = pj * bfhi(w); }
            for (int j0 = 0; j0 < 128; j0 += 16) {
                f32x2 vv[16];
#pragma unroll
                for (int u = 0; u < 16; ++u) { const int j = j0 + u; vv[u] = (j == 0) ? (f32x2){0.f, 0.f} : *(const f32x2*)(cv + (size_t)(W - j * dil) * 512 + 2 * lane); }
#pragma unroll
                for (int u = 0; u < 16; ++u) { const int j = j0 + u; const float pj = __shfl(j < 64 ? p0 : p1, j & 63); o0 += pj * vv[u].x; o1 += pj * vv[u].y; }
            }
            const float inv = 1.0f / den;
            *(unsigned*)(OG + ((size_t)g * MT + row) * 512 + h * 128 + 2 * lane) = pk2(o0 * inv, o1 * inv);
            if (lane == 0) LSE[((size_t)g * MT + row) * 4 + h] = m + log2f(den);
            asm volatile("s_waitcnt lgkmcnt(0)" ::: "memory");
        }
    }
    SEAM(2);

    if (IN(3)) { PHASE_IDS
        for (int it = gw; it < MT * 4; it += nw) {
            const int row = it >> 2, h = it & 3;
            const float l0 = LSE[((size_t)0 * MT + row) * 4 + h], l1 = LSE[((size_t)1 * MT + row) * 4 + h], l2 = LSE[((size_t)2 * MT + row) * 4 + h];
            const float mx = fmaxf(l0, fmaxf(l1, l2));
            const float w0 = exp2f(l0 - mx), w1 = exp2f(l1 - mx), w2 = exp2f(l2 - mx), inv = 1.0f / (w0 + w1 + w2);
            const size_t off = (size_t)row * 512 + h * 128 + 2 * lane;
            const unsigned a = *(const unsigned*)(OG + (size_t)0 * MT * 512 + off), b = *(const unsigned*)(OG + (size_t)1 * MT * 512 + off), c = *(const unsigned*)(OG + (size_t)2 * MT * 512 + off);
            *(unsigned*)(AATT + off) = pk2((w0 * bflo(a) + w1 * bflo(b) + w2 * bflo(c)) * inv, (w0 * bfhi(a) + w1 * bfhi(b) + w2 * bfhi(c)) * inv);
        }
        for (size_t it = gtid; it < (size_t)64 * 8 * 128; it += nthr) {
            const int v = (int)(it & 127), pc = (int)(it >> 7) & 7, bh = (int)(it >> 10), h = bh & 7;
            const float gamma = dec[h * 128 + 1].x, g128 = dec[h * 128 + 127].x * gamma;
            float S[8];
#pragma unroll
            for (int j = 0; j < 8; ++j) S[j] = 0.f;
            for (int c = 0; c < 16; ++c) {
                const float* kvp = KV + ((size_t)(bh * 16 + c) * 64 + pc * 8) * 128 + v;
#pragma unroll
                for (int j = 0; j < 8; ++j) S[j] = g128 * S[j] + kvp[(size_t)j * 128];
                if (c < 15) st_bf8(ST + (((size_t)bh * 16 + (c + 1)) * 128 + v) * 64 + pc * 8, (f32x4){gamma * S[0], gamma * S[1], gamma * S[2], gamma * S[3]}, (f32x4){gamma * S[4], gamma * S[5], gamma * S[6], gamma * S[7]});
            }
            float* so = out + O_STP + ((size_t)bh * 64) * 128 + v;
#pragma unroll
            for (int j = 0; j < 8; ++j) { const int pq = pc * 8 + j; so[(size_t)((pq >> 1) + 32 * (pq & 1)) * 128] = S[j]; }
        }
    }
    SEAM(3);

    if (IN(4)) { PHASE_IDS
        for (int it = gw; it < NB * 8 * 16 * 4; it += nw) ret_out_tile(it, RQ, RK, RVT, ST, RG, p.in[I_GN], ARET, lane);
        const float* gn = p.in[I_GN];
        for (int it = gw; it < SB * 8; it += nw) {
            const int bs = it >> 3, h = it & 7;
            const size_t base = (size_t)(MP + bs) * 1024 + h * 128, sb = (size_t)bs * 1024 + h * 128;
            const float x0 = ROS[sb + lane], x1 = ROS[sb + 64 + lane];
            const float mu = wave_sum(x0 + x1) * (1.f / 128.f);
            const float d0 = x0 - mu, d1 = x1 - mu;
            const float r = rsqrtf(wave_sum(d0 * d0 + d1 * d1) * (1.f / 128.f) + NORM_EPS);
            ARET[base + lane] = (bf16)f2bf(bf2f(RG[base + lane]) * d0 * r * gn[h * 128 + lane]);
            ARET[base + 64 + lane] = (bf16)f2bf(bf2f(RG[base + 64 + lane]) * d1 * r * gn[h * 128 + 64 + lane]);
        }
    }
    SEAM(4);

    if (IN(5)) {
        for (int t = blockIdx.x; t < 16; t += G) {
            f32x4 r0 = (f32x4){0.f, 0.f, 0.f, 0.f}, r1 = r0;
            sample_tile(lds, ARET + (size_t)MP * 1024, 1024, WRB, 1024, 1024, t, [&](int, int, f32x4 v0, f32x4 v1) { r0 = v0; r1 = v1; });
            sample_tile(lds, AATT + (size_t)MP * 512, 512, WAB, 512, 512, t, [&](int row, int c, f32x4 v0, f32x4 v1) {
                f32x4 g0, g1, a0, a1; ld_bf8(SGR + (size_t)row * 1024 + c, g0, g1); ld_bf8(SGA + (size_t)row * 1024 + c, a0, a1);
                st_bf8(MIX + (size_t)row * 1024 + c, g0 * r0 + a0 * v0, g1 * r1 + a1 * v1); });
        }
        const EpiMix E{SGR, SGA, MIX}; const SchedMix S{G, (int)blockIdx.x, (const char*)ARET, (const char*)WRB, (const char*)AATT, (const char*)WAB};
        pg8::gemm_phase(lds, S, E);
    }
    SEAM(5);
    if (IN(6)) {
        const EResIn e{p.in[I_XP], p.in[I_XS], X};
        for (int t = blockIdx.x; t < 16; t += G) sample_tile(lds, MIX + (size_t)MP * 1024, 1024, WO, 1024, 1024, t, e);
        const EpiSimple<EResIn> E{e}; const SchedPlain S{G, (int)blockIdx.x, 4, 1024, (const char*)MIX, (const char*)WO}; pg8::gemm_phase(lds, S, E);
    }
    SEAM(6);
    if (IN(7)) { PHASE_IDS for (int m = gw; m < MT; m += nw) rms_row_to_bf16(X + (size_t)m * 1024, p.in[I_LN2], H2 + (size_t)m * 1024, lane); }
    SEAM(7);
    if (IN(8)) {
        const ERelu2 e{U};
        for (int t = blockIdx.x; t < 64; t += G) sample_tile(lds, H2 + (size_t)MP * 1024, 1024, WU, 1024, 1024, t, e);
        const EpiSimple<ERelu2> E{e}; const SchedPlain S{G, (int)blockIdx.x, 16, 1024, (const char*)H2, (const char*)WU}; pg8::gemm_phase(lds, S, E);
    }
    SEAM(8);
    if (IN(9)) {
        const EResX e{X, X2B};
        for (int t = blockIdx.x; t < 16; t += G) sample_tile(lds, U + (size_t)MP * DFF, DFF, WD, DFF, DFF, t, e);
        const EpiSimple<EResX> E{e}; const SchedPlain S{G, (int)blockIdx.x, 4, DFF, (const char*)U, (const char*)WD}; pg8::gemm_phase(lds, S, E);
    }
    SEAM(9);
    if (IN(10)) {
        const EPle e{X, P};
        for (int t = blockIdx.x; t < 16; t += G) sample_tile(lds, X2B + (size_t)MP * 1024, 1024, WPG, 1024, 1024, t, e);
        const EpiSimple<EPle> E{e}; const SchedPlain S{G, (int)blockIdx.x, 4, 1024, (const char*)X2B, (const char*)WPG}; pg8::gemm_phase(lds, S, E);
    }
    SEAM(10);
    if (IN(11)) { PHASE_IDS
        const float* g = p.in[I_LNF];
        for (int m = gw; m < MT; m += nw) {
            float* xr = X + (size_t)m * 1024;
            f32x4 v[4]; float s = 0.f;
#pragma unroll
            for (int j = 0; j < 4; ++j) { v[j] = *(const f32x4*)(xr + 4 * lane + 256 * j); s += (v[j][0] * v[j][0] + v[j][1] * v[j][1]) + (v[j][2] * v[j][2] + v[j][3] * v[j][3]); }
            const float r = rsqrtf(wave_sum(s) * (1.f / 1024.f) + NORM_EPS);
#pragma unroll
            for (int j = 0; j < 4; ++j) { const f32x4 gg = *(const f32x4*)(g + 4 * lane + 256 * j); *(f32x4*)(xr + 4 * lane + 256 * j) = v[j] * r * gg; }
        }
    }
#undef IN
#undef SEAM
}

#ifndef MK_N_LAUNCHES
#define MK_N_LAUNCHES 1
#endif
extern "C" void kernel_launch(void* const* d_in, const int* in_sizes, int n_in, void* d_out, int out_size, void* d_ws, size_t ws_size, hipStream_t stream) {
    static int grid = 0;
    if (grid == 0) {
        if (n_in != 24 || (size_t)out_size != O_END || ws_size < WS_END) { fprintf(stderr, "kernel_launch: unexpected problem shape (n_in %d out %d ws %zu)\n", n_in, out_size, ws_size); grid = -1; return; }
        int dev = 0, cus = 0, per_cu = 0;
        if (hipGetDevice(&dev) != hipSuccess || hipDeviceGetAttribute(&cus, hipDeviceAttributeMultiprocessorCount, dev) != hipSuccess) { grid = -1; return; }
        if (hipFuncSetAttribute((const void*)fwd_kernel, hipFuncAttributeMaxDynamicSharedMemorySize, LDS_BYTES) != hipSuccess) { fprintf(stderr, "kernel_launch: hipFuncSetAttribute failed\n"); grid = -1; return; }
        if (hipOccupancyMaxActiveBlocksPerMultiprocessor(&per_cu, (const void*)fwd_kernel, NTHREADS, LDS_BYTES) != hipSuccess || per_cu < 1) { fprintf(stderr, "kernel_launch: occupancy query failed (%d)\n", per_cu); (void)hipGetLastError(); per_cu = 1; }
        grid = cus * (per_cu < 1 ? 1 : (per_cu > 1 ? 1 : per_cu));
    }
    if (grid < 0) return;
    (void)hipMemsetAsync((char*)d_ws + WS_CTL, 0, CTL_ZERO_BYTES, stream);
    Params p{};
    for (int i = 0; i < 24; ++i) p.in[i] = (const float*)d_in[i];
    p.out = (float*)d_out; p.ws = (unsigned char*)d_ws;
#if MK_N_LAUNCHES == 1
    p.ph_lo = 0; p.ph_hi = NPHASE;
    void* args[] = {&p};
    hipError_t e = hipLaunchCooperativeKernel((const void*)fwd_kernel, dim3(grid), dim3(NTHREADS), args, LDS_BYTES, stream);
    if (e != hipSuccess) fprintf(stderr, "kernel_launch: cooperative launch failed: %s (grid %d)\n", hipGetErrorString(e), grid);
#else
    for (int k = 0; k < NPHASE; ++k) { p.ph_lo = k; p.ph_hi = k + 1; hipLaunchKernelGGL(fwd_kernel, dim3(grid), dim3(NTHREADS), LDS_BYTES, stream, p); }
#endif
}
```

```cpp
#include <hip/hip_runtime.h>
#include <cstdio>
#include <cstdint>

#define LAS __attribute__((address_space(3)))
typedef unsigned short bf16;
typedef short bf16x8 __attribute__((ext_vector_type(8)));
typedef float f32x4 __attribute__((ext_vector_type(4)));
typedef float f32x2 __attribute__((ext_vector_type(2)));
typedef unsigned u32x4 __attribute__((ext_vector_type(4)));
typedef unsigned u32x2 __attribute__((ext_vector_type(2)));
typedef float f32x2_t_ __attribute__((ext_vector_type(2)));
typedef float f32x16 __attribute__((ext_vector_type(16)));

constexpr int D = 1024, NB = 8, SEQ = 2048, MP = NB * SEQ, SB = 32, MT = MP + SB, MPAD = 16640;
constexpr int NIN = 9728, DFF = 4096, DPLE = 256;
constexpr int NWAVES = 8, NTHREADS = NWAVES * 64;
constexpr int LDS_BYTES = 147456;
constexpr float NORM_EPS = 1e-6f;
constexpr float LOG2E = 1.4426950408889634f;
constexpr float QSCALE = 0.08838834764831845f * LOG2E;

constexpr size_t O_Y = 0;
constexpr size_t O_STP = (size_t)MT * 1024;
constexpr size_t O_KVP0 = O_STP + 524288;
constexpr size_t O_STS = O_KVP0 + 2 * 524288 + 2 * 2097152 + 2 * 8388608;
constexpr size_t O_KVS0 = O_STS + 2097152;
constexpr size_t O_END = O_KVS0 + 2 * 2097152 + 2 * 8388608 + 2 * 33554432;
static_assert(O_END == 129531904, "d_out size");
__host__ __device__ constexpr int win_of(int g) { return g == 0 ? 128 : (g == 1 ? 512 : 2048); }
__host__ __device__ constexpr int dil_of(int g) { return g == 0 ? 1 : (g == 1 ? 4 : 16); }
__host__ __device__ constexpr size_t okvp(int g, int isv) {
    return O_KVP0 + (g == 0 ? 0 : (g == 1 ? 2 * 524288 : 2 * 524288 + 2 * 2097152)) + (size_t)isv * (size_t)NB * win_of(g) * 512;
}
__host__ __device__ constexpr size_t okvs(int g, int isv) {
    return O_KVS0 + (g == 0 ? 0 : (g == 1 ? 2 * 2097152 : 2 * 2097152 + 2 * 8388608)) + (size_t)isv * (size_t)SB * win_of(g) * 512;
}

constexpr size_t MiB = 1u << 20;
constexpr size_t WS_CTL = 0, CTL_ZERO_BYTES = 1 * MiB;
constexpr size_t WS_ROPE = 1 * MiB;
constexpr size_t WS_BIAS = 1 * MiB + 640 * 1024;
constexpr size_t WS_DEC = 1 * MiB + 704 * 1024;
constexpr size_t WS_WIN = 2 * MiB;
constexpr size_t WS_WRB = 21 * MiB;
constexpr size_t WS_WAB = 23 * MiB;
constexpr size_t WS_WO = 24 * MiB;
constexpr size_t WS_WU = 26 * MiB;
constexpr size_t WS_WD = 34 * MiB;
constexpr size_t WS_WPL = 42 * MiB;
constexpr size_t WS_WPG = 43 * MiB;
constexpr size_t WS_RVS = 45 * MiB;
constexpr size_t WS_AVS = 45 * MiB + 64 * 1024;
constexpr size_t WS_ROS = 45 * MiB + 160 * 1024;
constexpr size_t WS_HN = 46 * MiB;
constexpr size_t WS_PB = 79 * MiB;
constexpr size_t WS_P = 88 * MiB;
constexpr size_t WS_RQ = 121 * MiB;
constexpr size_t WS_RK = 138 * MiB;
constexpr size_t WS_RVT = 155 * MiB;
constexpr size_t WS_RG = 188 * MiB;
constexpr size_t WS_AQ = 221 * MiB;
constexpr size_t WS_AK = 270 * MiB;
constexpr size_t WS_AVT = 319 * MiB;
constexpr size_t WS_SGR = 367 * MiB;
constexpr size_t WS_SGA = 400 * MiB;
constexpr size_t WS_OG = 433 * MiB;
constexpr size_t WS_LSE = 482 * MiB;
constexpr size_t WS_KT = 483 * MiB;
constexpr size_t WS_END = 499 * MiB;
static_assert(WS_AQ + (size_t)MT * 4096 * 2 <= WS_SGR, "U overlay");
static_assert((size_t)MT * 1024 * 2 <= 33 * MiB && (size_t)MT * 512 * 2 <= 17 * MiB && (size_t)MT * 1536 * 2 <= 49 * MiB, "slots");

__device__ __forceinline__ unsigned f2bf(float f) { unsigned u = __float_as_uint(f); return (u + 0x7fffu + ((u >> 16) & 1u)) >> 16; }
__device__ __forceinline__ float bf2f(unsigned b) { return __uint_as_float(b << 16); }
typedef __bf16 bf16x2_t __attribute__((ext_vector_type(2)));
__device__ __forceinline__ unsigned pk2(float lo, float hi) { const f32x2_t_ v = {lo, hi}; const bf16x2_t b = __builtin_convertvector(v, bf16x2_t); return __builtin_bit_cast(unsigned, b); }
__device__ __forceinline__ float bflo(unsigned w) { return __uint_as_float(w << 16); }
__device__ __forceinline__ float bfhi(unsigned w) { return __uint_as_float(w & 0xffff0000u); }
__device__ __forceinline__ float wave_sum(float v) {
#pragma unroll
    for (int o = 1; o < 64; o <<= 1) v += __shfl_xor(v, o);
    return v;
}
__device__ __forceinline__ float wave_max(float v) {
#pragma unroll
    for (int o = 1; o < 64; o <<= 1) v = fmaxf(v, __shfl_xor(v, o));
    return v;
}
__device__ __forceinline__ float sigmoidf_(float v) { return 1.0f / (1.0f + __expf(-v)); }
__device__ __forceinline__ void st_bf4(bf16* p, f32x4 v) { u32x2 w; w.x = pk2(v[0], v[1]); w.y = pk2(v[2], v[3]); *(u32x2*)p = w; }
__device__ __forceinline__ f32x4 ld_bf4(const bf16* p) { const u32x2 w = *(const u32x2*)p; return (f32x4){bflo(w.x), bfhi(w.x), bflo(w.y), bfhi(w.y)}; }

struct Params {
    const float* in[24];
    float* out;
    unsigned char* ws;
    int ph_lo, ph_hi;
};
enum { I_XP = 0, I_XS, I_STATE, I_CK128, I_CV128, I_CK512, I_CV512, I_CK2K, I_CV2K, I_PP, I_PS, I_LN1, I_WIN, I_GN, I_WRB, I_WAB, I_WO, I_LN2, I_WU, I_WD, I_WPL, I_WPG, I_RELB, I_LNF };

__device__ __forceinline__ void st_bf8(bf16* p, f32x4 a, f32x4 b) { u32x4 w; w.x = pk2(a[0], a[1]); w.y = pk2(a[2], a[3]); w.z = pk2(b[0], b[1]); w.w = pk2(b[2], b[3]); *(u32x4*)p = w; }
__device__ __forceinline__ void ld_bf8(const bf16* p, f32x4& a, f32x4& b) { const u32x4 w = *(const u32x4*)p; a = (f32x4){bflo(w.x), bfhi(w.x), bflo(w.y), bfhi(w.y)}; b = (f32x4){bflo(w.z), bfhi(w.z), bflo(w.w), bfhi(w.w)}; }

namespace pg8 {
typedef bf16 bf16_t;
constexpr int BM = 256, BK = 64, HALF = 128, HTB = HALF * BK * 2, STAGE_BYTES = 8 * HTB, NXCD = 8, WGM = 8;
__host__ __device__ __forceinline__ int lds_byte(int r, int c) { const int st = (r >> 4) * 2 + (c >> 5), rr = r & 15, cc = c & 31, ob = rr * 64 + cc * 2; return st * 1024 + (ob ^ (((ob >> 9) & 1) << 5)); }
__host__ __device__ __forceinline__ void stage_rc(int b, int& R, int& C) { const int st = b / 1024, sb = b % 1024, swz = sb ^ (((sb >> 9) & 1) << 5); R = (st >> 1) * 16 + swz / 64; C = (st & 1) * 32 + (swz % 64) / 2; }
__host__ __device__ __forceinline__ int perm32(int rho) { const int n = rho >> 4, i = rho & 15; return 8 * (i >> 2) + 4 * n + (i & 3); }
struct Unit { const char* A; const char* B; int lda, ldb, nt, pm, pn, kind, keep; };
__device__ __forceinline__ void tile_of(int L, int nM, int nN, int& pm, int& pn) {
    const int nwg = nM * nN; int wgid = L; { const int q = nwg / NXCD, r = nwg % NXCD, xcd = wgid % NXCD, off = wgid / NXCD; wgid = (xcd < r ? xcd * (q + 1) : r * (q + 1) + (xcd - r) * q) + off; }
    const int nig = WGM * nN, gid = wgid / nig, fm = gid * WGM, gsz = (nM - fm) < WGM ? (nM - fm) : WGM;
    pm = fm + ((wgid % nig) % gsz); pn = (wgid % nig) / gsz;
}
template <class F> __device__ __forceinline__ void for_tile(f32x4 (&acc)[2][2][4][2], const Unit& u, int wr, int wc, int fr, int fq, const F& f) {
#pragma unroll
    for (int ai = 0; ai < 2; ++ai)
#pragma unroll
        for (int m = 0; m < 4; ++m) { const int row = u.pm * BM + ai * HALF + wr * 64 + m * 16 + fr;
#pragma unroll
            for (int bj = 0; bj < 2; ++bj) f(row, u.pn * BM + bj * HALF + wc * 32 + 8 * fq, acc[ai][bj][m][0], acc[ai][bj][m][1]); }
}
template <class Epi, class Sched>
__device__ __forceinline__ void gemm_phase(LAS unsigned char* lds, const Sched& S, const Epi& E) {
    const int tid = threadIdx.x, wid = __builtin_amdgcn_readfirstlane(tid >> 6), lane = tid & 63, wr = wid >> 2, wc = wid & 3, fr = lane & 15, fq = lane >> 4;
    unsigned RA[2], RB[2], CC[2];
#pragma unroll
    for (int i = 0; i < 2; ++i) { int R, C; stage_rc(tid * 16 + i * 8192, R, C); RA[i] = 2u * (unsigned)R; RB[i] = 2u * (unsigned)((R & ~31) + perm32(R & 31)); CC[i] = 2u * (unsigned)C; }
    const size_t kstep = (size_t)(BK * 2);
    const unsigned ldsw = (unsigned)wid * 1024u;
    const int aoff = lds_byte(wr * 64 + fr, fq * 8), boff = lds_byte(wc * 32 + fr, fq * 8);
#define PG8_SA(b, h) (((b) * 2 + (h)) * HTB)
#define PG8_SB(b, h) ((4 + (b) * 2 + (h)) * HTB)
#define PG8_STAGE(bufoff, gbase, RR, ld) do { _Pragma("unroll") for (int _i = 0; _i < 2; ++_i) \
        __builtin_amdgcn_global_load_lds((const unsigned*)((const char*)(gbase) + (RR[_i] * (unsigned)(ld) + CC[_i])), (LAS unsigned*)(lds + (bufoff) + ldsw + _i * 8192), 16, 0, 0); } while (0)
#define PG8_LDA(dst, b, h) do { _Pragma("unroll") for (int m = 0; m < 4; ++m) _Pragma("unroll") for (int k = 0; k < 2; ++k) dst[m][k] = *(const LAS bf16x8*)(lds + PG8_SA(b, h) + aoff + m * 2048 + k * 1024); } while (0)
#define PG8_LDB(dst, b, h) do { _Pragma("unroll") for (int n = 0; n < 2; ++n) _Pragma("unroll") for (int k = 0; k < 2; ++k) dst[n][k] = *(const LAS bf16x8*)(lds + PG8_SB(b, h) + boff + n * 2048 + k * 1024); } while (0)
#define PG8_MMA(ai, bj, At, Bt) do { __builtin_amdgcn_s_setprio(1); _Pragma("unroll") for (int m = 0; m < 4; ++m) _Pragma("unroll") for (int n = 0; n < 2; ++n) _Pragma("unroll") for (int k = 0; k < 2; ++k) \
        acc[ai][bj][m][n] = __builtin_amdgcn_mfma_f32_16x16x32_bf16(Bt[n][k], At[m][k], acc[ai][bj][m][n], 0, 0, 0); __builtin_amdgcn_s_setprio(0); } while (0)
#define PG8_WAIT_V(n) asm volatile("s_waitcnt vmcnt(" #n ")" ::: "memory")
#define PG8_WAIT_L(n) asm volatile("s_waitcnt lgkmcnt(" #n ")" ::: "memory")
#define PG8_BAR __builtin_amdgcn_s_barrier()
#define PG8_SCHED __builtin_amdgcn_sched_barrier(0)
    Unit cur, nxt; int ui = 0;
    if (!S.next(0, cur)) return;
    f32x4 acc[2][2][4][2];
#pragma unroll
    for (int a = 0; a < 2; ++a)
#pragma unroll
        for (int b = 0; b < 2; ++b)
#pragma unroll
            for (int m = 0; m < 4; ++m)
#pragma unroll
                for (int n = 0; n < 2; ++n) acc[a][b][m][n] = (f32x4){0.f, 0.f, 0.f, 0.f};
    bf16x8 At[4][2], B0[2][2], B1[2][2];
    int ldAc = cur.lda, ldBc = cur.ldb;
    const char* cA = cur.A; const char* cB = cur.B;
#define HA(ld) ((size_t)HALF * 2 * (size_t)(ld))
    PG8_STAGE(PG8_SB(0, 0), cB, RB, ldBc); PG8_STAGE(PG8_SB(0, 1), cB + HA(ldBc), RB, ldBc); PG8_STAGE(PG8_SA(0, 0), cA, RA, ldAc); PG8_STAGE(PG8_SA(0, 1), cA + HA(ldAc), RA, ldAc);
    if (wr == 1) PG8_BAR;
    PG8_WAIT_V(2); PG8_BAR;
    PG8_STAGE(PG8_SB(1, 0), cB + kstep, RB, ldBc); PG8_STAGE(PG8_SA(1, 0), cA + kstep, RA, ldAc); PG8_STAGE(PG8_SB(1, 1), cB + HA(ldBc) + kstep, RB, ldBc);
    PG8_WAIT_V(6); PG8_BAR;
    for (;;) {
        const bool has_next = S.next(ui + 1, nxt);
        const char* nA = cA; const char* nB = cB; int ldAn = ldAc, ldBn = ldBc;
        if (has_next) { nA = nxt.A; nB = nxt.B; ldAn = nxt.lda; ldBn = nxt.ldb; }
        const int nt = cur.nt;
        for (int t = 0; t < nt; t += 2) {
            const bool last = (t == nt - 2);
            const char* a1 = cA + (size_t)(t + 1) * kstep;
            const char* a2 = last ? nA : cA + (size_t)(t + 2) * kstep; const char* b2 = last ? nB : cB + (size_t)(t + 2) * kstep;
            const char* a3 = a2 + kstep; const char* b3 = b2 + kstep;
            const int ldA2 = last ? ldAn : ldAc, ldB2 = last ? ldBn : ldBc;
            PG8_LDB(B0, 0, 0); PG8_LDB(B1, 0, 1); PG8_SCHED; PG8_LDA(At, 0, 0); PG8_STAGE(PG8_SA(1, 1), a1 + HA(ldAc), RA, ldAc);
            PG8_WAIT_V(8); PG8_WAIT_L(0); PG8_BAR; PG8_MMA(0, 0, At, B0); PG8_MMA(0, 1, At, B1); PG8_BAR; PG8_SCHED;
            PG8_LDA(At, 0, 1); PG8_STAGE(PG8_SB(0, 0), b2, RB, ldB2); PG8_STAGE(PG8_SB(0, 1), b2 + HA(ldB2), RB, ldB2); PG8_STAGE(PG8_SA(0, 0), a2, RA, ldA2);
            PG8_WAIT_V(8); PG8_WAIT_L(0); PG8_BAR; PG8_MMA(1, 0, At, B0); PG8_MMA(1, 1, At, B1); PG8_BAR; PG8_SCHED;
            PG8_LDB(B0, 1, 0); PG8_LDB(B1, 1, 1); PG8_SCHED; PG8_LDA(At, 1, 0); PG8_STAGE(PG8_SA(0, 1), a2 + HA(ldA2), RA, ldA2);
            PG8_WAIT_V(8); PG8_WAIT_L(0); PG8_BAR; PG8_MMA(0, 0, At, B0); PG8_MMA(0, 1, At, B1); PG8_BAR; PG8_SCHED;
            PG8_LDA(At, 1, 1); PG8_STAGE(PG8_SB(1, 0), b3, RB, ldB2); PG8_STAGE(PG8_SB(1, 1), b3 + HA(ldB2), RB, ldB2); PG8_STAGE(PG8_SA(1, 0), a3, RA, ldA2);
            PG8_WAIT_V(8); PG8_WAIT_L(0); PG8_BAR; PG8_MMA(1, 0, At, B0); PG8_MMA(1, 1, At, B1); PG8_BAR; PG8_SCHED;
        }
        if (wr == 0) PG8_BAR;
        E(acc, cur, wr, wc, fr, fq);
        if (!has_next) break;
        if (!cur.keep) {
#pragma unroll
            for (int a = 0; a < 2; ++a)
#pragma unroll
                for (int b = 0; b < 2; ++b)
#pragma unroll
                    for (int m = 0; m < 4; ++m)
#pragma unroll
                        for (int n = 0; n < 2; ++n) acc[a][b][m][n] = (f32x4){0.f, 0.f, 0.f, 0.f};
        }
        cur = nxt; cA = nA; cB = nB; ldAc = ldAn; ldBc = ldBn; ++ui;
        if (wr == 1) PG8_BAR;
    }
    PG8_WAIT_V(0);
    PG8_BAR;
#undef PG8_SA
#undef PG8_SB
#undef PG8_STAGE
#undef PG8_LDA
#undef PG8_LDB
#undef PG8_MMA
#undef PG8_WAIT_V
#undef PG8_WAIT_L
#undef PG8_BAR
#undef PG8_SCHED
#undef HA
}
}

template <class F>
__device__ __forceinline__ void sample_tile(LAS unsigned char* lds, const bf16* __restrict__ A, int lda, const bf16* __restrict__ Bt, int ldb, int K, int tile, const F& f) {
    const int tid = threadIdx.x, lane = tid & 63, wave = tid >> 6, fr = lane & 15, fq = lane >> 4;
    f32x4 acc[2][4];
#pragma unroll
    for (int a = 0; a < 2; ++a)
#pragma unroll
        for (int b = 0; b < 4; ++b) acc[a][b] = (f32x4){0.f, 0.f, 0.f, 0.f};
    const int kw = K / 8;
    const bf16* ap = A + (size_t)fr * lda + wave * kw + fq * 8;
    const bf16* bp = Bt + (size_t)(tile * 64 + fr) * ldb + wave * kw + fq * 8;
    for (int k0 = 0; k0 < kw; k0 += 32) {
        bf16x8 a[2], b[4];
#pragma unroll
        for (int mi = 0; mi < 2; ++mi) a[mi] = *(const bf16x8*)(ap + (size_t)mi * 16 * lda + k0);
#pragma unroll
        for (int ni = 0; ni < 4; ++ni) b[ni] = *(const bf16x8*)(bp + (size_t)ni * 16 * ldb + k0);
#pragma unroll
        for (int mi = 0; mi < 2; ++mi)
#pragma unroll
            for (int ni = 0; ni < 4; ++ni) acc[mi][ni] = __builtin_amdgcn_mfma_f32_16x16x32_bf16(b[ni], a[mi], acc[mi][ni], 0, 0, 0);
    }
    LAS float* part = (LAS float*)lds;
#pragma unroll
    for (int mi = 0; mi < 2; ++mi)
#pragma unroll
        for (int ni = 0; ni < 4; ++ni) *(LAS f32x4*)(part + ((size_t)wave * 32 + mi * 16 + fr) * 68 + ni * 16 + fq * 4) = acc[mi][ni];
    __syncthreads();
    if (tid < 256) {
        const int row = tid >> 3, cg = (tid & 7) * 8;
        f32x4 v0 = (f32x4){0.f, 0.f, 0.f, 0.f}, v1 = v0;
#pragma unroll
        for (int w = 0; w < 8; ++w) { v0 += *(const LAS f32x4*)(part + ((size_t)w * 32 + row) * 68 + cg); v1 += *(const LAS f32x4*)(part + ((size_t)w * 32 + row) * 68 + cg + 4); }
        f(MP + row, tile * 64 + cg, v0, v1);
    }
    __syncthreads();
}

struct EIn {
    bf16 *RQ, *RK, *KT, *RVT, *RVS, *RG, *AQ, *AK, *AVT, *AVS, *SGR, *SGA; const f32x2* rope; const f32x2* dec; float* out;
    template <int SEG> __device__ __forceinline__ void seg(int row, int c, f32x4 v0, f32x4 v1) const {
        if (SEG == 0 || SEG == 1) {
            const int cc = c & 511, h = cc >> 6, tp = row < MP ? (row & (SEQ - 1)) : SEQ, i0 = (cc & 63) >> 1;
            const f32x4 r0 = *(const f32x4*)(rope + tp * 32 + i0), r1 = *(const f32x4*)(rope + tp * 32 + i0 + 2);
            const f32x2 dd = dec[h * 128 + (row < MP ? (row & 127) : 0)];
            const float sc = SEG == 1 ? 0.125f * dd.y : dd.x;
            f32x4 o0, o1;
            o0[0] = v0[0] * r0[0] - v0[1] * r0[1]; o0[1] = v0[0] * r0[1] + v0[1] * r0[0]; o0[2] = v0[2] * r0[2] - v0[3] * r0[3]; o0[3] = v0[2] * r0[3] + v0[3] * r0[2];
            o1[0] = v1[0] * r1[0] - v1[1] * r1[1]; o1[1] = v1[0] * r1[1] + v1[1] * r1[0]; o1[2] = v1[2] * r1[2] - v1[3] * r1[3]; o1[3] = v1[2] * r1[3] + v1[3] * r1[2];
            o0 *= sc; o1 *= sc;
            st_bf8((SEG == 1 ? RK : RQ) + (size_t)row * 512 + cc, o0, o1);
            if (SEG == 1 && row < MP) {
                bf16* d = KT + ((size_t)((row >> 11) * 8 + h) * 64 + (cc & 63)) * SEQ + (row & (SEQ - 1));
#pragma unroll
                for (int j = 0; j < 4; ++j) { d[(size_t)j * SEQ] = (bf16)f2bf(o0[j]); d[(size_t)(j + 4) * SEQ] = (bf16)f2bf(o1[j]); }
            }
        } else if (SEG == 2) {
            const int cc = c - 1024;
            if (row < MP) {
                bf16* d = RVT + ((size_t)((row >> 11) * 8 + (cc >> 7)) * 128 + (cc & 127)) * SEQ + (row & (SEQ - 1));
#pragma unroll
                for (int j = 0; j < 4; ++j) { d[(size_t)j * SEQ] = (bf16)f2bf(v0[j]); d[(size_t)(j + 4) * SEQ] = (bf16)f2bf(v1[j]); }
            } else st_bf8(RVS + (size_t)(row - MP) * 1024 + cc, v0, v1);
        } else if (SEG == 3) {
            f32x4 s0, s1;
#pragma unroll
            for (int j = 0; j < 4; ++j) { s0[j] = v0[j] * sigmoidf_(v0[j]); s1[j] = v1[j] * sigmoidf_(v1[j]); }
            st_bf8(RG + (size_t)row * 1024 + (c - 2048), s0, s1);
        } else if (SEG == 4) {
            st_bf8(AQ + (size_t)row * 1536 + (c - 3072), v0 * QSCALE, v1 * QSCALE);
        } else if (SEG == 5 || SEG == 6) {
            const int isv = SEG == 6; const int cc = c - (isv ? 6144 : 4608); const int g = cc >> 9, hc = cc & 511;
            const int W = win_of(g);
            float* dst = nullptr;
            if (row < MP) { const int t = row & (SEQ - 1), b = row >> 11; if (t >= SEQ - W) dst = out + okvp(g, isv) + ((size_t)(b * W + t - (SEQ - W)) * 512 + hc); }
            else { const int bs = row - MP; dst = out + okvs(g, isv) + ((size_t)(bs * W + (W - 1)) * 512 + hc); }
            if (dst) { *(f32x4*)dst = v0; *(f32x4*)(dst + 4) = v1; }
            if (!isv) st_bf8(AK + (size_t)row * 1536 + cc, v0, v1);
            else if (row < MP) {
                const int t = row & (SEQ - 1), b = row >> 11, sh = 2 * g;
                bf16* d = AVT + ((size_t)((b * 3 + g) * 4 + (hc >> 7)) * 128 + (hc & 127)) * SEQ + (size_t)(t & ((1 << sh) - 1)) * (SEQ >> sh) + (t >> sh);
#pragma unroll
                for (int j = 0; j < 4; ++j) { d[(size_t)j * SEQ] = (bf16)f2bf(v0[j]); d[(size_t)(j + 4) * SEQ] = (bf16)f2bf(v1[j]); }
            } else st_bf8(AVS + (size_t)(row - MP) * 1536 + cc, v0, v1);
        } else {
            f32x4 s0, s1;
#pragma unroll
            for (int j = 0; j < 4; ++j) { s0[j] = sigmoidf_(v0[j]); s1[j] = sigmoidf_(v1[j]); }
            st_bf8((SEG == 8 ? SGA : SGR) + (size_t)row * 1024 + (c - (SEG == 8 ? 8704 : 7680)), s0, s1);
        }
    }
    __device__ __forceinline__ static int seg_of(int c) { return c < 512 ? 0 : c < 1024 ? 1 : c < 2048 ? 2 : c < 3072 ? 3 : c < 4608 ? 4 : c < 6144 ? 5 : c < 7680 ? 6 : c < 8704 ? 7 : 8; }
    __device__ __forceinline__ void operator()(int row, int c, f32x4 v0, f32x4 v1) const {
        switch (seg_of(c)) { case 0: seg<0>(row, c, v0, v1); break; case 1: seg<1>(row, c, v0, v1); break; case 2: seg<2>(row, c, v0, v1); break; case 3: seg<3>(row, c, v0, v1); break;
            case 4: seg<4>(row, c, v0, v1); break; case 5: seg<5>(row, c, v0, v1); break; case 6: seg<6>(row, c, v0, v1); break; case 7: seg<7>(row, c, v0, v1); break; default: seg<8>(row, c, v0, v1); break; }
    }
};
struct EStoreBf { bf16* O; int ld; __device__ __forceinline__ void operator()(int row, int c, f32x4 v0, f32x4 v1) const { st_bf8(O + (size_t)row * ld + c, v0, v1); } };
struct EResIn {
    const float *xp, *xs; float* X;
    __device__ __forceinline__ void operator()(int row, int c, f32x4 v0, f32x4 v1) const {
        const float* src = row < MP ? xp + (size_t)row * 1024 + c : xs + (size_t)(row - MP) * 1024 + c; float* d = X + (size_t)row * 1024 + c;
        *(f32x4*)d = *(const f32x4*)src + v0; *(f32x4*)(d + 4) = *(const f32x4*)(src + 4) + v1;
    }
};
struct ERelu2 {
    bf16* U;
    __device__ __forceinline__ void operator()(int row, int c, f32x4 v0, f32x4 v1) const {
        f32x4 s0, s1;
#pragma unroll
        for (int j = 0; j < 4; ++j) { const float a = fmaxf(v0[j], 0.f), b = fmaxf(v1[j], 0.f); s0[j] = a * a; s1[j] = b * b; }
        st_bf8(U + (size_t)row * DFF + c, s0, s1);
    }
};
struct EResX {
    float* X; bf16* XB;
    __device__ __forceinline__ void operator()(int row, int c, f32x4 v0, f32x4 v1) const {
        float* p = X + (size_t)row * 1024 + c; const f32x4 o0 = *(const f32x4*)p + v0, o1 = *(const f32x4*)(p + 4) + v1; *(f32x4*)p = o0; *(f32x4*)(p + 4) = o1;
        st_bf8(XB + (size_t)row * 1024 + c, o0, o1);
    }
};
struct EPle {
    float* X; const bf16* P;
    __device__ __forceinline__ void operator()(int row, int c, f32x4 v0, f32x4 v1) const {
        float* p = X + (size_t)row * 1024 + c; f32x4 p0, p1; ld_bf8(P + (size_t)row * 1024 + c, p0, p1); f32x4 o0 = *(const f32x4*)p, o1 = *(const f32x4*)(p + 4);
#pragma unroll
        for (int j = 0; j < 4; ++j) { o0[j] += sigmoidf_(v0[j]) * p0[j]; o1[j] += sigmoidf_(v1[j]) * p1[j]; }
        *(f32x4*)p = o0; *(f32x4*)(p + 4) = o1;
    }
};

enum { K_IN = 0, K_P = 1, K_MIXA = 2, K_MIXB = 3 };
struct EpiG1 {
    EIn e; EStoreBf ep;
    __device__ __forceinline__ void operator()(f32x4 (&acc)[2][2][4][2], const pg8::Unit& u, int wr, int wc, int fr, int fq) const {
        if (u.kind == K_P) { pg8::for_tile(acc, u, wr, wc, fr, fq, [&](int r, int c, f32x4& a, f32x4& b) { ep(r, c, a, b); }); return; }
        switch (EIn::seg_of(u.pn * 256)) {
            case 0: pg8::for_tile(acc, u, wr, wc, fr, fq, [&](int r, int c, f32x4& a, f32x4& b) { e.seg<0>(r, c, a, b); }); break;
            case 1: pg8::for_tile(acc, u, wr, wc, fr, fq, [&](int r, int c, f32x4& a, f32x4& b) { e.seg<1>(r, c, a, b); }); break;
            case 2: pg8::for_tile(acc, u, wr, wc, fr, fq, [&](int r, int c, f32x4& a, f32x4& b) { e.seg<2>(r, c, a, b); }); break;
            case 3: pg8::for_tile(acc, u, wr, wc, fr, fq, [&](int r, int c, f32x4& a, f32x4& b) { e.seg<3>(r, c, a, b); }); break;
            case 4: pg8::for_tile(acc, u, wr, wc, fr, fq, [&](int r, int c, f32x4& a, f32x4& b) { e.seg<4>(r, c, a, b); }); break;
            case 5: pg8::for_tile(acc, u, wr, wc, fr, fq, [&](int r, int c, f32x4& a, f32x4& b) { e.seg<5>(r, c, a, b); }); break;
            case 6: pg8::for_tile(acc, u, wr, wc, fr, fq, [&](int r, int c, f32x4& a, f32x4& b) { e.seg<6>(r, c, a, b); }); break;
            case 7: pg8::for_tile(acc, u, wr, wc, fr, fq, [&](int r, int c, f32x4& a, f32x4& b) { e.seg<7>(r, c, a, b); }); break;
            default: pg8::for_tile(acc, u, wr, wc, fr, fq, [&](int r, int c, f32x4& a, f32x4& b) { e.seg<8>(r, c, a, b); }); break;
        }
    }
};
struct SchedG1 {
    int G, c; const char *HN, *WIN, *PB, *WPL;
    __device__ __forceinline__ bool next(int i, pg8::Unit& u) const {
        constexpr int NMAIN = 64 * 38;
        long L = (long)i * G + c;
        if (L >= NMAIN && G == 256 && i == 10) L = (long)i * G + ((c + 128) & 255);
        if (L < NMAIN) { int pm, pn; pg8::tile_of((int)L, 64, 38, pm, pn); u.A = HN + (size_t)pm * 256 * 1024 * 2; u.B = WIN + (size_t)pn * 256 * 1024 * 2; u.lda = 1024; u.ldb = 1024; u.nt = 16; u.pm = pm; u.pn = pn; u.kind = K_IN; u.keep = 0; return true; }
        L -= NMAIN; if (L >= 256) return false;
        const int pm = (int)(L >> 2), pn = (int)(L & 3);
        u.A = PB + (size_t)pm * 256 * DPLE * 2; u.B = WPL + (size_t)pn * 256 * DPLE * 2; u.lda = DPLE; u.ldb = DPLE; u.nt = 4; u.pm = pm; u.pn = pn; u.kind = K_P; u.keep = 0; return true;
    }
};
template <class F> struct EpiSimple {
    F f;
    __device__ __forceinline__ void operator()(f32x4 (&acc)[2][2][4][2], const pg8::Unit& u, int wr, int wc, int fr, int fq) const {
        pg8::for_tile(acc, u, wr, wc, fr, fq, [&](int r, int c, f32x4& a, f32x4& b) { f(r, c, a, b); });
    }
};
struct SchedPlain {
    int G, c, nN, K; const char *A, *B;
    __device__ __forceinline__ bool next(int i, pg8::Unit& u) const {
        const long L = (long)i * G + c; if (L >= 64 * nN) return false;
        int pm, pn; pg8::tile_of((int)L, 64, nN, pm, pn);
        u.A = A + (size_t)pm * 256 * K * 2; u.B = B + (size_t)pn * 256 * K * 2; u.lda = K; u.ldb = K; u.nt = K / 64; u.pm = pm; u.pn = pn; u.kind = 0; u.keep = 0; return true;
    }
};
struct EpiMix {
    const bf16 *SGR, *SGA; bf16* MIX;
    __device__ __forceinline__ void operator()(f32x4 (&acc)[2][2][4][2], const pg8::Unit& u, int wr, int wc, int fr, int fq) const {
        if (u.kind == K_MIXA) pg8::for_tile(acc, u, wr, wc, fr, fq, [&](int r, int c, f32x4& a, f32x4& b) {
            f32x4 r0, r1, a0, a1; ld_bf8(SGR + (size_t)r * 1024 + c, r0, r1); ld_bf8(SGA + (size_t)r * 1024 + c, a0, a1);
#pragma unroll
            for (int j = 0; j < 4; ++j) { a[j] *= r0[j] / a0[j]; b[j] *= r1[j] / a1[j]; } });
        else pg8::for_tile(acc, u, wr, wc, fr, fq, [&](int r, int c, f32x4& a, f32x4& b) {
            f32x4 a0, a1; ld_bf8(SGA + (size_t)r * 1024 + c, a0, a1); st_bf8(MIX + (size_t)r * 1024 + c, a * a0, b * a1); });
    }
};
struct SchedMix {
    int G, c; const char *ARET, *WRB, *AATT, *WAB;
    __device__ __forceinline__ bool next(int i, pg8::Unit& u) const {
        const int tile = (i >> 1) * G + c; if (tile >= 256) return false;
        int pm, pn; pg8::tile_of(tile, 64, 4, pm, pn); u.pm = pm; u.pn = pn;
        if ((i & 1) == 0) { u.A = ARET + (size_t)pm * 256 * 1024 * 2; u.B = WRB + (size_t)pn * 256 * 1024 * 2; u.lda = 1024; u.ldb = 1024; u.nt = 16; u.kind = K_MIXA; u.keep = 1; }
        else { u.A = AATT + (size_t)pm * 256 * 512 * 2; u.B = WAB + (size_t)pn * 256 * 512 * 2; u.lda = 512; u.ldb = 512; u.nt = 8; u.kind = K_MIXB; u.keep = 0; }
        return true;
    }
};

#define MFMA32(a, b, c) __builtin_amdgcn_mfma_f32_32x32x16_bf16((a), (b), (c), 0, 0, 0)
__device__ __forceinline__ bf16x8 pack8(const float* v) { u32x4 w; w.x = pk2(v[0], v[1]); w.y = pk2(v[2], v[3]); w.z = pk2(v[4], v[5]); w.w = pk2(v[6], v[7]); return __builtin_bit_cast(bf16x8, w); }
__device__ __forceinline__ bf16x8 ld_2x4(const bf16* p) { const u32x2 lo = *(const u32x2*)p, hi = *(const u32x2*)(p + 8); u32x4 w; w.x = lo.x; w.y = lo.y; w.z = hi.x; w.w = hi.y; return __builtin_bit_cast(bf16x8, w); }

__device__ __forceinline__ void attn_tile(int item, const bf16* __restrict__ AQ, const bf16* __restrict__ AK, const bf16* __restrict__ AVT, bf16* __restrict__ OG, float* __restrict__ LSE, const LAS float* biasl, int lane) {
    const int q32 = item & 3, idx16 = (item >> 2) & 15, h = (item >> 6) & 3, gb = item >> 8, b = gb & 7, g = gb >> 3;
    const int sh = 2 * g, dil = 1 << sh, L = SEQ >> sh, nbs = 4 - sh;
    const int s = idx16 >> nbs, q0 = (idx16 & ((1 << nbs) - 1)) * 128 + q32 * 32;
    const int r = lane & 31, hh = lane >> 5;
    const size_t rowbase = (size_t)b * SEQ + s;
    const int colq = g * 512 + h * 128 + hh * 8;
    bf16x8 qf[8];
    { const bf16* qp = AQ + (rowbase + (size_t)dil * (q0 + r)) * 1536 + colq;
#pragma unroll
      for (int ks = 0; ks < 8; ++ks) qf[ks] = *(const bf16x8*)(qp + ks * 16); }
    f32x16 O[4];
#pragma unroll
    for (int dt = 0; dt < 4; ++dt)
#pragma unroll
        for (int q = 0; q < 16; ++q) O[dt][q] = 0.f;
    float m = -INFINITY, l = 0.f;
    const LAS float* bl = biasl + (g * 4 + h) * 128;
    const bf16* vbase = AVT + ((size_t)((b * 3 + g) * 4 + h) * 128 + r) * SEQ + (size_t)s * L + 4 * hh;
    for (int kb = 0; kb < 5; ++kb) {
        const int kbase = q0 - 128 + 32 * kb;
        if (kbase < 0) continue;
        const bf16* kp = AK + (rowbase + (size_t)dil * (kbase + r)) * 1536 + colq;
        f32x16 S;
#pragma unroll
        for (int q = 0; q < 16; ++q) S[q] = 0.f;
#pragma unroll
        for (int ks = 0; ks < 8; ++ks) { const bf16x8 kf = *(const bf16x8*)(kp + ks * 16); S = MFMA32(kf, qf[ks], S); }
        const int jd0 = q0 + r - kbase - 4 * hh;
        float sv[16]; float mx = -INFINITY;
#pragma unroll
        for (int q = 0; q < 16; ++q) { const int jd = jd0 - ((q & 3) + 8 * (q >> 2)); const bool ok = (unsigned)jd <= 127u; const float bv = bl[ok ? jd : 0]; sv[q] = ok ? S[q] + bv : -INFINITY; mx = fmaxf(mx, sv[q]); }
        mx = fmaxf(mx, __shfl_xor(mx, 32));
        const float mn = fmaxf(m, mx), ms = (mn == -INFINITY) ? 0.f : mn;
        const float alpha = exp2f(m - ms);
        float rs = 0.f;
#pragma unroll
        for (int q = 0; q < 16; ++q) { sv[q] = exp2f(sv[q] - ms); rs += sv[q]; }
        rs += __shfl_xor(rs, 32);
        l = l * alpha + rs; m = mn;
#pragma unroll
        for (int dt = 0; dt < 4; ++dt) O[dt] *= alpha;
        const bf16x8 pb0 = pack8(sv), pb1 = pack8(sv + 8);
#pragma unroll
        for (int dt = 0; dt < 4; ++dt) {
            const bf16* vp = vbase + (size_t)dt * 32 * SEQ + kbase;
            O[dt] = MFMA32(ld_2x4(vp), pb0, O[dt]);
            O[dt] = MFMA32(ld_2x4(vp + 16), pb1, O[dt]);
        }
    }
    const float inv = 1.0f / l;
    const size_t row = rowbase + (size_t)dil * (q0 + r);
    bf16* op = OG + ((size_t)g * MT + row) * 512 + h * 128 + 4 * hh;
#pragma unroll
    for (int dt = 0; dt < 4; ++dt)
#pragma unroll
        for (int rg = 0; rg < 4; ++rg) st_bf4(op + dt * 32 + 8 * rg, (f32x4){O[dt][4 * rg] * inv, O[dt][4 * rg + 1] * inv, O[dt][4 * rg + 2] * inv, O[dt][4 * rg + 3] * inv});
    if (hh == 0) LSE[((size_t)g * MT + row) * 4 + h] = m + log2f(l);
}

__device__ __forceinline__ void ret_kv_tile(int item, const bf16* __restrict__ KT, const bf16* __restrict__ RVT, float* __restrict__ KV, const f32x2* __restrict__ dec, int lane) {
    const int vt = item & 3, c = (item >> 2) & 15, bh = item >> 6, h = bh & 7, r = lane & 31, hh = lane >> 5;
    const bf16* ka = KT + ((size_t)bh * 64 + r) * SEQ + c * 128 + hh * 8;
    const bf16* vb = RVT + ((size_t)bh * 128 + vt * 32 + r) * SEQ + c * 128 + hh * 8;
    f32x16 D0, D1;
#pragma unroll
    for (int q = 0; q < 16; ++q) { D0[q] = 0.f; D1[q] = 0.f; }
#pragma unroll
    for (int s = 0; s < 8; ++s) {
        const bf16x8 a0 = *(const bf16x8*)(ka + 16 * s), a1 = *(const bf16x8*)(ka + (size_t)32 * SEQ + 16 * s), bv = *(const bf16x8*)(vb + 16 * s);
        D0 = MFMA32(a0, bv, D0); D1 = MFMA32(a1, bv, D1);
    }
    const float g127 = dec[h * 128 + 127].x;
    float* o = KV + ((size_t)(bh * 16 + c) * 64) * 128 + vt * 32 + r;
#pragma unroll
    for (int q = 0; q < 16; ++q) { const int pq = (q & 3) + 8 * (q >> 2) + 4 * hh; o[(size_t)pq * 128] = D0[q] * g127; o[(size_t)(32 + pq) * 128] = D1[q] * g127; }
}

__device__ __forceinline__ void ret_out_tile(int item, const bf16* __restrict__ RQ, const bf16* __restrict__ RK, const bf16* __restrict__ RVT, const bf16* __restrict__ ST,
                                             const bf16* __restrict__ RG, const float* __restrict__ gn, bf16* __restrict__ ARET, int lane) {
    const int qb = item & 3, c = (item >> 2) & 15, bh = item >> 6, b = bh >> 3, h = bh & 7, r = lane & 31, hh = lane >> 5;
    const size_t row = (size_t)b * SEQ + c * 128 + qb * 32 + r;
    bf16x8 qf[4];
    { const bf16* qp = RQ + row * 512 + h * 64 + hh * 8;
#pragma unroll
      for (int ks = 0; ks < 4; ++ks) qf[ks] = *(const bf16x8*)(qp + ks * 16); }
    f32x16 O[4];
#pragma unroll
    for (int vt = 0; vt < 4; ++vt)
#pragma unroll
        for (int q = 0; q < 16; ++q) O[vt][q] = 0.f;
    const bf16* vbase = RVT + ((size_t)bh * 128 + r) * SEQ + c * 128 + 4 * hh;
    for (int kb = 0; kb <= qb; ++kb) {
        const bf16* kp = RK + ((size_t)b * SEQ + c * 128 + kb * 32 + r) * 512 + h * 64 + hh * 8;
        f32x16 X;
#pragma unroll
        for (int q = 0; q < 16; ++q) X[q] = 0.f;
#pragma unroll
        for (int ks = 0; ks < 4; ++ks) { const bf16x8 kf = *(const bf16x8*)(kp + ks * 16); X = MFMA32(kf, qf[ks], X); }
        float xv[16];
#pragma unroll
        for (int q = 0; q < 16; ++q) { const int kk = (q & 3) + 8 * (q >> 2) + 4 * hh; xv[q] = (kb == qb && kk > r) ? 0.f : X[q]; }
        const bf16x8 pb0 = pack8(xv), pb1 = pack8(xv + 8);
#pragma unroll
        for (int vt = 0; vt < 4; ++vt) {
            const bf16* vp = vbase + (size_t)vt * 32 * SEQ + kb * 32;
            O[vt] = MFMA32(ld_2x4(vp), pb0, O[vt]);
            O[vt] = MFMA32(ld_2x4(vp + 16), pb1, O[vt]);
        }
    }
    if (c > 0) {
        const bf16* sp = ST + (((size_t)bh * 16 + c) * 128 + r) * 64 + hh * 8;
#pragma unroll
        for (int ks = 0; ks < 4; ++ks)
#pragma unroll
            for (int vt = 0; vt < 4; ++vt) { const bf16x8 sf = *(const bf16x8*)(sp + (size_t)vt * 32 * 64 + ks * 16); O[vt] = MFMA32(sf, qf[ks], O[vt]); }
    }
    float sum = 0.f;
#pragma unroll
    for (int vt = 0; vt < 4; ++vt)
#pragma unroll
        for (int q = 0; q < 16; ++q) sum += O[vt][q];
    sum += __shfl_xor(sum, 32);
    const float mu = sum * (1.f / 128.f);
    float sq = 0.f;
#pragma unroll
    for (int vt = 0; vt < 4; ++vt)
#pragma unroll
        for (int q = 0; q < 16; ++q) { const float d = O[vt][q] - mu; sq += d * d; }
    sq += __shfl_xor(sq, 32);
    const float rstd = rsqrtf(sq * (1.f / 128.f) + NORM_EPS);
    const size_t ob = row * 1024 + h * 128 + 4 * hh;
#pragma unroll
    for (int vt = 0; vt < 4; ++vt)
#pragma unroll
        for (int rg = 0; rg < 4; ++rg) {
            const int vo = vt * 32 + 8 * rg;
            const f32x4 gate = ld_bf4(RG + ob + vo), gg = *(const f32x4*)(gn + h * 128 + 4 * hh + vo);
            f32x4 o;
#pragma unroll
            for (int j = 0; j < 4; ++j) o[j] = gate[j] * (O[vt][4 * rg + j] - mu) * rstd * gg[j];
            st_bf4(ARET + ob + vo, o);
        }
}

template <bool PERM>
__device__ __forceinline__ void transpose_item(const float* __restrict__ W, int K, int N, bf16* __restrict__ WT, LAS float* scr, int item, int lane) {
    const int nblk = N / 32, kb = item / nblk, nb = item % nblk, k0 = 64 * kb, n0 = 32 * nb;
    int srcc = n0 + (lane & 31);
    if (PERM && n0 < 1024) srcc = (n0 & ~63) + ((n0 & 32) >> 1) + ((lane & 31) >> 1) + 32 * (lane & 1);
#pragma unroll 8
    for (int i = 0; i < 32; ++i) { const int kk = 2 * i + (lane >> 5); scr[kk * 33 + (lane & 31)] = W[(size_t)(k0 + kk) * N + srcc]; }
    asm volatile("s_waitcnt lgkmcnt(0)" ::: "memory");
    const int c = lane & 7;
#pragma unroll
    for (int j = 0; j < 4; ++j) { const int n = (lane >> 3) + 8 * j; const LAS float* s = scr + (8 * c) * 33 + n;
        u32x4 o; o.x = pk2(s[0 * 33], s[1 * 33]); o.y = pk2(s[2 * 33], s[3 * 33]); o.z = pk2(s[4 * 33], s[5 * 33]); o.w = pk2(s[6 * 33], s[7 * 33]);
        *(u32x4*)(WT + (size_t)(n0 + n) * K + k0 + 8 * c) = o; }
    asm volatile("s_waitcnt lgkmcnt(0)" ::: "memory");
}
__device__ __forceinline__ void rms_row_to_bf16(const float* __restrict__ xrow, const float* __restrict__ g, bf16* __restrict__ orow, int lane) {
    f32x4 v[4]; float s = 0.f;
#pragma unroll
    for (int j = 0; j < 4; ++j) { v[j] = *(const f32x4*)(xrow + 4 * lane + 256 * j); s += (v[j][0] * v[j][0] + v[j][1] * v[j][1]) + (v[j][2] * v[j][2] + v[j][3] * v[j][3]); }
    const float r = rsqrtf(wave_sum(s) * (1.f / 1024.f) + NORM_EPS);
#pragma unroll
    for (int j = 0; j < 4; ++j) { const f32x4 gg = *(const f32x4*)(g + 4 * lane + 256 * j); st_bf4(orow + 4 * lane + 256 * j, v[j] * r * gg); }
}

#define XB_TMO      128
#define XB_XCNT(j)  (256  + 64 * (j))
#define XB_XSUB(j)  (1280 + 64 * (j))
#define XB_XGEN(j)  (2304 + 64 * (j))
#define XB_TOP      3328
#define XB_TOPGEN   3392
#define XCD_BAR_WORDS 3456
#define XB_SPIN_CAP (1u << 18)
__device__ __forceinline__ unsigned xb_ld(unsigned* p)              { return __hip_atomic_load(p, __ATOMIC_RELAXED, __HIP_MEMORY_SCOPE_AGENT); }
__device__ __forceinline__ unsigned xb_add(unsigned* p, unsigned v) { return __hip_atomic_fetch_add(p, v, __ATOMIC_RELAXED, __HIP_MEMORY_SCOPE_AGENT); }
__device__ __forceinline__ unsigned xb_xcc_id() { return (unsigned)__builtin_amdgcn_s_getreg((3 << 11) | 20) & 0xFu; }
#define XB_SPIN(cond, bar) do { unsigned _sp = 0; while (cond) { __builtin_amdgcn_s_sleep(1); \
    if ((++_sp & 255u) == 0u) { if (xb_ld(&(bar)[XB_TMO])) break; if (_sp > XB_SPIN_CAP) { atomicAdd(&(bar)[XB_TMO], 1u); break; } } } } while (0)
struct XcdBarrier { unsigned* bar; unsigned x; volatile LAS unsigned* st; };
__device__ __forceinline__ XcdBarrier xcd_barrier_post(unsigned* bar, volatile LAS unsigned* st) {
    XcdBarrier b; b.bar = bar; b.x = xb_xcc_id(); b.st = st;
    if (threadIdx.x == 0) (void)xb_add(&bar[XB_XCNT(b.x)], 1u);
    return b;
}
__device__ __forceinline__ void xcd_barrier_complete(unsigned* bar, unsigned x, unsigned& nloc, unsigned& nx) {
    const unsigned G = gridDim.x * gridDim.y * gridDim.z;
    unsigned sum, cnt, mine, sp = 0u;
    for (;;) {
        sum = 0u; cnt = 0u; mine = 0u;
#pragma unroll
        for (unsigned j = 0; j < 16; ++j) { const unsigned c = xb_ld(&bar[XB_XCNT(j)]); sum += c; cnt += (c > 0u) ? 1u : 0u; mine = (j == x) ? c : mine; }
        if (sum == G) break;
        __builtin_amdgcn_s_sleep(1);
        if ((++sp & 255u) == 0u) { if (xb_ld(&bar[XB_TMO])) break; if (sp > XB_SPIN_CAP) { atomicAdd(&bar[XB_TMO], 1u); break; } }
    }
    nloc = mine > 0u ? mine : 1u; nx = cnt > 0u ? cnt : 1u;
}
__device__ __forceinline__ void xcd_barrier(const XcdBarrier& b) {
    asm volatile("s_waitcnt vmcnt(0)" ::: "memory");
    __syncthreads();
    if (threadIdx.x == 0) {
        unsigned* bar = b.bar;
        __builtin_amdgcn_s_waitcnt(0);
        unsigned nloc = b.st[0], nx = b.st[1];
        if (nloc == 0u) { xcd_barrier_complete(bar, b.x, nloc, nx); b.st[0] = nloc; b.st[1] = nx; }
        const unsigned old = xb_add(&bar[XB_XSUB(b.x)], 1u);
        const unsigned gen = old / nloc;
        if (old + 1u == (gen + 1u) * nloc) {
            __builtin_amdgcn_fence(__ATOMIC_RELEASE, "agent");
            asm volatile("s_waitcnt vmcnt(0)" ::: "memory");
            const unsigned og = xb_add(&bar[XB_TOP], 1u);
            const unsigned tg = og / nx;
            if (og + 1u == (tg + 1u) * nx) xb_add(&bar[XB_TOPGEN], 1u);
            else XB_SPIN(xb_ld(&bar[XB_TOPGEN]) == tg, bar);
            __builtin_amdgcn_fence(__ATOMIC_ACQUIRE, "agent");
            xb_add(&bar[XB_XGEN(b.x)], 1u);
            asm volatile("s_waitcnt vmcnt(0)" ::: "memory");
        } else {
            XB_SPIN(xb_ld(&bar[XB_XGEN(b.x)]) == gen, bar);
            __builtin_amdgcn_fence(__ATOMIC_ACQUIRE, "agent");
            asm volatile("s_waitcnt vmcnt(0)" ::: "memory");
        }
    }
    __syncthreads();
}

constexpr int NPHASE = 12;
__global__ void __launch_bounds__(NTHREADS, 2) fwd_kernel(Params p) {
    extern __shared__ __attribute__((aligned(16))) unsigned char lds_raw[];
    LAS unsigned char* lds = (LAS unsigned char*)lds_raw;
    volatile LAS unsigned* bst = (volatile LAS unsigned*)(lds + 131072 + 1024);
    if (threadIdx.x == 0) { bst[0] = 0u; bst[1] = 0u; bst[2] = 0u; bst[3] = 0u; }
    __syncthreads();
    const XcdBarrier gbar = xcd_barrier_post((unsigned*)(p.ws + WS_CTL) + 4096, bst);
    const int G = gridDim.x, nw = G * NWAVES;
    const size_t nthr = (size_t)G * NTHREADS;
#define PHASE_IDS int tid = threadIdx.x; asm volatile("" : "+v"(tid)); const int lane = tid & 63, wave = tid >> 6, gw = blockIdx.x * NWAVES + wave; const size_t gtid = (size_t)blockIdx.x * NTHREADS + tid; (void)lane; (void)wave; (void)gw; (void)gtid;
    unsigned char* ws = p.ws; float* out = p.out;
    const f32x2* rope = (const f32x2*)(ws + WS_ROPE);
    float* bias2 = (float*)(ws + WS_BIAS);
    const f32x2* dec = (const f32x2*)(ws + WS_DEC);
    bf16* WIN = (bf16*)(ws + WS_WIN); bf16* WRB = (bf16*)(ws + WS_WRB); bf16* WAB = (bf16*)(ws + WS_WAB); bf16* WO = (bf16*)(ws + WS_WO);
    bf16* WU = (bf16*)(ws + WS_WU); bf16* WD = (bf16*)(ws + WS_WD); bf16* WPL = (bf16*)(ws + WS_WPL); bf16* WPG = (bf16*)(ws + WS_WPG);
    bf16* HN = (bf16*)(ws + WS_HN); float* KV = (float*)(ws + WS_HN); bf16* ARET = HN; bf16* PB = (bf16*)(ws + WS_PB); bf16* P = (bf16*)(ws + WS_P);
    bf16* RQ = (bf16*)(ws + WS_RQ); bf16* RK = (bf16*)(ws + WS_RK); bf16* RVT = (bf16*)(ws + WS_RVT); bf16* MIX = RVT; bf16* KT = (bf16*)(ws + WS_KT);
    bf16* RVS = (bf16*)(ws + WS_RVS); bf16* AVS = (bf16*)(ws + WS_AVS); float* ROS = (float*)(ws + WS_ROS);
    bf16* RG = (bf16*)(ws + WS_RG); bf16* H2 = RG; bf16* AQ = (bf16*)(ws + WS_AQ); bf16* ST = AQ; bf16* AK = (bf16*)(ws + WS_AK); bf16* AATT = AK; bf16* AVT = (bf16*)(ws + WS_AVT); bf16* U = AQ;
    bf16* SGR = (bf16*)(ws + WS_SGR); bf16* X2B = SGR; bf16* SGA = (bf16*)(ws + WS_SGA); bf16* OG = (bf16*)(ws + WS_OG); float* LSE = (float*)(ws + WS_LSE);
    float* X = out + O_Y;
    const int lo = p.ph_lo, hi = p.ph_hi;
#define IN(k) (lo <= (k) && (k) < hi)
#define SEAM(k) do { if (IN(k) && IN((k) + 1)) xcd_barrier(gbar); } while (0)

    if (IN(0)) { PHASE_IDS
        LAS float* scr = (LAS float*)(lds + wave * 16384);
        constexpr int I_IN = 16 * (NIN / 32), I_RB = 16 * 32, I_AB = 8 * 32, I_O = 16 * 32, I_U = 16 * 128, I_D = 64 * 32, I_PL = 4 * 32, I_PG = 16 * 32;
        constexpr int NITEMS = I_IN + I_RB + I_AB + I_O + I_U + I_D + I_PL + I_PG;
        for (int it = gw; it < NITEMS; it += nw) {
            int r = it;
            if (r < I_IN) { transpose_item<true>(p.in[I_WIN], 1024, NIN, WIN, scr, r, lane); continue; } r -= I_IN;
            if (r < I_RB) { transpose_item<false>(p.in[I_WRB], 1024, 1024, WRB, scr, r, lane); continue; } r -= I_RB;
            if (r < I_AB) { transpose_item<false>(p.in[I_WAB], 512, 1024, WAB, scr, r, lane); continue; } r -= I_AB;
            if (r < I_O) { transpose_item<false>(p.in[I_WO], 1024, 1024, WO, scr, r, lane); continue; } r -= I_O;
            if (r < I_U) { transpose_item<false>(p.in[I_WU], 1024, DFF, WU, scr, r, lane); continue; } r -= I_U;
            if (r < I_D) { transpose_item<false>(p.in[I_WD], DFF, 1024, WD, scr, r, lane); continue; } r -= I_D;
            if (r < I_PL) { transpose_item<false>(p.in[I_WPL], DPLE, 1024, WPL, scr, r, lane); continue; } r -= I_PL;
            transpose_item<false>(p.in[I_WPG], 1024, 1024, WPG, scr, r, lane);
        }
        for (int m = gw; m < MT; m += nw) {
            const float* xr = m < MP ? p.in[I_XP] + (size_t)m * 1024 : p.in[I_XS] + (size_t)(m - MP) * 1024;
            rms_row_to_bf16(xr, p.in[I_LN1], HN + (size_t)m * 1024, lane);
            const float* pr = m < MP ? p.in[I_PP] + (size_t)m * DPLE : p.in[I_PS] + (size_t)(m - MP) * DPLE;
            st_bf4(PB + (size_t)m * DPLE + 4 * lane, *(const f32x4*)(pr + 4 * lane));
        }
        for (size_t i = gtid; i < (size_t)2049 * 32; i += nthr) {
            const int tp = (int)(i >> 5), j = (int)(i & 31);
            const float pos = tp < SEQ ? (float)tp : 16384.0f;
            const float inv = exp2f(-(float)j * (13.287712379549449f / 32.0f));
            const float ang = pos * inv;
            double rev = (double)ang * 0.15915494309189535; rev -= floor(rev);
            const float rr = (float)(rev * 6.283185307179586 - 3.141592653589793);
            float sn, cs; __sincosf(rr, &sn, &cs);
            ((f32x2*)(ws + WS_ROPE))[i] = (f32x2){-cs, -sn};
        }
        for (size_t i = gtid; i < 12 * 128; i += nthr) {
            const int gh = (int)(i >> 7), j = (int)(i & 127), g = gh >> 2;
            const int d = j * dil_of(g);
            int bkt;
            if (d < 16) bkt = d;
            else { const float lr = logf((float)d / 16.0f) / 4.852030263919617f; bkt = 16 + (int)(lr * 16.0f); bkt = bkt < 31 ? bkt : 31; }
            bias2[i] = p.in[I_RELB][bkt * 12 + gh] * LOG2E;
        }
        for (size_t i = gtid; i < 8 * 128; i += nthr) {
            const int h = (int)(i >> 7), j = (int)(i & 127);
            const float lg = log2f(1.0f - exp2f(-5.0f - (float)h));
            ((f32x2*)(ws + WS_DEC))[i] = (f32x2){exp2f((float)j * lg), exp2f(-(float)j * lg)};
        }
        for (int a = 0; a < 6; ++a) {
            const int g = a >> 1, isv = a & 1, W = win_of(g);
            const f32x4* src = (const f32x4*)p.in[I_CK128 + a]; f32x4* dst = (f32x4*)(out + okvs(g, isv));
            const size_t per = (size_t)(W - 1) * 128, tot = per * SB;
            for (size_t i = gtid; i < tot; i += nthr) { const size_t bs = i / per, r = i - bs * per; dst[bs * (size_t)W * 128 + r] = src[bs * (size_t)W * 128 + 128 + r]; }
        }
    }
    SEAM(0);

    if (IN(1)) { PHASE_IDS
        const EIn e{RQ, RK, KT, RVT, RVS, RG, AQ, AK, AVT, AVS, SGR, SGA, rope, dec, out}; const EStoreBf ep{P, 1024};
        { const EpiG1 E{e, ep}; const SchedG1 S{G, (int)blockIdx.x, (const char*)HN, (const char*)WIN, (const char*)PB, (const char*)WPL}; pg8::gemm_phase(lds, S, E); }
        const int s0 = (G == 256) ? (int)blockIdx.x - 128 : (int)blockIdx.x, sn = (G == 256) ? 128 : G;
        if (s0 >= 0) for (int t = s0; t < 168; t += sn) {
            if (t < 152) sample_tile(lds, HN + (size_t)MP * 1024, 1024, WIN, 1024, 1024, t, e);
            else sample_tile(lds, PB + (size_t)MP * DPLE, DPLE, WPL, DPLE, DPLE, t - 152, ep);
        }
    }
    SEAM(1);

    if (IN(2)) { PHASE_IDS
        LAS float* biasl = (LAS float*)lds;
        LAS float* qs = biasl + 12 * 128;
        LAS float* sc = qs + 128;
        LAS float* red = sc + 128;
        for (int i = tid; i < 12 * 128; i += NTHREADS) biasl[i] = bias2[i];
        __syncthreads();
        for (int it = blockIdx.x; it < 3 * SB * 4; it += G) {
            const int g = it / (SB * 4), rem = it - g * (SB * 4), bs = rem >> 2, h = rem & 3, dil = dil_of(g), W = win_of(g);
            const size_t row = (size_t)MP + bs;
            const float* ck = p.in[I_CK128 + 2 * g] + (size_t)bs * W * 512 + h * 128;
            const float* cv = p.in[I_CV128 + 2 * g] + (size_t)bs * W * 512 + h * 128;
            if (tid < 64) { const unsigned w = *(const unsigned*)(AQ + row * 1536 + g * 512 + h * 128 + 2 * tid); qs[2 * tid] = bflo(w); qs[2 * tid + 1] = bfhi(w); }
            __syncthreads();
            {
                const int j = tid >> 2, part = tid & 3;
                float acc = 0.f;
                if (j == 0) {
                    const bf16* kp = AK + row * 1536 + g * 512 + h * 128 + part * 32;
#pragma unroll
                    for (int c8 = 0; c8 < 4; ++c8) { f32x4 k0, k1; ld_bf8(kp + c8 * 8, k0, k1); const f32x4 q0 = *(const LAS f32x4*)(qs + part * 32 + c8 * 8), q1 = *(const LAS f32x4*)(qs + part * 32 + c8 * 8 + 4);
                        acc += k0[0] * q0[0] + k0[1] * q0[1] + k0[2] * q0[2] + k0[3] * q0[3] + k1[0] * q1[0] + k1[1] * q1[1] + k1[2] * q1[2] + k1[3] * q1[3]; }
                } else {
                    const f32x4* kp = (const f32x4*)(ck + (size_t)(W - j * dil) * 512 + part * 32);
                    f32x4 kv[8];
#pragma unroll
                    for (int c4 = 0; c4 < 8; ++c4) kv[c4] = kp[c4];
#pragma unroll
                    for (int c4 = 0; c4 < 8; ++c4) { const f32x4 q0 = *(const LAS f32x4*)(qs + part * 32 + c4 * 4); acc += kv[c4][0] * q0[0] + kv[c4][1] * q0[1] + kv[c4][2] * q0[2] + kv[c4][3] * q0[3]; }
                }
                acc += __shfl_xor(acc, 1); acc += __shfl_xor(acc, 2);
                if (part == 0) sc[j] = acc + biasl[(g * 4 + h) * 128 + j];
            }
            __syncthreads();
            if (tid < 64) {
                const float s0 = sc[tid], s1 = sc[tid + 64];
                const float m = wave_max(fmaxf(s0, s1));
                const float p0 = exp2f(s0 - m), p1 = exp2f(s1 - m);
                const float den = wave_sum(p0 + p1), inv = 1.0f / den;
                sc[tid] = p0 * inv; sc[tid + 64] = p1 * inv;
                if (tid == 0) LSE[((size_t)g * MT + row) * 4 + h] = m + log2f(den);
            }
            __syncthreads();
            {
                const int d = tid & 127, kq = tid >> 7;
                float vv[32];
#pragma unroll
                for (int u = 0; u < 32; ++u) { const int j = kq * 32 + u; vv[u] = (j == 0) ? bf2f(AVS[(size_t)bs * 1536 + g * 512 + h * 128 + d]) : cv[(size_t)(W - j * dil) * 512 + d]; }
                float o = 0.f;
#pragma unroll
                for (int u = 0; u < 32; ++u) o += sc[kq * 32 + u] * vv[u];
                red[kq * 128 + d] = o;
            }
            __syncthreads();
            if (tid < 64) {
                const float o0 = (red[2 * tid] + red[128 + 2 * tid]) + (red[256 + 2 * tid] + red[384 + 2 * tid]);
                const float o1 = (red[2 * tid + 1] + red[128 + 2 * tid + 1]) + (red[256 + 2 * tid + 1] + red[384 + 2 * tid + 1]);
                *(unsigned*)(OG + ((size_t)g * MT + row) * 512 + h * 128 + 2 * tid) = pk2(o0, o1);
            }
            __syncthreads();
        }
        if (tid < 128) for (size_t it = (size_t)blockIdx.x * 128 + tid; it < (size_t)SB * 8 * 128; it += (size_t)G * 128) {
            const int bs = (int)(it >> 10), h = (int)(it >> 7) & 7, v = (int)(it & 127);
            const float gamma = 1.0f - exp2f(-5.0f - (float)h);
            const size_t row = (size_t)MP + bs;
            const float vv = bf2f(RVS[(size_t)bs * 1024 + h * 128 + v]);
            const float* si = p.in[I_STATE] + ((size_t)(bs * 8 + h) * 64) * 128 + v;
            float* so = out + O_STS + ((size_t)(bs * 8 + h) * 64) * 128 + v;
            float o = 0.f;
#pragma unroll 16
            for (int k = 0; k < 64; ++k) {
                const int ko = (k >> 1) + 32 * (k & 1);
                const float s = gamma * si[(size_t)ko * 128] + bf2f(RK[row * 512 + h * 64 + k]) * vv;
                o += bf2f(RQ[row * 512 + h * 64 + k]) * s;
                so[(size_t)ko * 128] = s;
            }
            ROS[(size_t)bs * 1024 + h * 128 + v] = o;
        }
        for (int it = gw; it < 3 * NB * 4 * 16 * 4; it += nw) attn_tile(it, AQ, AK, AVT, OG, LSE, biasl, lane);
        for (int it = gw; it < NB * 8 * 16 * 4; it += nw) ret_kv_tile(it, KT, RVT, KV, dec, lane);
    }
    SEAM(2);

    if (IN(3)) { PHASE_IDS
        {
            const int h = lane >> 4, co = h * 128 + (lane & 15) * 8;
#pragma unroll 2
            for (int row = gw; row < MT; row += nw) {
                const float l0 = LSE[((size_t)0 * MT + row) * 4 + h], l1 = LSE[((size_t)1 * MT + row) * 4 + h], l2 = LSE[((size_t)2 * MT + row) * 4 + h];
                const size_t off = (size_t)row * 512 + co;
                f32x4 a0, a1, b0, b1, c0, c1; ld_bf8(OG + (size_t)0 * MT * 512 + off, a0, a1); ld_bf8(OG + (size_t)1 * MT * 512 + off, b0, b1); ld_bf8(OG + (size_t)2 * MT * 512 + off, c0, c1);
                const float mx = fmaxf(l0, fmaxf(l1, l2));
                float w0 = exp2f(l0 - mx), w1 = exp2f(l1 - mx), w2 = exp2f(l2 - mx); const float inv = 1.0f / (w0 + w1 + w2); w0 *= inv; w1 *= inv; w2 *= inv;
                st_bf8(AATT + off, a0 * w0 + b0 * w1 + c0 * w2, a1 * w0 + b1 * w1 + c1 * w2);
            }
        }
        for (size_t it = gtid; it < (size_t)64 * 8 * 128; it += nthr) {
            const int v = (int)(it & 127), pc = (int)(it >> 7) & 7, bh = (int)(it >> 10), h = bh & 7;
            const float gamma = dec[h * 128 + 1].x, g128 = dec[h * 128 + 127].x * gamma;
            float S[8];
#pragma unroll
            for (int j = 0; j < 8; ++j) S[j] = 0.f;
            for (int c0 = 0; c0 < 16; c0 += 4) {
                float kv[4][8];
#pragma unroll
                for (int cc = 0; cc < 4; ++cc) { const float* kvp = KV + ((size_t)(bh * 16 + c0 + cc) * 64 + pc * 8) * 128 + v;
#pragma unroll
                    for (int j = 0; j < 8; ++j) kv[cc][j] = kvp[(size_t)j * 128]; }
#pragma unroll
                for (int cc = 0; cc < 4; ++cc) { const int c = c0 + cc;
#pragma unroll
                    for (int j = 0; j < 8; ++j) S[j] = g128 * S[j] + kv[cc][j];
                    if (c < 15) st_bf8(ST + (((size_t)bh * 16 + (c + 1)) * 128 + v) * 64 + pc * 8, (f32x4){gamma * S[0], gamma * S[1], gamma * S[2], gamma * S[3]}, (f32x4){gamma * S[4], gamma * S[5], gamma * S[6], gamma * S[7]}); }
            }
            float* so = out + O_STP + ((size_t)bh * 64) * 128 + v;
#pragma unroll
            for (int j = 0; j < 8; ++j) { const int pq = pc * 8 + j; so[(size_t)((pq >> 1) + 32 * (pq & 1)) * 128] = S[j]; }
        }
    }
    SEAM(3);

    if (IN(4)) { PHASE_IDS
        for (int it = gw; it < NB * 8 * 16 * 4; it += nw) ret_out_tile(it, RQ, RK, RVT, ST, RG, p.in[I_GN], ARET, lane);
        const float* gn = p.in[I_GN];
        for (int it = gw; it < SB * 8; it += nw) {
            const int bs = it >> 3, h = it & 7;
            const size_t base = (size_t)(MP + bs) * 1024 + h * 128, sb = (size_t)bs * 1024 + h * 128;
            const float x0 = ROS[sb + lane], x1 = ROS[sb + 64 + lane];
            const float mu = wave_sum(x0 + x1) * (1.f / 128.f);
            const float d0 = x0 - mu, d1 = x1 - mu;
            const float r = rsqrtf(wave_sum(d0 * d0 + d1 * d1) * (1.f / 128.f) + NORM_EPS);
            ARET[base + lane] = (bf16)f2bf(bf2f(RG[base + lane]) * d0 * r * gn[h * 128 + lane]);
            ARET[base + 64 + lane] = (bf16)f2bf(bf2f(RG[base + 64 + lane]) * d1 * r * gn[h * 128 + 64 + lane]);
        }
    }
    SEAM(4);

    if (IN(5)) {
        for (int t = blockIdx.x; t < 16; t += G) {
            f32x4 r0 = (f32x4){0.f, 0.f, 0.f, 0.f}, r1 = r0;
            sample_tile(lds, ARET + (size_t)MP * 1024, 1024, WRB, 1024, 1024, t, [&](int, int, f32x4 v0, f32x4 v1) { r0 = v0; r1 = v1; });
            sample_tile(lds, AATT + (size_t)MP * 512, 512, WAB, 512, 512, t, [&](int row, int c, f32x4 v0, f32x4 v1) {
                f32x4 g0, g1, a0, a1; ld_bf8(SGR + (size_t)row * 1024 + c, g0, g1); ld_bf8(SGA + (size_t)row * 1024 + c, a0, a1);
                st_bf8(MIX + (size_t)row * 1024 + c, g0 * r0 + a0 * v0, g1 * r1 + a1 * v1); });
        }
        const EpiMix E{SGR, SGA, MIX}; const SchedMix S{G, (int)blockIdx.x, (const char*)ARET, (const char*)WRB, (const char*)AATT, (const char*)WAB};
        pg8::gemm_phase(lds, S, E);
    }
    SEAM(5);
    if (IN(6)) {
        const EResIn e{p.in[I_XP], p.in[I_XS], X};
        for (int t = blockIdx.x; t < 16; t += G) sample_tile(lds, MIX + (size_t)MP * 1024, 1024, WO, 1024, 1024, t, e);
        const EpiSimple<EResIn> E{e}; const SchedPlain S{G, (int)blockIdx.x, 4, 1024, (const char*)MIX, (const char*)WO}; pg8::gemm_phase(lds, S, E);
    }
    SEAM(6);
    if (IN(7)) { PHASE_IDS for (int m = gw; m < MT; m += nw) rms_row_to_bf16(X + (size_t)m * 1024, p.in[I_LN2], H2 + (size_t)m * 1024, lane); }
    SEAM(7);
    if (IN(8)) {
        const ERelu2 e{U};
        for (int t = blockIdx.x; t < 64; t += G) sample_tile(lds, H2 + (size_t)MP * 1024, 1024, WU, 1024, 1024, t, e);
        const EpiSimple<ERelu2> E{e}; const SchedPlain S{G, (int)blockIdx.x, 16, 1024, (const char*)H2, (const char*)WU}; pg8::gemm_phase(lds, S, E);
    }
    SEAM(8);
    if (IN(9)) {
        const EResX e{X, X2B};
        for (int t = blockIdx.x; t < 16; t += G) sample_tile(lds, U + (size_t)MP * DFF, DFF, WD, DFF, DFF, t, e);
        const EpiSimple<EResX> E{e}; const SchedPlain S{G, (int)blockIdx.x, 4, DFF, (const char*)U, (const char*)WD}; pg8::gemm_phase(lds, S, E);
    }
    SEAM(9);
    if (IN(10)) {
        const EPle e{X, P};
        for (int t = blockIdx.x; t < 16; t += G) sample_tile(lds, X2B + (size_t)MP * 1024, 1024, WPG, 1024, 1024, t, e);
        const EpiSimple<EPle> E{e}; const SchedPlain S{G, (int)blockIdx.x, 4, 1024, (const char*)X2B, (const char*)WPG}; pg8::gemm_phase(lds, S, E);
    }
    SEAM(10);
    if (IN(11)) { PHASE_IDS
        const float* g = p.in[I_LNF];
        for (int m = gw; m < MT; m += nw) {
            float* xr = X + (size_t)m * 1024;
            f32x4 v[4]; float s = 0.f;
#pragma unroll
            for (int j = 0; j < 4; ++j) { v[j] = *(const f32x4*)(xr + 4 * lane + 256 * j); s += (v[j][0] * v[j][0] + v[j][1] * v[j][1]) + (v[j][2] * v[j][2] + v[j][3] * v[j][3]); }
            const float r = rsqrtf(wave_sum(s) * (1.f / 1024.f) + NORM_EPS);
#pragma unroll
            for (int j = 0; j < 4; ++j) { const f32x4 gg = *(const f32x4*)(g + 4 * lane + 256 * j); *(f32x4*)(xr + 4 * lane + 256 * j) = v[j] * r * gg; }
        }
    }
#undef IN
#undef SEAM
}

#ifndef MK_N_LAUNCHES
#define MK_N_LAUNCHES 1
#endif
extern "C" void kernel_launch(void* const* d_in, const int* in_sizes, int n_in, void* d_out, int out_size, void* d_ws, size_t ws_size, hipStream_t stream) {
    static int grid = 0;
    if (grid == 0) {
        if (n_in != 24 || (size_t)out_size != O_END || ws_size < WS_END) { fprintf(stderr, "kernel_launch: unexpected problem shape (n_in %d out %d ws %zu)\n", n_in, out_size, ws_size); grid = -1; return; }
        int dev = 0, cus = 0, per_cu = 0;
        if (hipGetDevice(&dev) != hipSuccess || hipDeviceGetAttribute(&cus, hipDeviceAttributeMultiprocessorCount, dev) != hipSuccess) { grid = -1; return; }
        if (hipFuncSetAttribute((const void*)fwd_kernel, hipFuncAttributeMaxDynamicSharedMemorySize, LDS_BYTES) != hipSuccess) { fprintf(stderr, "kernel_launch: hipFuncSetAttribute failed\n"); grid = -1; return; }
        if (hipOccupancyMaxActiveBlocksPerMultiprocessor(&per_cu, (const void*)fwd_kernel, NTHREADS, LDS_BYTES) != hipSuccess || per_cu < 1) { fprintf(stderr, "kernel_launch: occupancy query failed (%d)\n", per_cu); (void)hipGetLastError(); per_cu = 1; }
        grid = cus * (per_cu < 1 ? 1 : (per_cu > 1 ? 1 : per_cu));
    }
    if (grid < 0) return;
    (void)hipMemsetAsync((char*)d_ws + WS_CTL, 0, CTL_ZERO_BYTES, stream);
    Params p{};
    for (int i = 0; i < 24; ++i) p.in[i] = (const float*)d_in[i];
    p.out = (float*)d_out; p.ws = (unsigned char*)d_ws;
#if MK_N_LAUNCHES == 1
    p.ph_lo = 0; p.ph_hi = NPHASE;
    void* args[] = {&p};
    hipError_t e = hipLaunchCooperativeKernel((const void*)fwd_kernel, dim3(grid), dim3(NTHREADS), args, LDS_BYTES, stream);
    if (e != hipSuccess) fprintf(stderr, "kernel_launch: cooperative launch failed: %s (grid %d)\n", hipGetErrorString(e), grid);
#else
    for (int k = 0; k < NPHASE; ++k) { p.ph_lo = k; p.ph_hi = k + 1; hipLaunchKernelGGL(fwd_kernel, dim3(grid), dim3(NTHREADS), LDS_BYTES, stream, p); }
#endif
}
```

```cpp
#include <hip/hip_runtime.h>
#include <cstdio>
#include <cstdint>

#define LAS __attribute__((address_space(3)))
typedef unsigned short bf16;
typedef short bf16x8 __attribute__((ext_vector_type(8)));
typedef float f32x4 __attribute__((ext_vector_type(4)));
typedef float f32x2 __attribute__((ext_vector_type(2)));
typedef unsigned u32x4 __attribute__((ext_vector_type(4)));
typedef unsigned u32x2 __attribute__((ext_vector_type(2)));
typedef float f32x2_t_ __attribute__((ext_vector_type(2)));
typedef float f32x16 __attribute__((ext_vector_type(16)));

constexpr int D = 1024, NB = 8, SEQ = 2048, MP = NB * SEQ, SB = 32, MT = MP + SB, MPAD = 16640;
constexpr int NIN = 9728, DFF = 4096, DPLE = 256;
constexpr int NWAVES = 8, NTHREADS = NWAVES * 64;
constexpr int LDS_BYTES = 147456;
constexpr float NORM_EPS = 1e-6f;
constexpr float LOG2E = 1.4426950408889634f;
constexpr float QSCALE = 0.08838834764831845f * LOG2E;

constexpr size_t O_Y = 0;
constexpr size_t O_STP = (size_t)MT * 1024;
constexpr size_t O_KVP0 = O_STP + 524288;
constexpr size_t O_STS = O_KVP0 + 2 * 524288 + 2 * 2097152 + 2 * 8388608;
constexpr size_t O_KVS0 = O_STS + 2097152;
constexpr size_t O_END = O_KVS0 + 2 * 2097152 + 2 * 8388608 + 2 * 33554432;
static_assert(O_END == 129531904, "d_out size");
__host__ __device__ constexpr int win_of(int g) { return g == 0 ? 128 : (g == 1 ? 512 : 2048); }
__host__ __device__ constexpr int dil_of(int g) { return g == 0 ? 1 : (g == 1 ? 4 : 16); }
__host__ __device__ constexpr size_t okvp(int g, int isv) {
    return O_KVP0 + (g == 0 ? 0 : (g == 1 ? 2 * 524288 : 2 * 524288 + 2 * 2097152)) + (size_t)isv * (size_t)NB * win_of(g) * 512;
}
__host__ __device__ constexpr size_t okvs(int g, int isv) {
    return O_KVS0 + (g == 0 ? 0 : (g == 1 ? 2 * 2097152 : 2 * 2097152 + 2 * 8388608)) + (size_t)isv * (size_t)SB * win_of(g) * 512;
}

constexpr size_t MiB = 1u << 20;
constexpr size_t WS_CTL = 0, CTL_ZERO_BYTES = 1 * MiB;
constexpr size_t WS_ROPE = 1 * MiB;
constexpr size_t WS_BIAS = 1 * MiB + 640 * 1024;
constexpr size_t WS_DEC = 1 * MiB + 704 * 1024;
constexpr size_t WS_WIN = 2 * MiB;
constexpr size_t WS_WRB = 21 * MiB;
constexpr size_t WS_WAB = 23 * MiB;
constexpr size_t WS_WO = 24 * MiB;
constexpr size_t WS_WU = 26 * MiB;
constexpr size_t WS_WD = 34 * MiB;
constexpr size_t WS_WPL = 42 * MiB;
constexpr size_t WS_WPG = 43 * MiB;
constexpr size_t WS_ROS = 45 * MiB;
constexpr size_t WS_HN = 46 * MiB;
constexpr size_t WS_PB = 79 * MiB;
constexpr size_t WS_P = 88 * MiB;
constexpr size_t WS_RQ = 121 * MiB;
constexpr size_t WS_RK = 138 * MiB;
constexpr size_t WS_RV = 155 * MiB;
constexpr size_t WS_RG = 188 * MiB;
constexpr size_t WS_AQ = 221 * MiB;
constexpr size_t WS_AK = 270 * MiB;
constexpr size_t WS_AV = 319 * MiB;
constexpr size_t WS_SGR = 368 * MiB;
constexpr size_t WS_SGA = 401 * MiB;
constexpr size_t WS_OG = 434 * MiB;
constexpr size_t WS_LSE = 483 * MiB;
constexpr size_t WS_END = 484 * MiB;
static_assert(WS_AQ + (size_t)MT * 4096 * 2 <= WS_SGR, "U overlay");
static_assert((size_t)MT * 1024 * 2 <= 33 * MiB && (size_t)MT * 512 * 2 <= 17 * MiB && (size_t)MT * 1536 * 2 <= 49 * MiB, "slots");

__device__ __forceinline__ unsigned f2bf(float f) { unsigned u = __float_as_uint(f); return (u + 0x7fffu + ((u >> 16) & 1u)) >> 16; }
__device__ __forceinline__ float bf2f(unsigned b) { return __uint_as_float(b << 16); }
typedef __bf16 bf16x2_t __attribute__((ext_vector_type(2)));
__device__ __forceinline__ unsigned pk2(float lo, float hi) { const f32x2_t_ v = {lo, hi}; const bf16x2_t b = __builtin_convertvector(v, bf16x2_t); return __builtin_bit_cast(unsigned, b); }
__device__ __forceinline__ float bflo(unsigned w) { return __uint_as_float(w << 16); }
__device__ __forceinline__ float bfhi(unsigned w) { return __uint_as_float(w & 0xffff0000u); }
__device__ __forceinline__ float wave_sum(float v) {
#pragma unroll
    for (int o = 1; o < 64; o <<= 1) v += __shfl_xor(v, o);
    return v;
}
__device__ __forceinline__ float wave_max(float v) {
#pragma unroll
    for (int o = 1; o < 64; o <<= 1) v = fmaxf(v, __shfl_xor(v, o));
    return v;
}
__device__ __forceinline__ float sigmoidf_(float v) { return 1.0f / (1.0f + __expf(-v)); }
__device__ __forceinline__ void st_bf4(bf16* p, f32x4 v) { u32x2 w; w.x = pk2(v[0], v[1]); w.y = pk2(v[2], v[3]); *(u32x2*)p = w; }
__device__ __forceinline__ f32x4 ld_bf4(const bf16* p) { const u32x2 w = *(const u32x2*)p; return (f32x4){bflo(w.x), bfhi(w.x), bflo(w.y), bfhi(w.y)}; }

struct Params {
    const float* in[24];
    float* out;
    unsigned char* ws;
    int ph_lo, ph_hi;
};
enum { I_XP = 0, I_XS, I_STATE, I_CK128, I_CV128, I_CK512, I_CV512, I_CK2K, I_CV2K, I_PP, I_PS, I_LN1, I_WIN, I_GN, I_WRB, I_WAB, I_WO, I_LN2, I_WU, I_WD, I_WPL, I_WPG, I_RELB, I_LNF };

__device__ __forceinline__ void st_bf8(bf16* p, f32x4 a, f32x4 b) { u32x4 w; w.x = pk2(a[0], a[1]); w.y = pk2(a[2], a[3]); w.z = pk2(b[0], b[1]); w.w = pk2(b[2], b[3]); *(u32x4*)p = w; }
__device__ __forceinline__ void ld_bf8(const bf16* p, f32x4& a, f32x4& b) { const u32x4 w = *(const u32x4*)p; a = (f32x4){bflo(w.x), bfhi(w.x), bflo(w.y), bfhi(w.y)}; b = (f32x4){bflo(w.z), bfhi(w.z), bflo(w.w), bfhi(w.w)}; }

namespace pg8 {
typedef bf16 bf16_t;
constexpr int BM = 256, BK = 64, HALF = 128, HTB = HALF * BK * 2, STAGE_BYTES = 8 * HTB, NXCD = 8, WGM = 8;
__host__ __device__ __forceinline__ int lds_byte(int r, int c) { const int st = (r >> 4) * 2 + (c >> 5), rr = r & 15, cc = c & 31, ob = rr * 64 + cc * 2; return st * 1024 + (ob ^ (((ob >> 9) & 1) << 5)); }
__host__ __device__ __forceinline__ void stage_rc(int b, int& R, int& C) { const int st = b / 1024, sb = b % 1024, swz = sb ^ (((sb >> 9) & 1) << 5); R = (st >> 1) * 16 + swz / 64; C = (st & 1) * 32 + (swz % 64) / 2; }
__host__ __device__ __forceinline__ int perm32(int rho) { const int n = rho >> 4, i = rho & 15; return 8 * (i >> 2) + 4 * n + (i & 3); }
struct Unit { const char* A; const char* B; int lda, ldb, nt, pm, pn, kind, keep; };
__device__ __forceinline__ void tile_of(int L, int nM, int nN, int& pm, int& pn) {
    const int nwg = nM * nN; int wgid = L; { const int q = nwg / NXCD, r = nwg % NXCD, xcd = wgid % NXCD, off = wgid / NXCD; wgid = (xcd < r ? xcd * (q + 1) : r * (q + 1) + (xcd - r) * q) + off; }
    const int nig = WGM * nN, gid = wgid / nig, fm = gid * WGM, gsz = (nM - fm) < WGM ? (nM - fm) : WGM;
    pm = fm + ((wgid % nig) % gsz); pn = (wgid % nig) / gsz;
}
template <class F> __device__ __forceinline__ void for_tile(f32x4 (&acc)[2][2][4][2], const Unit& u, int wr, int wc, int fr, int fq, const F& f) {
#pragma unroll
    for (int ai = 0; ai < 2; ++ai)
#pragma unroll
        for (int m = 0; m < 4; ++m) { const int row = u.pm * BM + ai * HALF + wr * 64 + m * 16 + fr;
#pragma unroll
            for (int bj = 0; bj < 2; ++bj) f(row, u.pn * BM + bj * HALF + wc * 32 + 8 * fq, acc[ai][bj][m][0], acc[ai][bj][m][1]); }
}
template <class Epi, class Sched>
__device__ __forceinline__ void gemm_phase(LAS unsigned char* lds, const Sched& S, const Epi& E) {
    const int tid = threadIdx.x, wid = __builtin_amdgcn_readfirstlane(tid >> 6), lane = tid & 63, wr = wid >> 2, wc = wid & 3, fr = lane & 15, fq = lane >> 4;
    unsigned RA[2], RB[2], CC[2];
#pragma unroll
    for (int i = 0; i < 2; ++i) { int R, C; stage_rc(tid * 16 + i * 8192, R, C); RA[i] = 2u * (unsigned)R; RB[i] = 2u * (unsigned)((R & ~31) + perm32(R & 31)); CC[i] = 2u * (unsigned)C; }
    const size_t kstep = (size_t)(BK * 2);
    const unsigned ldsw = (unsigned)wid * 1024u;
    const int aoff = lds_byte(wr * 64 + fr, fq * 8), boff = lds_byte(wc * 32 + fr, fq * 8);
#define PG8_SA(b, h) (((b) * 2 + (h)) * HTB)
#define PG8_SB(b, h) ((4 + (b) * 2 + (h)) * HTB)
#define PG8_STAGE(bufoff, gbase, RR, ld) do { _Pragma("unroll") for (int _i = 0; _i < 2; ++_i) \
        __builtin_amdgcn_global_load_lds((const unsigned*)((const char*)(gbase) + (RR[_i] * (unsigned)(ld) + CC[_i])), (LAS unsigned*)(lds + (bufoff) + ldsw + _i * 8192), 16, 0, 0); } while (0)
#define PG8_LDA(dst, b, h) do { _Pragma("unroll") for (int m = 0; m < 4; ++m) _Pragma("unroll") for (int k = 0; k < 2; ++k) dst[m][k] = *(const LAS bf16x8*)(lds + PG8_SA(b, h) + aoff + m * 2048 + k * 1024); } while (0)
#define PG8_LDB(dst, b, h) do { _Pragma("unroll") for (int n = 0; n < 2; ++n) _Pragma("unroll") for (int k = 0; k < 2; ++k) dst[n][k] = *(const LAS bf16x8*)(lds + PG8_SB(b, h) + boff + n * 2048 + k * 1024); } while (0)
#define PG8_MMA(ai, bj, At, Bt) do { __builtin_amdgcn_s_setprio(1); _Pragma("unroll") for (int m = 0; m < 4; ++m) _Pragma("unroll") for (int n = 0; n < 2; ++n) _Pragma("unroll") for (int k = 0; k < 2; ++k) \
        acc[ai][bj][m][n] = __builtin_amdgcn_mfma_f32_16x16x32_bf16(Bt[n][k], At[m][k], acc[ai][bj][m][n], 0, 0, 0); __builtin_amdgcn_s_setprio(0); } while (0)
#define PG8_WAIT_V(n) asm volatile("s_waitcnt vmcnt(" #n ")" ::: "memory")
#define PG8_WAIT_L(n) asm volatile("s_waitcnt lgkmcnt(" #n ")" ::: "memory")
#define PG8_BAR __builtin_amdgcn_s_barrier()
#define PG8_SCHED __builtin_amdgcn_sched_barrier(0)
    Unit cur, nxt; int ui = 0;
    if (!S.next(0, cur)) return;
    f32x4 acc[2][2][4][2];
#pragma unroll
    for (int a = 0; a < 2; ++a)
#pragma unroll
        for (int b = 0; b < 2; ++b)
#pragma unroll
            for (int m = 0; m < 4; ++m)
#pragma unroll
                for (int n = 0; n < 2; ++n) acc[a][b][m][n] = (f32x4){0.f, 0.f, 0.f, 0.f};
    bf16x8 At[4][2], B0[2][2], B1[2][2];
    int ldAc = cur.lda, ldBc = cur.ldb;
    const char* cA = cur.A; const char* cB = cur.B;
#define HA(ld) ((size_t)HALF * 2 * (size_t)(ld))
    PG8_STAGE(PG8_SB(0, 0), cB, RB, ldBc); PG8_STAGE(PG8_SB(0, 1), cB + HA(ldBc), RB, ldBc); PG8_STAGE(PG8_SA(0, 0), cA, RA, ldAc); PG8_STAGE(PG8_SA(0, 1), cA + HA(ldAc), RA, ldAc);
    if (wr == 1) PG8_BAR;
    PG8_WAIT_V(2); PG8_BAR;
    PG8_STAGE(PG8_SB(1, 0), cB + kstep, RB, ldBc); PG8_STAGE(PG8_SA(1, 0), cA + kstep, RA, ldAc); PG8_STAGE(PG8_SB(1, 1), cB + HA(ldBc) + kstep, RB, ldBc);
    PG8_WAIT_V(6); PG8_BAR;
    for (;;) {
        const bool has_next = S.next(ui + 1, nxt);
        const char* nA = cA; const char* nB = cB; int ldAn = ldAc, ldBn = ldBc;
        if (has_next) { nA = nxt.A; nB = nxt.B; ldAn = nxt.lda; ldBn = nxt.ldb; }
        const int nt = cur.nt;
        for (int t = 0; t < nt; t += 2) {
            const bool last = (t == nt - 2);
            const char* a1 = cA + (size_t)(t + 1) * kstep;
            const char* a2 = last ? nA : cA + (size_t)(t + 2) * kstep; const char* b2 = last ? nB : cB + (size_t)(t + 2) * kstep;
            const char* a3 = a2 + kstep; const char* b3 = b2 + kstep;
            const int ldA2 = last ? ldAn : ldAc, ldB2 = last ? ldBn : ldBc;
            PG8_LDB(B0, 0, 0); PG8_LDB(B1, 0, 1); PG8_SCHED; PG8_LDA(At, 0, 0); PG8_STAGE(PG8_SA(1, 1), a1 + HA(ldAc), RA, ldAc);
            PG8_WAIT_V(8); PG8_WAIT_L(0); PG8_BAR; PG8_MMA(0, 0, At, B0); PG8_MMA(0, 1, At, B1); PG8_BAR; PG8_SCHED;
            PG8_LDA(At, 0, 1); PG8_STAGE(PG8_SB(0, 0), b2, RB, ldB2); PG8_STAGE(PG8_SB(0, 1), b2 + HA(ldB2), RB, ldB2); PG8_STAGE(PG8_SA(0, 0), a2, RA, ldA2);
            PG8_WAIT_V(8); PG8_WAIT_L(0); PG8_BAR; PG8_MMA(1, 0, At, B0); PG8_MMA(1, 1, At, B1); PG8_BAR; PG8_SCHED;
            PG8_LDB(B0, 1, 0); PG8_LDB(B1, 1, 1); PG8_SCHED; PG8_LDA(At, 1, 0); PG8_STAGE(PG8_SA(0, 1), a2 + HA(ldA2), RA, ldA2);
            PG8_WAIT_V(8); PG8_WAIT_L(0); PG8_BAR; PG8_MMA(0, 0, At, B0); PG8_MMA(0, 1, At, B1); PG8_BAR; PG8_SCHED;
            PG8_LDA(At, 1, 1); PG8_STAGE(PG8_SB(1, 0), b3, RB, ldB2); PG8_STAGE(PG8_SB(1, 1), b3 + HA(ldB2), RB, ldB2); PG8_STAGE(PG8_SA(1, 0), a3, RA, ldA2);
            PG8_WAIT_V(8); PG8_WAIT_L(0); PG8_BAR; PG8_MMA(1, 0, At, B0); PG8_MMA(1, 1, At, B1); PG8_BAR; PG8_SCHED;
        }
        if (wr == 0) PG8_BAR;
        E(acc, cur, wr, wc, fr, fq);
        if (!has_next) break;
        if (!cur.keep) {
#pragma unroll
            for (int a = 0; a < 2; ++a)
#pragma unroll
                for (int b = 0; b < 2; ++b)
#pragma unroll
                    for (int m = 0; m < 4; ++m)
#pragma unroll
                        for (int n = 0; n < 2; ++n) acc[a][b][m][n] = (f32x4){0.f, 0.f, 0.f, 0.f};
        }
        cur = nxt; cA = nA; cB = nB; ldAc = ldAn; ldBc = ldBn; ++ui;
        if (wr == 1) PG8_BAR;
    }
    PG8_WAIT_V(0);
    PG8_BAR;
#undef PG8_SA
#undef PG8_SB
#undef PG8_STAGE
#undef PG8_LDA
#undef PG8_LDB
#undef PG8_MMA
#undef PG8_WAIT_V
#undef PG8_WAIT_L
#undef PG8_BAR
#undef PG8_SCHED
#undef HA
}
}

template <class F>
__device__ __forceinline__ void sample_tile(LAS unsigned char* lds, const bf16* __restrict__ A, int lda, const bf16* __restrict__ Bt, int ldb, int K, int tile, const F& f) {
    const int tid = threadIdx.x, lane = tid & 63, wave = tid >> 6, fr = lane & 15, fq = lane >> 4;
    f32x4 acc[2][4];
#pragma unroll
    for (int a = 0; a < 2; ++a)
#pragma unroll
        for (int b = 0; b < 4; ++b) acc[a][b] = (f32x4){0.f, 0.f, 0.f, 0.f};
    const int kw = K / 8;
    const bf16* ap = A + (size_t)fr * lda + wave * kw + fq * 8;
    const bf16* bp = Bt + (size_t)(tile * 64 + fr) * ldb + wave * kw + fq * 8;
    for (int k0 = 0; k0 < kw; k0 += 32) {
        bf16x8 a[2], b[4];
#pragma unroll
        for (int mi = 0; mi < 2; ++mi) a[mi] = *(const bf16x8*)(ap + (size_t)mi * 16 * lda + k0);
#pragma unroll
        for (int ni = 0; ni < 4; ++ni) b[ni] = *(const bf16x8*)(bp + (size_t)ni * 16 * ldb + k0);
#pragma unroll
        for (int mi = 0; mi < 2; ++mi)
#pragma unroll
            for (int ni = 0; ni < 4; ++ni) acc[mi][ni] = __builtin_amdgcn_mfma_f32_16x16x32_bf16(b[ni], a[mi], acc[mi][ni], 0, 0, 0);
    }
    LAS float* part = (LAS float*)lds;
#pragma unroll
    for (int mi = 0; mi < 2; ++mi)
#pragma unroll
        for (int ni = 0; ni < 4; ++ni) *(LAS f32x4*)(part + ((size_t)wave * 32 + mi * 16 + fr) * 68 + ni * 16 + fq * 4) = acc[mi][ni];
    __syncthreads();
    if (tid < 256) {
        const int row = tid >> 3, cg = (tid & 7) * 8;
        f32x4 v0 = (f32x4){0.f, 0.f, 0.f, 0.f}, v1 = v0;
#pragma unroll
        for (int w = 0; w < 8; ++w) { v0 += *(const LAS f32x4*)(part + ((size_t)w * 32 + row) * 68 + cg); v1 += *(const LAS f32x4*)(part + ((size_t)w * 32 + row) * 68 + cg + 4); }
        f(MP + row, tile * 64 + cg, v0, v1);
    }
    __syncthreads();
}

struct EIn {
    bf16 *RQ, *RK, *RV, *RG, *AQ, *AK, *AV, *SGR, *SGA; const f32x2* rope; const f32x2* dec; float* out;
    template <int SEG> __device__ __forceinline__ void seg(int row, int c, f32x4 v0, f32x4 v1) const {
        if (SEG == 0 || SEG == 1) {
            const int cc = c & 511, h = cc >> 6, tp = row < MP ? (row & (SEQ - 1)) : SEQ, i0 = (cc & 63) >> 1;
            const f32x4 r0 = *(const f32x4*)(rope + tp * 32 + i0), r1 = *(const f32x4*)(rope + tp * 32 + i0 + 2);
            const f32x2 dd = dec[h * 128 + (row < MP ? (row & 127) : 0)];
            const float sc = SEG == 1 ? 0.125f * dd.y : dd.x;
            f32x4 o0, o1;
            o0[0] = v0[0] * r0[0] - v0[1] * r0[1]; o0[1] = v0[0] * r0[1] + v0[1] * r0[0]; o0[2] = v0[2] * r0[2] - v0[3] * r0[3]; o0[3] = v0[2] * r0[3] + v0[3] * r0[2];
            o1[0] = v1[0] * r1[0] - v1[1] * r1[1]; o1[1] = v1[0] * r1[1] + v1[1] * r1[0]; o1[2] = v1[2] * r1[2] - v1[3] * r1[3]; o1[3] = v1[2] * r1[3] + v1[3] * r1[2];
            o0 *= sc; o1 *= sc;
            st_bf8((SEG == 1 ? RK : RQ) + (size_t)row * 512 + cc, o0, o1);
        } else if (SEG == 2) {
            st_bf8(RV + (size_t)row * 1024 + (c - 1024), v0, v1);
        } else if (SEG == 3) {
            f32x4 s0, s1;
#pragma unroll
            for (int j = 0; j < 4; ++j) { s0[j] = v0[j] * sigmoidf_(v0[j]); s1[j] = v1[j] * sigmoidf_(v1[j]); }
            st_bf8(RG + (size_t)row * 1024 + (c - 2048), s0, s1);
        } else if (SEG == 4) {
            st_bf8(AQ + (size_t)row * 1536 + (c - 3072), v0 * QSCALE, v1 * QSCALE);
        } else if (SEG == 5 || SEG == 6) {
            const int isv = SEG == 6; const int cc = c - (isv ? 6144 : 4608); const int g = cc >> 9, hc = cc & 511;
            const int W = win_of(g);
            float* dst = nullptr;
            if (row < MP) { const int t = row & (SEQ - 1), b = row >> 11; if (t >= SEQ - W) dst = out + okvp(g, isv) + ((size_t)(b * W + t - (SEQ - W)) * 512 + hc); }
            else { const int bs = row - MP; dst = out + okvs(g, isv) + ((size_t)(bs * W + (W - 1)) * 512 + hc); }
            if (dst) { *(f32x4*)dst = v0; *(f32x4*)(dst + 4) = v1; }
            st_bf8((isv ? AV : AK) + (size_t)row * 1536 + cc, v0, v1);
        } else {
            f32x4 s0, s1;
#pragma unroll
            for (int j = 0; j < 4; ++j) { s0[j] = sigmoidf_(v0[j]); s1[j] = sigmoidf_(v1[j]); }
            st_bf8((SEG == 8 ? SGA : SGR) + (size_t)row * 1024 + (c - (SEG == 8 ? 8704 : 7680)), s0, s1);
        }
    }
    __device__ __forceinline__ static int seg_of(int c) { return c < 512 ? 0 : c < 1024 ? 1 : c < 2048 ? 2 : c < 3072 ? 3 : c < 4608 ? 4 : c < 6144 ? 5 : c < 7680 ? 6 : c < 8704 ? 7 : 8; }
    __device__ __forceinline__ void operator()(int row, int c, f32x4 v0, f32x4 v1) const {
        switch (seg_of(c)) { case 0: seg<0>(row, c, v0, v1); break; case 1: seg<1>(row, c, v0, v1); break; case 2: seg<2>(row, c, v0, v1); break; case 3: seg<3>(row, c, v0, v1); break;
            case 4: seg<4>(row, c, v0, v1); break; case 5: seg<5>(row, c, v0, v1); break; case 6: seg<6>(row, c, v0, v1); break; case 7: seg<7>(row, c, v0, v1); break; default: seg<8>(row, c, v0, v1); break; }
    }
};
struct EStoreBf { bf16* O; int ld; __device__ __forceinline__ void operator()(int row, int c, f32x4 v0, f32x4 v1) const { st_bf8(O + (size_t)row * ld + c, v0, v1); } };
struct EResIn {
    const float *xp, *xs; float* X;
    __device__ __forceinline__ void operator()(int row, int c, f32x4 v0, f32x4 v1) const {
        const float* src = row < MP ? xp + (size_t)row * 1024 + c : xs + (size_t)(row - MP) * 1024 + c; float* d = X + (size_t)row * 1024 + c;
        *(f32x4*)d = *(const f32x4*)src + v0; *(f32x4*)(d + 4) = *(const f32x4*)(src + 4) + v1;
    }
};
struct ERelu2 {
    bf16* U;
    __device__ __forceinline__ void operator()(int row, int c, f32x4 v0, f32x4 v1) const {
        f32x4 s0, s1;
#pragma unroll
        for (int j = 0; j < 4; ++j) { const float a = fmaxf(v0[j], 0.f), b = fmaxf(v1[j], 0.f); s0[j] = a * a; s1[j] = b * b; }
        st_bf8(U + (size_t)row * DFF + c, s0, s1);
    }
};
struct EResX {
    float* X; bf16* XB;
    __device__ __forceinline__ void operator()(int row, int c, f32x4 v0, f32x4 v1) const {
        float* p = X + (size_t)row * 1024 + c; const f32x4 o0 = *(const f32x4*)p + v0, o1 = *(const f32x4*)(p + 4) + v1; *(f32x4*)p = o0; *(f32x4*)(p + 4) = o1;
        st_bf8(XB + (size_t)row * 1024 + c, o0, o1);
    }
};
struct EPle {
    float* X; const bf16* P;
    __device__ __forceinline__ void operator()(int row, int c, f32x4 v0, f32x4 v1) const {
        float* p = X + (size_t)row * 1024 + c; f32x4 p0, p1; ld_bf8(P + (size_t)row * 1024 + c, p0, p1); f32x4 o0 = *(const f32x4*)p, o1 = *(const f32x4*)(p + 4);
#pragma unroll
        for (int j = 0; j < 4; ++j) { o0[j] += sigmoidf_(v0[j]) * p0[j]; o1[j] += sigmoidf_(v1[j]) * p1[j]; }
        *(f32x4*)p = o0; *(f32x4*)(p + 4) = o1;
    }
};

enum { K_IN = 0, K_P = 1, K_MIXA = 2, K_MIXB = 3 };
struct EpiG1 {
    EIn e; EStoreBf ep;
    __device__ __forceinline__ void operator()(f32x4 (&acc)[2][2][4][2], const pg8::Unit& u, int wr, int wc, int fr, int fq) const {
        if (u.kind == K_P) { pg8::for_tile(acc, u, wr, wc, fr, fq, [&](int r, int c, f32x4& a, f32x4& b) { ep(r, c, a, b); }); return; }
        switch (EIn::seg_of(u.pn * 256)) {
            case 0: pg8::for_tile(acc, u, wr, wc, fr, fq, [&](int r, int c, f32x4& a, f32x4& b) { e.seg<0>(r, c, a, b); }); break;
            case 1: pg8::for_tile(acc, u, wr, wc, fr, fq, [&](int r, int c, f32x4& a, f32x4& b) { e.seg<1>(r, c, a, b); }); break;
            case 2: pg8::for_tile(acc, u, wr, wc, fr, fq, [&](int r, int c, f32x4& a, f32x4& b) { e.seg<2>(r, c, a, b); }); break;
            case 3: pg8::for_tile(acc, u, wr, wc, fr, fq, [&](int r, int c, f32x4& a, f32x4& b) { e.seg<3>(r, c, a, b); }); break;
            case 4: pg8::for_tile(acc, u, wr, wc, fr, fq, [&](int r, int c, f32x4& a, f32x4& b) { e.seg<4>(r, c, a, b); }); break;
            case 5: pg8::for_tile(acc, u, wr, wc, fr, fq, [&](int r, int c, f32x4& a, f32x4& b) { e.seg<5>(r, c, a, b); }); break;
            case 6: pg8::for_tile(acc, u, wr, wc, fr, fq, [&](int r, int c, f32x4& a, f32x4& b) { e.seg<6>(r, c, a, b); }); break;
            case 7: pg8::for_tile(acc, u, wr, wc, fr, fq, [&](int r, int c, f32x4& a, f32x4& b) { e.seg<7>(r, c, a, b); }); break;
            default: pg8::for_tile(acc, u, wr, wc, fr, fq, [&](int r, int c, f32x4& a, f32x4& b) { e.seg<8>(r, c, a, b); }); break;
        }
    }
};
struct SchedG1 {
    int G, c; const char *HN, *WIN, *PB, *WPL;
    __device__ __forceinline__ bool next(int i, pg8::Unit& u) const {
        constexpr int NMAIN = 64 * 38;
        long L = (long)i * G + c;
        if (L >= NMAIN && G == 256 && i == 10) L = (long)i * G + ((c + 128) & 255);
        if (L < NMAIN) { int pm, pn; pg8::tile_of((int)L, 64, 38, pm, pn); u.A = HN + (size_t)pm * 256 * 1024 * 2; u.B = WIN + (size_t)pn * 256 * 1024 * 2; u.lda = 1024; u.ldb = 1024; u.nt = 16; u.pm = pm; u.pn = pn; u.kind = K_IN; u.keep = 0; return true; }
        L -= NMAIN; if (L >= 256) return false;
        const int pm = (int)(L >> 2), pn = (int)(L & 3);
        u.A = PB + (size_t)pm * 256 * DPLE * 2; u.B = WPL + (size_t)pn * 256 * DPLE * 2; u.lda = DPLE; u.ldb = DPLE; u.nt = 4; u.pm = pm; u.pn = pn; u.kind = K_P; u.keep = 0; return true;
    }
};
template <class F> struct EpiSimple {
    F f;
    __device__ __forceinline__ void operator()(f32x4 (&acc)[2][2][4][2], const pg8::Unit& u, int wr, int wc, int fr, int fq) const {
        pg8::for_tile(acc, u, wr, wc, fr, fq, [&](int r, int c, f32x4& a, f32x4& b) { f(r, c, a, b); });
    }
};
struct SchedPlain {
    int G, c, nN, K; const char *A, *B;
    __device__ __forceinline__ bool next(int i, pg8::Unit& u) const {
        const long L = (long)i * G + c; if (L >= 64 * nN) return false;
        int pm, pn; pg8::tile_of((int)L, 64, nN, pm, pn);
        u.A = A + (size_t)pm * 256 * K * 2; u.B = B + (size_t)pn * 256 * K * 2; u.lda = K; u.ldb = K; u.nt = K / 64; u.pm = pm; u.pn = pn; u.kind = 0; u.keep = 0; return true;
    }
};
struct EpiMix {
    const bf16 *SGR, *SGA; bf16* MIX;
    __device__ __forceinline__ void operator()(f32x4 (&acc)[2][2][4][2], const pg8::Unit& u, int wr, int wc, int fr, int fq) const {
        if (u.kind == K_MIXA) pg8::for_tile(acc, u, wr, wc, fr, fq, [&](int r, int c, f32x4& a, f32x4& b) {
            f32x4 r0, r1, a0, a1; ld_bf8(SGR + (size_t)r * 1024 + c, r0, r1); ld_bf8(SGA + (size_t)r * 1024 + c, a0, a1);
#pragma unroll
            for (int j = 0; j < 4; ++j) { a[j] *= r0[j] / a0[j]; b[j] *= r1[j] / a1[j]; } });
        else pg8::for_tile(acc, u, wr, wc, fr, fq, [&](int r, int c, f32x4& a, f32x4& b) {
            f32x4 a0, a1; ld_bf8(SGA + (size_t)r * 1024 + c, a0, a1); st_bf8(MIX + (size_t)r * 1024 + c, a * a0, b * a1); });
    }
};
struct SchedMix {
    int G, c; const char *ARET, *WRB, *AATT, *WAB;
    __device__ __forceinline__ bool next(int i, pg8::Unit& u) const {
        const int tile = (i >> 1) * G + c; if (tile >= 256) return false;
        int pm, pn; pg8::tile_of(tile, 64, 4, pm, pn); u.pm = pm; u.pn = pn;
        if ((i & 1) == 0) { u.A = ARET + (size_t)pm * 256 * 1024 * 2; u.B = WRB + (size_t)pn * 256 * 1024 * 2; u.lda = 1024; u.ldb = 1024; u.nt = 16; u.kind = K_MIXA; u.keep = 1; }
        else { u.A = AATT + (size_t)pm * 256 * 512 * 2; u.B = WAB + (size_t)pn * 256 * 512 * 2; u.lda = 512; u.ldb = 512; u.nt = 8; u.kind = K_MIXB; u.keep = 0; }
        return true;
    }
};

#define MFMA32(a, b, c) __builtin_amdgcn_mfma_f32_32x32x16_bf16((a), (b), (c), 0, 0, 0)
__device__ __forceinline__ bf16x8 pack8(const float* v) { u32x4 w; w.x = pk2(v[0], v[1]); w.y = pk2(v[2], v[3]); w.z = pk2(v[4], v[5]); w.w = pk2(v[6], v[7]); return __builtin_bit_cast(bf16x8, w); }
__device__ __forceinline__ bf16x8 ld_2x4(const bf16* p) { const u32x2 lo = *(const u32x2*)p, hi = *(const u32x2*)(p + 8); u32x4 w; w.x = lo.x; w.y = lo.y; w.z = hi.x; w.w = hi.y; return __builtin_bit_cast(bf16x8, w); }

__device__ __forceinline__ unsigned off_b(unsigned row, unsigned ch) { return 256u * row + 16u * (ch ^ (((row & 3) << 2) | ((row >> 2) & 3))); }
__device__ __forceinline__ unsigned off_k(unsigned row, unsigned ch) { return 128u * row + 16u * (ch ^ (((row >> 1) & 1) << 2)); }
typedef short v4i16_t __attribute__((ext_vector_type(4)));
__device__ __forceinline__ v4i16_t tr_rd(const LAS unsigned char* p) { return __builtin_amdgcn_ds_read_tr16_b64_v4i16((LAS v4i16_t*)p); }
__device__ __forceinline__ bf16x8 cat44(v4i16_t a, v4i16_t b) { return (bf16x8){a[0], a[1], a[2], a[3], b[0], b[1], b[2], b[3]}; }
__device__ __forceinline__ v4i16_t tr_b(const LAS unsigned char* T, int r0, int ct, int lane) { const int blk = (lane >> 4) & 1, q = (lane & 15) >> 2, pp = lane & 3; return tr_rd(T + off_b(r0 + q, 4 * ct + 2 * blk + (pp >> 1)) + 8 * (pp & 1)); }
__device__ __forceinline__ v4i16_t tr_k(const LAS unsigned char* T, int r0, int ct, int lane) { const int blk = (lane >> 4) & 1, q = (lane & 15) >> 2, pp = lane & 3; return tr_rd(T + off_k(r0 + q, 4 * ct + 2 * blk + (pp >> 1)) + 8 * (pp & 1)); }

constexpr int BT = 192;
__device__ __forceinline__ void attn_tile(int item, const bf16* __restrict__ AQ, const bf16* __restrict__ AK, const bf16* __restrict__ AV, bf16* __restrict__ OG, float* __restrict__ LSE,
                                          const LAS float* biasl, LAS unsigned char* wl, int lane) {
    const int q32 = item & 3, idx16 = (item >> 2) & 15, h = (item >> 6) & 3, gb = item >> 8, b = gb & 7, g = gb >> 3;
    const int sh = 2 * g, dil = 1 << sh, nbs = 4 - sh;
    const int s = idx16 >> nbs, q0 = (idx16 & ((1 << nbs) - 1)) * 128 + q32 * 32;
    const int r = lane & 31, hh = lane >> 5, srow = lane >> 4, sch = lane & 15;
    const size_t rowbase = (size_t)b * SEQ + s;
    LAS unsigned char* Kt = wl; LAS unsigned char* Vt = wl + 8192;
    bf16x8 qf[8];
    { const bf16* qp = AQ + (rowbase + (size_t)dil * (q0 + r)) * 1536 + g * 512 + h * 128 + hh * 8;
#pragma unroll
      for (int ks = 0; ks < 8; ++ks) qf[ks] = *(const bf16x8*)(qp + ks * 16); }
    const int kb_lo = q0 >= 128 ? 0 : 4 - (q0 >> 5);
    const size_t kstride = (size_t)dil * 1536;
    const bf16* kg = AK + (rowbase + (size_t)dil * srow) * 1536 + g * 512 + h * 128 + sch * 8;
    const bf16* vg = AV + (rowbase + (size_t)dil * srow) * 1536 + g * 512 + h * 128 + sch * 8;
    u32x4 kr[8], vr[8];
    { const int kbase = q0 - 128 + 32 * kb_lo;
#pragma unroll
      for (int t = 0; t < 8; ++t) { kr[t] = *(const u32x4*)(kg + (size_t)(kbase + 4 * t) * kstride); vr[t] = *(const u32x4*)(vg + (size_t)(kbase + 4 * t) * kstride); } }
    f32x16 O[4];
#pragma unroll
    for (int dt = 0; dt < 4; ++dt)
#pragma unroll
        for (int q = 0; q < 16; ++q) O[dt][q] = 0.f;
    float m = -INFINITY, l = 0.f;
    const LAS float* bl = biasl + (g * 4 + h) * BT + 32 + r - 4 * hh;
    for (int kb = kb_lo; kb < 5; ++kb) {
        const int kbase = q0 - 128 + 32 * kb;
#pragma unroll
        for (int t = 0; t < 8; ++t) { *(LAS u32x4*)(Kt + off_b(4 * t + srow, sch)) = kr[t]; *(LAS u32x4*)(Vt + off_b(4 * t + srow, sch)) = vr[t]; }
        if (kb < 4) {
#pragma unroll
            for (int t = 0; t < 8; ++t) { kr[t] = *(const u32x4*)(kg + (size_t)(kbase + 32 + 4 * t) * kstride); vr[t] = *(const u32x4*)(vg + (size_t)(kbase + 32 + 4 * t) * kstride); } }
        f32x16 S;
#pragma unroll
        for (int q = 0; q < 16; ++q) S[q] = 0.f;
#pragma unroll
        for (int ks = 0; ks < 8; ++ks) { const bf16x8 kf = *(const LAS bf16x8*)(Kt + off_b(r, 2 * ks + hh)); S = MFMA32(kf, qf[ks], S); }
        const LAS float* bq = bl + (q0 - kbase);
        float sv[16]; float mx = -INFINITY;
#pragma unroll
        for (int q = 0; q < 16; ++q) { sv[q] = S[q] + bq[-((q & 3) + 8 * (q >> 2))]; mx = fmaxf(mx, sv[q]); }
        mx = fmaxf(mx, __shfl_xor(mx, 32));
        const float mn = fmaxf(m, mx), ms = (mn == -INFINITY) ? 0.f : mn;
        const float alpha = exp2f(m - ms);
        float rs = 0.f;
#pragma unroll
        for (int q = 0; q < 16; ++q) { sv[q] = exp2f(sv[q] - ms); rs += sv[q]; }
        rs += __shfl_xor(rs, 32);
        l = l * alpha + rs; m = mn;
#pragma unroll
        for (int dt = 0; dt < 4; ++dt) O[dt] *= alpha;
        const bf16x8 pb0 = pack8(sv), pb1 = pack8(sv + 8);
#pragma unroll
        for (int dt = 0; dt < 4; ++dt) {
            const bf16x8 v0 = cat44(tr_b(Vt, 4 * hh, dt, lane), tr_b(Vt, 8 + 4 * hh, dt, lane));
            const bf16x8 v1 = cat44(tr_b(Vt, 16 + 4 * hh, dt, lane), tr_b(Vt, 24 + 4 * hh, dt, lane));
            O[dt] = MFMA32(v0, pb0, O[dt]); O[dt] = MFMA32(v1, pb1, O[dt]);
        }
    }
    const float inv = 1.0f / l;
    const size_t row = rowbase + (size_t)dil * (q0 + r);
    bf16* op = OG + ((size_t)g * MT + row) * 512 + h * 128 + 4 * hh;
#pragma unroll
    for (int dt = 0; dt < 4; ++dt)
#pragma unroll
        for (int rg = 0; rg < 4; ++rg) st_bf4(op + dt * 32 + 8 * rg, (f32x4){O[dt][4 * rg] * inv, O[dt][4 * rg + 1] * inv, O[dt][4 * rg + 2] * inv, O[dt][4 * rg + 3] * inv});
    if (hh == 0) LSE[((size_t)g * MT + row) * 4 + h] = m + log2f(l);
}

__device__ __forceinline__ void ret_kv_tile(int item, const bf16* __restrict__ RK, const bf16* __restrict__ RV, float* __restrict__ KV, const f32x2* __restrict__ dec, LAS unsigned char* wl, int lane) {
    const int kt = item & 1, c = (item >> 1) & 15, bh = item >> 5, b = bh >> 3, h = bh & 7, r = lane & 31, hh = lane >> 5;
    LAS unsigned char* Kt = wl; LAS unsigned char* Vt = wl + 4096;
    const size_t tok0 = (size_t)b * SEQ + c * 128;
    const bf16* kg = RK + (tok0 + (lane >> 3)) * 512 + h * 64 + (lane & 7) * 8;
    const bf16* vg = RV + (tok0 + (lane >> 4)) * 1024 + h * 128 + (lane & 15) * 8;
    u32x4 kr[4], vr[8];
#pragma unroll
    for (int t = 0; t < 4; ++t) kr[t] = *(const u32x4*)(kg + (size_t)(8 * t) * 512);
#pragma unroll
    for (int t = 0; t < 8; ++t) vr[t] = *(const u32x4*)(vg + (size_t)(4 * t) * 1024);
    f32x16 D[4];
#pragma unroll
    for (int vt = 0; vt < 4; ++vt)
#pragma unroll
        for (int q = 0; q < 16; ++q) D[vt][q] = 0.f;
    for (int tb = 0; tb < 4; ++tb) {
#pragma unroll
        for (int t = 0; t < 4; ++t) *(LAS u32x4*)(Kt + off_k(8 * t + (lane >> 3), lane & 7)) = kr[t];
#pragma unroll
        for (int t = 0; t < 8; ++t) *(LAS u32x4*)(Vt + off_b(4 * t + (lane >> 4), lane & 15)) = vr[t];
        if (tb < 3) {
#pragma unroll
            for (int t = 0; t < 4; ++t) kr[t] = *(const u32x4*)(kg + (size_t)((tb + 1) * 32 + 8 * t) * 512);
#pragma unroll
            for (int t = 0; t < 8; ++t) vr[t] = *(const u32x4*)(vg + (size_t)((tb + 1) * 32 + 4 * t) * 1024);
        }
#pragma unroll
        for (int s2 = 0; s2 < 2; ++s2) {
            const bf16x8 af = cat44(tr_k(Kt, 16 * s2 + 8 * hh, kt, lane), tr_k(Kt, 16 * s2 + 8 * hh + 4, kt, lane));
#pragma unroll
            for (int vt = 0; vt < 4; ++vt) { const bf16x8 bv = cat44(tr_b(Vt, 16 * s2 + 8 * hh, vt, lane), tr_b(Vt, 16 * s2 + 8 * hh + 4, vt, lane)); D[vt] = MFMA32(af, bv, D[vt]); }
        }
    }
    const float g127 = dec[h * 128 + 127].x;
    float* o = KV + ((size_t)(bh * 16 + c) * 64 + kt * 32) * 128 + r;
#pragma unroll
    for (int vt = 0; vt < 4; ++vt)
#pragma unroll
        for (int q = 0; q < 16; ++q) { const int pq = (q & 3) + 8 * (q >> 2) + 4 * hh; o[(size_t)pq * 128 + vt * 32] = D[vt][q] * g127; }
}

__device__ __forceinline__ void ret_out_tile(int item, const bf16* __restrict__ RQ, const bf16* __restrict__ RK, const bf16* __restrict__ RV, const bf16* __restrict__ ST,
                                             const bf16* __restrict__ RG, const float* __restrict__ gn, bf16* __restrict__ ARET, LAS unsigned char* wl, int lane) {
    const int qb = item & 3, c = (item >> 2) & 15, bh = item >> 6, b = bh >> 3, h = bh & 7, r = lane & 31, hh = lane >> 5;
    const size_t tok0 = (size_t)b * SEQ + c * 128, row = tok0 + qb * 32 + r;
    LAS unsigned char* Vt = wl;
    bf16x8 qf[4], kf[4];
    { const bf16* qp = RQ + row * 512 + h * 64 + hh * 8;
#pragma unroll
      for (int ks = 0; ks < 4; ++ks) qf[ks] = *(const bf16x8*)(qp + ks * 16); }
    { const bf16* kp = RK + (tok0 + r) * 512 + h * 64 + hh * 8;
#pragma unroll
      for (int ks = 0; ks < 4; ++ks) kf[ks] = *(const bf16x8*)(kp + ks * 16); }
    const bf16* vg = RV + (tok0 + (lane >> 4)) * 1024 + h * 128 + (lane & 15) * 8;
    u32x4 vr[8];
#pragma unroll
    for (int t = 0; t < 8; ++t) vr[t] = *(const u32x4*)(vg + (size_t)(4 * t) * 1024);
    f32x16 O[4];
#pragma unroll
    for (int vt = 0; vt < 4; ++vt)
#pragma unroll
        for (int q = 0; q < 16; ++q) O[vt][q] = 0.f;
    if (c > 0) {
        const bf16* sp = ST + ((size_t)(bh * 16 + c) * 16 * 64 + lane) * 8;
#pragma unroll
        for (int ks = 0; ks < 4; ++ks) {
            bf16x8 sf[4];
#pragma unroll
            for (int vt = 0; vt < 4; ++vt) sf[vt] = *(const bf16x8*)(sp + (size_t)(vt * 4 + ks) * 64 * 8);
#pragma unroll
            for (int vt = 0; vt < 4; ++vt) O[vt] = MFMA32(sf[vt], qf[ks], O[vt]);
        }
    }
    for (int kb = 0; kb <= qb; ++kb) {
#pragma unroll
        for (int t = 0; t < 8; ++t) *(LAS u32x4*)(Vt + off_b(4 * t + (lane >> 4), lane & 15)) = vr[t];
        if (kb < qb) {
#pragma unroll
            for (int t = 0; t < 8; ++t) vr[t] = *(const u32x4*)(vg + (size_t)((kb + 1) * 32 + 4 * t) * 1024); }
        f32x16 X;
#pragma unroll
        for (int q = 0; q < 16; ++q) X[q] = 0.f;
#pragma unroll
        for (int ks = 0; ks < 4; ++ks) X = MFMA32(kf[ks], qf[ks], X);
        if (kb < qb) { const bf16* kp = RK + (tok0 + (kb + 1) * 32 + r) * 512 + h * 64 + hh * 8;
#pragma unroll
            for (int ks = 0; ks < 4; ++ks) kf[ks] = *(const bf16x8*)(kp + ks * 16); }
        float xv[16];
#pragma unroll
        for (int q = 0; q < 16; ++q) { const int kk = (q & 3) + 8 * (q >> 2) + 4 * hh; xv[q] = (kb == qb && kk > r) ? 0.f : X[q]; }
        const bf16x8 pb0 = pack8(xv), pb1 = pack8(xv + 8);
#pragma unroll
        for (int vt = 0; vt < 4; ++vt) {
            const bf16x8 v0 = cat44(tr_b(Vt, 4 * hh, vt, lane), tr_b(Vt, 8 + 4 * hh, vt, lane));
            const bf16x8 v1 = cat44(tr_b(Vt, 16 + 4 * hh, vt, lane), tr_b(Vt, 24 + 4 * hh, vt, lane));
            O[vt] = MFMA32(v0, pb0, O[vt]); O[vt] = MFMA32(v1, pb1, O[vt]);
        }
    }
    float sum = 0.f;
#pragma unroll
    for (int vt = 0; vt < 4; ++vt)
#pragma unroll
        for (int q = 0; q < 16; ++q) sum += O[vt][q];
    sum += __shfl_xor(sum, 32);
    const float mu = sum * (1.f / 128.f);
    float sq = 0.f;
#pragma unroll
    for (int vt = 0; vt < 4; ++vt)
#pragma unroll
        for (int q = 0; q < 16; ++q) { const float d = O[vt][q] - mu; sq += d * d; }
    sq += __shfl_xor(sq, 32);
    const float rstd = rsqrtf(sq * (1.f / 128.f) + NORM_EPS);
    const size_t ob = row * 1024 + h * 128 + 4 * hh;
#pragma unroll
    for (int vt = 0; vt < 4; ++vt)
#pragma unroll
        for (int rg = 0; rg < 4; ++rg) {
            const int vo = vt * 32 + 8 * rg;
            const f32x4 gate = ld_bf4(RG + ob + vo), gg = *(const f32x4*)(gn + h * 128 + 4 * hh + vo);
            f32x4 o;
#pragma unroll
            for (int j = 0; j < 4; ++j) o[j] = gate[j] * (O[vt][4 * rg + j] - mu) * rstd * gg[j];
            st_bf4(ARET + ob + vo, o);
        }
}

template <bool PERM>
__device__ __forceinline__ void transpose_item(const float* __restrict__ W, int K, int N, bf16* __restrict__ WT, LAS float* scr, int item, int lane) {
    const int nblk = N / 32, kb = item / nblk, nb = item % nblk, k0 = 64 * kb, n0 = 32 * nb;
    int srcc = n0 + (lane & 31);
    if (PERM && n0 < 1024) srcc = (n0 & ~63) + ((n0 & 32) >> 1) + ((lane & 31) >> 1) + 32 * (lane & 1);
#pragma unroll 8
    for (int i = 0; i < 32; ++i) { const int kk = 2 * i + (lane >> 5); scr[kk * 33 + (lane & 31)] = W[(size_t)(k0 + kk) * N + srcc]; }
    asm volatile("s_waitcnt lgkmcnt(0)" ::: "memory");
    const int c = lane & 7;
#pragma unroll
    for (int j = 0; j < 4; ++j) { const int n = (lane >> 3) + 8 * j; const LAS float* s = scr + (8 * c) * 33 + n;
        u32x4 o; o.x = pk2(s[0 * 33], s[1 * 33]); o.y = pk2(s[2 * 33], s[3 * 33]); o.z = pk2(s[4 * 33], s[5 * 33]); o.w = pk2(s[6 * 33], s[7 * 33]);
        *(u32x4*)(WT + (size_t)(n0 + n) * K + k0 + 8 * c) = o; }
    asm volatile("s_waitcnt lgkmcnt(0)" ::: "memory");
}
__device__ __forceinline__ void rms_row_to_bf16(const float* __restrict__ xrow, const float* __restrict__ g, bf16* __restrict__ orow, int lane) {
    f32x4 v[4]; float s = 0.f;
#pragma unroll
    for (int j = 0; j < 4; ++j) { v[j] = *(const f32x4*)(xrow + 4 * lane + 256 * j); s += (v[j][0] * v[j][0] + v[j][1] * v[j][1]) + (v[j][2] * v[j][2] + v[j][3] * v[j][3]); }
    const float r = rsqrtf(wave_sum(s) * (1.f / 1024.f) + NORM_EPS);
#pragma unroll
    for (int j = 0; j < 4; ++j) { const f32x4 gg = *(const f32x4*)(g + 4 * lane + 256 * j); st_bf4(orow + 4 * lane + 256 * j, v[j] * r * gg); }
}

#define XB_TMO      128
#define XB_XCNT(j)  (256  + 64 * (j))
#define XB_XSUB(j)  (1280 + 64 * (j))
#define XB_XGEN(j)  (2304 + 64 * (j))
#define XB_TOP      3328
#define XB_TOPGEN   3392
#define XCD_BAR_WORDS 3456
#define XB_SPIN_CAP (1u << 18)
__device__ __forceinline__ unsigned xb_ld(unsigned* p)              { return __hip_atomic_load(p, __ATOMIC_RELAXED, __HIP_MEMORY_SCOPE_AGENT); }
__device__ __forceinline__ unsigned xb_add(unsigned* p, unsigned v) { return __hip_atomic_fetch_add(p, v, __ATOMIC_RELAXED, __HIP_MEMORY_SCOPE_AGENT); }
__device__ __forceinline__ unsigned xb_xcc_id() { return (unsigned)__builtin_amdgcn_s_getreg((3 << 11) | 20) & 0xFu; }
#define XB_SPIN(cond, bar) do { unsigned _sp = 0; while (cond) { __builtin_amdgcn_s_sleep(1); \
    if ((++_sp & 255u) == 0u) { if (xb_ld(&(bar)[XB_TMO])) break; if (_sp > XB_SPIN_CAP) { atomicAdd(&(bar)[XB_TMO], 1u); break; } } } } while (0)
struct XcdBarrier { unsigned* bar; unsigned x; volatile LAS unsigned* st; };
__device__ __forceinline__ XcdBarrier xcd_barrier_post(unsigned* bar, volatile LAS unsigned* st) {
    XcdBarrier b; b.bar = bar; b.x = xb_xcc_id(); b.st = st;
    if (threadIdx.x == 0) (void)xb_add(&bar[XB_XCNT(b.x)], 1u);
    return b;
}
__device__ __forceinline__ void xcd_barrier_complete(unsigned* bar, unsigned x, unsigned& nloc, unsigned& nx) {
    const unsigned G = gridDim.x * gridDim.y * gridDim.z;
    unsigned sum, cnt, mine, sp = 0u;
    for (;;) {
        sum = 0u; cnt = 0u; mine = 0u;
#pragma unroll
        for (unsigned j = 0; j < 16; ++j) { const unsigned c = xb_ld(&bar[XB_XCNT(j)]); sum += c; cnt += (c > 0u) ? 1u : 0u; mine = (j == x) ? c : mine; }
        if (sum == G) break;
        __builtin_amdgcn_s_sleep(1);
        if ((++sp & 255u) == 0u) { if (xb_ld(&bar[XB_TMO])) break; if (sp > XB_SPIN_CAP) { atomicAdd(&bar[XB_TMO], 1u); break; } }
    }
    nloc = mine > 0u ? mine : 1u; nx = cnt > 0u ? cnt : 1u;
}
__device__ __forceinline__ void xcd_barrier(const XcdBarrier& b) {
    asm volatile("s_waitcnt vmcnt(0)" ::: "memory");
    __syncthreads();
    if (threadIdx.x == 0) {
        unsigned* bar = b.bar;
        __builtin_amdgcn_s_waitcnt(0);
        unsigned nloc = b.st[0], nx = b.st[1];
        if (nloc == 0u) { xcd_barrier_complete(bar, b.x, nloc, nx); b.st[0] = nloc; b.st[1] = nx; }
        const unsigned old = xb_add(&bar[XB_XSUB(b.x)], 1u);
        const unsigned gen = old / nloc;
        if (old + 1u == (gen + 1u) * nloc) {
            __builtin_amdgcn_fence(__ATOMIC_RELEASE, "agent");
            asm volatile("s_waitcnt vmcnt(0)" ::: "memory");
            const unsigned og = xb_add(&bar[XB_TOP], 1u);
            const unsigned tg = og / nx;
            if (og + 1u == (tg + 1u) * nx) xb_add(&bar[XB_TOPGEN], 1u);
            else XB_SPIN(xb_ld(&bar[XB_TOPGEN]) == tg, bar);
            __builtin_amdgcn_fence(__ATOMIC_ACQUIRE, "agent");
            xb_add(&bar[XB_XGEN(b.x)], 1u);
            asm volatile("s_waitcnt vmcnt(0)" ::: "memory");
        } else {
            XB_SPIN(xb_ld(&bar[XB_XGEN(b.x)]) == gen, bar);
            __builtin_amdgcn_fence(__ATOMIC_ACQUIRE, "agent");
            asm volatile("s_waitcnt vmcnt(0)" ::: "memory");
        }
    }
    __syncthreads();
}

constexpr int NPHASE = 12;
__global__ void __launch_bounds__(NTHREADS, 2) fwd_kernel(Params p) {
    extern __shared__ __attribute__((aligned(16))) unsigned char lds_raw[];
    LAS unsigned char* lds = (LAS unsigned char*)lds_raw;
    volatile LAS unsigned* bst = (volatile LAS unsigned*)(lds + 131072 + 1024);
    if (threadIdx.x == 0) { bst[0] = 0u; bst[1] = 0u; bst[2] = 0u; bst[3] = 0u; }
    __syncthreads();
    const XcdBarrier gbar = xcd_barrier_post((unsigned*)(p.ws + WS_CTL) + 4096, bst);
    const int G = gridDim.x, nw = G * NWAVES;
    const size_t nthr = (size_t)G * NTHREADS;
#define PHASE_IDS int tid = threadIdx.x; asm volatile("" : "+v"(tid)); const int lane = tid & 63, wave = tid >> 6, gw = blockIdx.x * NWAVES + wave; const size_t gtid = (size_t)blockIdx.x * NTHREADS + tid; (void)lane; (void)wave; (void)gw; (void)gtid;
    unsigned char* ws = p.ws; float* out = p.out;
    const f32x2* rope = (const f32x2*)(ws + WS_ROPE);
    float* bias2 = (float*)(ws + WS_BIAS);
    const f32x2* dec = (const f32x2*)(ws + WS_DEC);
    bf16* WIN = (bf16*)(ws + WS_WIN); bf16* WRB = (bf16*)(ws + WS_WRB); bf16* WAB = (bf16*)(ws + WS_WAB); bf16* WO = (bf16*)(ws + WS_WO);
    bf16* WU = (bf16*)(ws + WS_WU); bf16* WD = (bf16*)(ws + WS_WD); bf16* WPL = (bf16*)(ws + WS_WPL); bf16* WPG = (bf16*)(ws + WS_WPG);
    bf16* HN = (bf16*)(ws + WS_HN); float* KV = (float*)(ws + WS_HN); bf16* ARET = HN; bf16* PB = (bf16*)(ws + WS_PB); bf16* P = (bf16*)(ws + WS_P);
    bf16* RQ = (bf16*)(ws + WS_RQ); bf16* RK = (bf16*)(ws + WS_RK); bf16* RV = (bf16*)(ws + WS_RV); bf16* MIX = RV;
    float* ROS = (float*)(ws + WS_ROS);
    bf16* RG = (bf16*)(ws + WS_RG); bf16* H2 = RG; bf16* AQ = (bf16*)(ws + WS_AQ); bf16* ST = AQ; bf16* AK = (bf16*)(ws + WS_AK); bf16* AATT = AK; bf16* AV = (bf16*)(ws + WS_AV); bf16* U = AQ;
    bf16* SGR = (bf16*)(ws + WS_SGR); bf16* X2B = SGR; bf16* SGA = (bf16*)(ws + WS_SGA); bf16* OG = (bf16*)(ws + WS_OG); float* LSE = (float*)(ws + WS_LSE);
    float* X = out + O_Y;
    const int lo = p.ph_lo, hi = p.ph_hi;
#define IN(k) (lo <= (k) && (k) < hi)
#define SEAM(k) do { if (IN(k) && IN((k) + 1)) xcd_barrier(gbar); } while (0)

    if (IN(0)) { PHASE_IDS
        LAS float* scr = (LAS float*)(lds + wave * 16384);
        constexpr int I_IN = 16 * (NIN / 32), I_RB = 16 * 32, I_AB = 8 * 32, I_O = 16 * 32, I_U = 16 * 128, I_D = 64 * 32, I_PL = 4 * 32, I_PG = 16 * 32;
        constexpr int NITEMS = I_IN + I_RB + I_AB + I_O + I_U + I_D + I_PL + I_PG;
        for (int it = gw; it < NITEMS; it += nw) {
            int r = it;
            if (r < I_IN) { transpose_item<true>(p.in[I_WIN], 1024, NIN, WIN, scr, r, lane); continue; } r -= I_IN;
            if (r < I_RB) { transpose_item<false>(p.in[I_WRB], 1024, 1024, WRB, scr, r, lane); continue; } r -= I_RB;
            if (r < I_AB) { transpose_item<false>(p.in[I_WAB], 512, 1024, WAB, scr, r, lane); continue; } r -= I_AB;
            if (r < I_O) { transpose_item<false>(p.in[I_WO], 1024, 1024, WO, scr, r, lane); continue; } r -= I_O;
            if (r < I_U) { transpose_item<false>(p.in[I_WU], 1024, DFF, WU, scr, r, lane); continue; } r -= I_U;
            if (r < I_D) { transpose_item<false>(p.in[I_WD], DFF, 1024, WD, scr, r, lane); continue; } r -= I_D;
            if (r < I_PL) { transpose_item<false>(p.in[I_WPL], DPLE, 1024, WPL, scr, r, lane); continue; } r -= I_PL;
            transpose_item<false>(p.in[I_WPG], 1024, 1024, WPG, scr, r, lane);
        }
        for (int m = gw; m < MT; m += nw) {
            const float* xr = m < MP ? p.in[I_XP] + (size_t)m * 1024 : p.in[I_XS] + (size_t)(m - MP) * 1024;
            rms_row_to_bf16(xr, p.in[I_LN1], HN + (size_t)m * 1024, lane);
            const float* pr = m < MP ? p.in[I_PP] + (size_t)m * DPLE : p.in[I_PS] + (size_t)(m - MP) * DPLE;
            st_bf4(PB + (size_t)m * DPLE + 4 * lane, *(const f32x4*)(pr + 4 * lane));
        }
        for (size_t i = gtid; i < (size_t)2049 * 32; i += nthr) {
            const int tp = (int)(i >> 5), j = (int)(i & 31);
            const float pos = tp < SEQ ? (float)tp : 16384.0f;
            const float inv = exp2f(-(float)j * (13.287712379549449f / 32.0f));
            const float ang = pos * inv;
            double rev = (double)ang * 0.15915494309189535; rev -= floor(rev);
            const float rr = (float)(rev * 6.283185307179586 - 3.141592653589793);
            float sn, cs; __sincosf(rr, &sn, &cs);
            ((f32x2*)(ws + WS_ROPE))[i] = (f32x2){-cs, -sn};
        }
        for (size_t i = gtid; i < 12 * 128; i += nthr) {
            const int gh = (int)(i >> 7), j = (int)(i & 127), g = gh >> 2;
            const int d = j * dil_of(g);
            int bkt;
            if (d < 16) bkt = d;
            else { const float lr = logf((float)d / 16.0f) / 4.852030263919617f; bkt = 16 + (int)(lr * 16.0f); bkt = bkt < 31 ? bkt : 31; }
            bias2[i] = p.in[I_RELB][bkt * 12 + gh] * LOG2E;
        }
        for (size_t i = gtid; i < 8 * 128; i += nthr) {
            const int h = (int)(i >> 7), j = (int)(i & 127);
            const float lg = log2f(1.0f - exp2f(-5.0f - (float)h));
            ((f32x2*)(ws + WS_DEC))[i] = (f32x2){exp2f((float)j * lg), exp2f(-(float)j * lg)};
        }
        for (int a = 0; a < 6; ++a) {
            const int g = a >> 1, isv = a & 1, W = win_of(g);
            const f32x4* src = (const f32x4*)p.in[I_CK128 + a]; f32x4* dst = (f32x4*)(out + okvs(g, isv));
            const size_t per = (size_t)(W - 1) * 128, tot = per * SB;
            for (size_t i = gtid; i < tot; i += nthr) { const size_t bs = i / per, r = i - bs * per; dst[bs * (size_t)W * 128 + r] = src[bs * (size_t)W * 128 + 128 + r]; }
        }
    }
    SEAM(0);

    if (IN(1)) { PHASE_IDS
        const EIn e{RQ, RK, RV, RG, AQ, AK, AV, SGR, SGA, rope, dec, out}; const EStoreBf ep{P, 1024};
        { const EpiG1 E{e, ep}; const SchedG1 S{G, (int)blockIdx.x, (const char*)HN, (const char*)WIN, (const char*)PB, (const char*)WPL}; pg8::gemm_phase(lds, S, E); }
        const int s0 = (G == 256) ? (int)blockIdx.x - 128 : (int)blockIdx.x, sn = (G == 256) ? 128 : G;
        if (s0 >= 0) for (int t = s0; t < 168; t += sn) {
            if (t < 152) sample_tile(lds, HN + (size_t)MP * 1024, 1024, WIN, 1024, 1024, t, e);
            else sample_tile(lds, PB + (size_t)MP * DPLE, DPLE, WPL, DPLE, DPLE, t - 152, ep);
        }
    }
    SEAM(1);

    if (IN(2)) { PHASE_IDS
        LAS float* biasl = (LAS float*)(lds + 131072 + 2048);
        LAS unsigned char* wl = lds + wave * 16384;
        LAS float* qs = biasl + 12 * BT;
        LAS float* sc = qs + 128;
        LAS float* red = sc + 128;
        for (int i = tid; i < 12 * BT; i += NTHREADS) { const int gh = i / BT, jd = i - gh * BT - 32; biasl[i] = ((unsigned)jd <= 127u) ? bias2[gh * 128 + jd] : -INFINITY; }
        __syncthreads();
        for (int it = blockIdx.x; it < 3 * SB * 4; it += G) {
            const int g = it / (SB * 4), rem = it - g * (SB * 4), bs = rem >> 2, h = rem & 3, dil = dil_of(g), W = win_of(g);
            const size_t row = (size_t)MP + bs;
            const float* ck = p.in[I_CK128 + 2 * g] + (size_t)bs * W * 512 + h * 128;
            const float* cv = p.in[I_CV128 + 2 * g] + (size_t)bs * W * 512 + h * 128;
            if (tid < 64) { const unsigned w = *(const unsigned*)(AQ + row * 1536 + g * 512 + h * 128 + 2 * tid); qs[2 * tid] = bflo(w); qs[2 * tid + 1] = bfhi(w); }
            __syncthreads();
            {
                const int j = tid >> 2, part = tid & 3;
                float acc = 0.f;
                if (j == 0) {
                    const bf16* kp = AK + row * 1536 + g * 512 + h * 128 + part * 32;
#pragma unroll
                    for (int c8 = 0; c8 < 4; ++c8) { f32x4 k0, k1; ld_bf8(kp + c8 * 8, k0, k1); const f32x4 q0 = *(const LAS f32x4*)(qs + part * 32 + c8 * 8), q1 = *(const LAS f32x4*)(qs + part * 32 + c8 * 8 + 4);
                        acc += k0[0] * q0[0] + k0[1] * q0[1] + k0[2] * q0[2] + k0[3] * q0[3] + k1[0] * q1[0] + k1[1] * q1[1] + k1[2] * q1[2] + k1[3] * q1[3]; }
                } else {
                    const f32x4* kp = (const f32x4*)(ck + (size_t)(W - j * dil) * 512 + part * 32);
                    f32x4 kv[8];
#pragma unroll
                    for (int c4 = 0; c4 < 8; ++c4) kv[c4] = kp[c4];
#pragma unroll
                    for (int c4 = 0; c4 < 8; ++c4) { const f32x4 q0 = *(const LAS f32x4*)(qs + part * 32 + c4 * 4); acc += kv[c4][0] * q0[0] + kv[c4][1] * q0[1] + kv[c4][2] * q0[2] + kv[c4][3] * q0[3]; }
                }
                acc += __shfl_xor(acc, 1); acc += __shfl_xor(acc, 2);
                if (part == 0) sc[j] = acc + biasl[(g * 4 + h) * BT + 32 + j];
            }
            __syncthreads();
            if (tid < 64) {
                const float s0 = sc[tid], s1 = sc[tid + 64];
                const float m = wave_max(fmaxf(s0, s1));
                const float p0 = exp2f(s0 - m), p1 = exp2f(s1 - m);
                const float den = wave_sum(p0 + p1), inv = 1.0f / den;
                sc[tid] = p0 * inv; sc[tid + 64] = p1 * inv;
                if (tid == 0) LSE[((size_t)g * MT + row) * 4 + h] = m + log2f(den);
            }
            __syncthreads();
            {
                const int d = tid & 127, kq = tid >> 7;
                float vv[32];
#pragma unroll
                for (int u = 0; u < 32; ++u) { const int j = kq * 32 + u; vv[u] = (j == 0) ? bf2f(AV[row * 1536 + g * 512 + h * 128 + d]) : cv[(size_t)(W - j * dil) * 512 + d]; }
                float o = 0.f;
#pragma unroll
                for (int u = 0; u < 32; ++u) o += sc[kq * 32 + u] * vv[u];
                red[kq * 128 + d] = o;
            }
            __syncthreads();
            if (tid < 64) {
                const float o0 = (red[2 * tid] + red[128 + 2 * tid]) + (red[256 + 2 * tid] + red[384 + 2 * tid]);
                const float o1 = (red[2 * tid + 1] + red[128 + 2 * tid + 1]) + (red[256 + 2 * tid + 1] + red[384 + 2 * tid + 1]);
                *(unsigned*)(OG + ((size_t)g * MT + row) * 512 + h * 128 + 2 * tid) = pk2(o0, o1);
            }
            __syncthreads();
        }
        if (tid < 128) for (size_t it = (size_t)blockIdx.x * 128 + tid; it < (size_t)SB * 8 * 128; it += (size_t)G * 128) {
            const int bs = (int)(it >> 10), h = (int)(it >> 7) & 7, v = (int)(it & 127);
            const float gamma = 1.0f - exp2f(-5.0f - (float)h);
            const size_t row = (size_t)MP + bs;
            const float vv = bf2f(RV[row * 1024 + h * 128 + v]);
            const float* si = p.in[I_STATE] + ((size_t)(bs * 8 + h) * 64) * 128 + v;
            float* so = out + O_STS + ((size_t)(bs * 8 + h) * 64) * 128 + v;
            float o = 0.f;
#pragma unroll 16
            for (int k = 0; k < 64; ++k) {
                const int ko = (k >> 1) + 32 * (k & 1);
                const float s = gamma * si[(size_t)ko * 128] + bf2f(RK[row * 512 + h * 64 + k]) * vv;
                o += bf2f(RQ[row * 512 + h * 64 + k]) * s;
                so[(size_t)ko * 128] = s;
            }
            ROS[(size_t)bs * 1024 + h * 128 + v] = o;
        }
        for (int it = gw; it < 3 * NB * 4 * 16 * 4; it += nw) attn_tile(it, AQ, AK, AV, OG, LSE, biasl, wl, lane);
        for (int it = gw; it < NB * 8 * 16 * 2; it += nw) ret_kv_tile(it, RK, RV, KV, dec, wl, lane);
    }
    SEAM(2);

    if (IN(3)) { PHASE_IDS
        {
            const int h = lane >> 4, co = h * 128 + (lane & 15) * 8;
#pragma unroll 2
            for (int row = gw; row < MT; row += nw) {
                const float l0 = LSE[((size_t)0 * MT + row) * 4 + h], l1 = LSE[((size_t)1 * MT + row) * 4 + h], l2 = LSE[((size_t)2 * MT + row) * 4 + h];
                const size_t off = (size_t)row * 512 + co;
                f32x4 a0, a1, b0, b1, c0, c1; ld_bf8(OG + (size_t)0 * MT * 512 + off, a0, a1); ld_bf8(OG + (size_t)1 * MT * 512 + off, b0, b1); ld_bf8(OG + (size_t)2 * MT * 512 + off, c0, c1);
                const float mx = fmaxf(l0, fmaxf(l1, l2));
                float w0 = exp2f(l0 - mx), w1 = exp2f(l1 - mx), w2 = exp2f(l2 - mx); const float inv = 1.0f / (w0 + w1 + w2); w0 *= inv; w1 *= inv; w2 *= inv;
                st_bf8(AATT + off, a0 * w0 + b0 * w1 + c0 * w2, a1 * w0 + b1 * w1 + c1 * w2);
            }
        }
        for (size_t it = gtid; it < (size_t)64 * 8 * 128; it += nthr) {
            const int v = (int)(it & 127), pc = (int)(it >> 7) & 7, bh = (int)(it >> 10), h = bh & 7;
            const float gamma = dec[h * 128 + 1].x, g128 = dec[h * 128 + 127].x * gamma;
            float S[8];
#pragma unroll
            for (int j = 0; j < 8; ++j) S[j] = 0.f;
            for (int c0 = 0; c0 < 16; c0 += 4) {
                float kv[4][8];
#pragma unroll
                for (int cc = 0; cc < 4; ++cc) { const float* kvp = KV + ((size_t)(bh * 16 + c0 + cc) * 64 + pc * 8) * 128 + v;
#pragma unroll
                    for (int j = 0; j < 8; ++j) kv[cc][j] = kvp[(size_t)j * 128]; }
#pragma unroll
                for (int cc = 0; cc < 4; ++cc) { const int c = c0 + cc;
#pragma unroll
                    for (int j = 0; j < 8; ++j) S[j] = g128 * S[j] + kv[cc][j];
                    if (c < 15) st_bf8(ST + ((((size_t)(bh * 16 + (c + 1)) * 4 + (v >> 5)) * 4 + (pc >> 1)) * 64 + (pc & 1) * 32 + (v & 31)) * 8, (f32x4){gamma * S[0], gamma * S[1], gamma * S[2], gamma * S[3]}, (f32x4){gamma * S[4], gamma * S[5], gamma * S[6], gamma * S[7]}); }
            }
            float* so = out + O_STP + ((size_t)bh * 64) * 128 + v;
#pragma unroll
            for (int j = 0; j < 8; ++j) { const int pq = pc * 8 + j; so[(size_t)((pq >> 1) + 32 * (pq & 1)) * 128] = S[j]; }
        }
    }
    SEAM(3);

    if (IN(4)) { PHASE_IDS
        for (int it = gw; it < NB * 8 * 16 * 4; it += nw) ret_out_tile(it, RQ, RK, RV, ST, RG, p.in[I_GN], ARET, lds + wave * 16384, lane);
        const float* gn = p.in[I_GN];
        for (int it = gw; it < SB * 8; it += nw) {
            const int bs = it >> 3, h = it & 7;
            const size_t base = (size_t)(MP + bs) * 1024 + h * 128, sb = (size_t)bs * 1024 + h * 128;
            const float x0 = ROS[sb + lane], x1 = ROS[sb + 64 + lane];
            const float mu = wave_sum(x0 + x1) * (1.f / 128.f);
            const float d0 = x0 - mu, d1 = x1 - mu;
            const float r = rsqrtf(wave_sum(d0 * d0 + d1 * d1) * (1.f / 128.f) + NORM_EPS);
            ARET[base + lane] = (bf16)f2bf(bf2f(RG[base + lane]) * d0 * r * gn[h * 128 + lane]);
            ARET[base + 64 + lane] = (bf16)f2bf(bf2f(RG[base + 64 + lane]) * d1 * r * gn[h * 128 + 64 + lane]);
        }
    }
    SEAM(4);

    if (IN(5)) {
        for (int t = blockIdx.x; t < 16; t += G) {
            f32x4 r0 = (f32x4){0.f, 0.f, 0.f, 0.f}, r1 = r0;
            sample_tile(lds, ARET + (size_t)MP * 1024, 1024, WRB, 1024, 1024, t, [&](int, int, f32x4 v0, f32x4 v1) { r0 = v0; r1 = v1; });
            sample_tile(lds, AATT + (size_t)MP * 512, 512, WAB, 512, 512, t, [&](int row, int c, f32x4 v0, f32x4 v1) {
                f32x4 g0, g1, a0, a1; ld_bf8(SGR + (size_t)row * 1024 + c, g0, g1); ld_bf8(SGA + (size_t)row * 1024 + c, a0, a1);
                st_bf8(MIX + (size_t)row * 1024 + c, g0 * r0 + a0 * v0, g1 * r1 + a1 * v1); });
        }
        const EpiMix E{SGR, SGA, MIX}; const SchedMix S{G, (int)blockIdx.x, (const char*)ARET, (const char*)WRB, (const char*)AATT, (const char*)WAB};
        pg8::gemm_phase(lds, S, E);
    }
    SEAM(5);
    if (IN(6)) {
        const EResIn e{p.in[I_XP], p.in[I_XS], X};
        for (int t = blockIdx.x; t < 16; t += G) sample_tile(lds, MIX + (size_t)MP * 1024, 1024, WO, 1024, 1024, t, e);
        const EpiSimple<EResIn> E{e}; const SchedPlain S{G, (int)blockIdx.x, 4, 1024, (const char*)MIX, (const char*)WO}; pg8::gemm_phase(lds, S, E);
    }
    SEAM(6);
    if (IN(7)) { PHASE_IDS for (int m = gw; m < MT; m += nw) rms_row_to_bf16(X + (size_t)m * 1024, p.in[I_LN2], H2 + (size_t)m * 1024, lane); }
    SEAM(7);
    if (IN(8)) {
        const ERelu2 e{U};
        for (int t = blockIdx.x; t < 64; t += G) sample_tile(lds, H2 + (size_t)MP * 1024, 1024, WU, 1024, 1024, t, e);
        const EpiSimple<ERelu2> E{e}; const SchedPlain S{G, (int)blockIdx.x, 16, 1024, (const char*)H2, (const char*)WU}; pg8::gemm_phase(lds, S, E);
    }
    SEAM(8);
    if (IN(9)) {
        const EResX e{X, X2B};
        for (int t = blockIdx.x; t < 16; t += G) sample_tile(lds, U + (size_t)MP * DFF, DFF, WD, DFF, DFF, t, e);
        const EpiSimple<EResX> E{e}; const SchedPlain S{G, (int)blockIdx.x, 4, DFF, (const char*)U, (const char*)WD}; pg8::gemm_phase(lds, S, E);
    }
    SEAM(9);
    if (IN(10)) {
        const EPle e{X, P};
        for (int t = blockIdx.x; t < 16; t += G) sample_tile(lds, X2B + (size_t)MP * 1024, 1024, WPG, 1024, 1024, t, e);
        const EpiSimple<EPle> E{e}; const SchedPlain S{G, (int)blockIdx.x, 4, 1024, (const char*)X2B, (const char*)WPG}; pg8::gemm_phase(lds, S, E);
    }
    SEAM(10);
    if (IN(11)) { PHASE_IDS
        const float* g = p.in[I_LNF];
        for (int m = gw; m < MT; m += nw) {
            float* xr = X + (size_t)m * 1024;
            f32x4 v[4]; float s = 0.f;
#pragma unroll
            for (int j = 0; j < 4; ++j) { v[j] = *(const f32x4*)(xr + 4 * lane + 256 * j); s += (v[j][0] * v[j][0] + v[j][1] * v[j][1]) + (v[j][2] * v[j][2] + v[j][3] * v[j][3]); }
            const float r = rsqrtf(wave_sum(s) * (1.f / 1024.f) + NORM_EPS);
#pragma unroll
            for (int j = 0; j < 4; ++j) { const f32x4 gg = *(const f32x4*)(g + 4 * lane + 256 * j); *(f32x4*)(xr + 4 * lane + 256 * j) = v[j] * r * gg; }
        }
    }
#undef IN
#undef SEAM
}

#ifndef MK_N_LAUNCHES
#define MK_N_LAUNCHES 1
#endif
extern "C" void kernel_launch(void* const* d_in, const int* in_sizes, int n_in, void* d_out, int out_size, void* d_ws, size_t ws_size, hipStream_t stream) {
    static int grid = 0;
    if (grid == 0) {
        if (n_in != 24 || (size_t)out_size != O_END || ws_size < WS_END) { fprintf(stderr, "kernel_launch: unexpected problem shape (n_in %d out %d ws %zu)\n", n_in, out_size, ws_size); grid = -1; return; }
        int dev = 0, cus = 0, per_cu = 0;
        if (hipGetDevice(&dev) != hipSuccess || hipDeviceGetAttribute(&cus, hipDeviceAttributeMultiprocessorCount, dev) != hipSuccess) { grid = -1; return; }
        if (hipFuncSetAttribute((const void*)fwd_kernel, hipFuncAttributeMaxDynamicSharedMemorySize, LDS_BYTES) != hipSuccess) { fprintf(stderr, "kernel_launch: hipFuncSetAttribute failed\n"); grid = -1; return; }
        if (hipOccupancyMaxActiveBlocksPerMultiprocessor(&per_cu, (const void*)fwd_kernel, NTHREADS, LDS_BYTES) != hipSuccess || per_cu < 1) { fprintf(stderr, "kernel_launch: occupancy query failed (%d)\n", per_cu); (void)hipGetLastError(); per_cu = 1; }
        grid = cus * (per_cu < 1 ? 1 : (per_cu > 1 ? 1 : per_cu));
    }
    if (grid < 0) return;
    (void)hipMemsetAsync((char*)d_ws + WS_CTL, 0, CTL_ZERO_BYTES, stream);
    Params p{};
    for (int i = 0; i < 24; ++i) p.in[i] = (const float*)d_in[i];
    p.out = (float*)d_out; p.ws = (unsigned char*)d_ws;
#if MK_N_LAUNCHES == 1
    p.ph_lo = 0; p.ph_hi = NPHASE;
    void* args[] = {&p};
    hipError_t e = hipLaunchCooperativeKernel((const void*)fwd_kernel, dim3(grid), dim3(NTHREADS), args, LDS_BYTES, stream);
    if (e != hipSuccess) fprintf(stderr, "kernel_launch: cooperative launch failed: %s (grid %d)\n", hipGetErrorString(e), grid);
#else
    for (int k = 0; k < NPHASE; ++k) { p.ph_lo = k; p.ph_hi = k + 1; hipLaunchKernelGGL(fwd_kernel, dim3(grid), dim3(NTHREADS), LDS_BYTES, stream, p); }
#endif
}
```

```cpp
#include <hip/hip_runtime.h>
#include <cstdio>
#include <cstdint>

#define LAS __attribute__((address_space(3)))
typedef unsigned short bf16;
typedef short bf16x8 __attribute__((ext_vector_type(8)));
typedef float f32x4 __attribute__((ext_vector_type(4)));
typedef float f32x2 __attribute__((ext_vector_type(2)));
typedef unsigned u32x4 __attribute__((ext_vector_type(4)));
typedef unsigned u32x2 __attribute__((ext_vector_type(2)));
typedef float f32x2_t_ __attribute__((ext_vector_type(2)));
typedef float f32x16 __attribute__((ext_vector_type(16)));

constexpr int D = 1024, NB = 8, SEQ = 2048, MP = NB * SEQ, SB = 32, MT = MP + SB, MPAD = 16640;
constexpr int NIN = 9728, DFF = 4096, DPLE = 256;
constexpr int NWAVES = 8, NTHREADS = NWAVES * 64;
constexpr int LDS_BYTES = 147456;
constexpr float NORM_EPS = 1e-6f;
constexpr float LOG2E = 1.4426950408889634f;
constexpr float QSCALE = 0.08838834764831845f * LOG2E;

constexpr size_t O_Y = 0;
constexpr size_t O_STP = (size_t)MT * 1024;
constexpr size_t O_KVP0 = O_STP + 524288;
constexpr size_t O_STS = O_KVP0 + 2 * 524288 + 2 * 2097152 + 2 * 8388608;
constexpr size_t O_KVS0 = O_STS + 2097152;
constexpr size_t O_END = O_KVS0 + 2 * 2097152 + 2 * 8388608 + 2 * 33554432;
static_assert(O_END == 129531904, "d_out size");
__host__ __device__ constexpr int win_of(int g) { return g == 0 ? 128 : (g == 1 ? 512 : 2048); }
__host__ __device__ constexpr int dil_of(int g) { return g == 0 ? 1 : (g == 1 ? 4 : 16); }
__host__ __device__ constexpr size_t okvp(int g, int isv) {
    return O_KVP0 + (g == 0 ? 0 : (g == 1 ? 2 * 524288 : 2 * 524288 + 2 * 2097152)) + (size_t)isv * (size_t)NB * win_of(g) * 512;
}
__host__ __device__ constexpr size_t okvs(int g, int isv) {
    return O_KVS0 + (g == 0 ? 0 : (g == 1 ? 2 * 2097152 : 2 * 2097152 + 2 * 8388608)) + (size_t)isv * (size_t)SB * win_of(g) * 512;
}

constexpr size_t MiB = 1u << 20;
constexpr size_t WS_CTL = 0, CTL_ZERO_BYTES = 1 * MiB;
constexpr size_t WS_ROPE = 1 * MiB;
constexpr size_t WS_BIAS = 1 * MiB + 640 * 1024;
constexpr size_t WS_DEC = 1 * MiB + 704 * 1024;
constexpr size_t WS_WIN = 2 * MiB;
constexpr size_t WS_WRB = 21 * MiB;
constexpr size_t WS_WAB = 23 * MiB;
constexpr size_t WS_WO = 24 * MiB;
constexpr size_t WS_WU = 26 * MiB;
constexpr size_t WS_WD = 34 * MiB;
constexpr size_t WS_WPL = 42 * MiB;
constexpr size_t WS_WPG = 43 * MiB;
constexpr size_t WS_ROS = 45 * MiB;
constexpr size_t WS_HN = 46 * MiB;
constexpr size_t WS_PB = 79 * MiB;
constexpr size_t WS_P = 88 * MiB;
constexpr size_t WS_RQ = 121 * MiB;
constexpr size_t WS_RK = 138 * MiB;
constexpr size_t WS_RV = 155 * MiB;
constexpr size_t WS_RG = 188 * MiB;
constexpr size_t WS_AQ = 221 * MiB;
constexpr size_t WS_AK = 270 * MiB;
constexpr size_t WS_AV = 319 * MiB;
constexpr size_t WS_SGR = 368 * MiB;
constexpr size_t WS_SGA = 401 * MiB;
constexpr size_t WS_OG = 434 * MiB;
constexpr size_t WS_LSE = 483 * MiB;
constexpr size_t WS_RSQ = 484 * MiB;
constexpr size_t WS_END = 486 * MiB;
static_assert(WS_AQ + (size_t)MT * 4096 * 2 <= WS_SGR, "U overlay");
static_assert((size_t)MT * 1024 * 2 <= 33 * MiB && (size_t)MT * 512 * 2 <= 17 * MiB && (size_t)MT * 1536 * 2 <= 49 * MiB, "slots");

__device__ __forceinline__ unsigned f2bf(float f) { unsigned u = __float_as_uint(f); return (u + 0x7fffu + ((u >> 16) & 1u)) >> 16; }
__device__ __forceinline__ float bf2f(unsigned b) { return __uint_as_float(b << 16); }
typedef __bf16 bf16x2_t __attribute__((ext_vector_type(2)));
__device__ __forceinline__ unsigned pk2(float lo, float hi) { const f32x2_t_ v = {lo, hi}; const bf16x2_t b = __builtin_convertvector(v, bf16x2_t); return __builtin_bit_cast(unsigned, b); }
__device__ __forceinline__ float bflo(unsigned w) { return __uint_as_float(w << 16); }
__device__ __forceinline__ float bfhi(unsigned w) { return __uint_as_float(w & 0xffff0000u); }
__device__ __forceinline__ float wave_sum(float v) {
#pragma unroll
    for (int o = 1; o < 64; o <<= 1) v += __shfl_xor(v, o);
    return v;
}
__device__ __forceinline__ float wave_max(float v) {
#pragma unroll
    for (int o = 1; o < 64; o <<= 1) v = fmaxf(v, __shfl_xor(v, o));
    return v;
}
__device__ __forceinline__ float rcp_(float v) { return __builtin_amdgcn_rcpf(v); }
__device__ __forceinline__ float ex2_(float v) { return __builtin_amdgcn_exp2f(v); }
__device__ __forceinline__ float sigmoidf_(float v) { return rcp_(1.0f + ex2_(-LOG2E * v)); }
__device__ __forceinline__ void st_bf4(bf16* p, f32x4 v) { u32x2 w; w.x = pk2(v[0], v[1]); w.y = pk2(v[2], v[3]); *(u32x2*)p = w; }
__device__ __forceinline__ f32x4 ld_bf4(const bf16* p) { const u32x2 w = *(const u32x2*)p; return (f32x4){bflo(w.x), bfhi(w.x), bflo(w.y), bfhi(w.y)}; }

struct Params {
    const float* in[24];
    float* out;
    unsigned char* ws;
    int ph_lo, ph_hi;
};
enum { I_XP = 0, I_XS, I_STATE, I_CK128, I_CV128, I_CK512, I_CV512, I_CK2K, I_CV2K, I_PP, I_PS, I_LN1, I_WIN, I_GN, I_WRB, I_WAB, I_WO, I_LN2, I_WU, I_WD, I_WPL, I_WPG, I_RELB, I_LNF };

constexpr int CP_CHUNKS = 2 * 32 * (8 + 32 + 128);
struct CpArgs { const float *s0, *s1, *s2, *s3, *s4, *s5; float* out; };
__device__ __forceinline__ void cp_chunk(const CpArgs& A, int cid, int lane) {
    int a, loc, sh;
    if (cid < 512) { a = cid >> 8; loc = cid & 255; sh = 3; }
    else if (cid < 2560) { const int c2 = cid - 512; a = 2 + (c2 >> 10); loc = c2 & 1023; sh = 5; }
    else { const int c2 = cid - 2560; a = 4 + (c2 >> 12); loc = c2 & 4095; sh = 7; }
    const int g = a >> 1, W = win_of(g), bs = loc >> sh, k = loc & ((1 << sh) - 1);
    const float* sp = a == 0 ? A.s0 : a == 1 ? A.s1 : a == 2 ? A.s2 : a == 3 ? A.s3 : a == 4 ? A.s4 : A.s5;
    const f32x4* src = (const f32x4*)sp + (size_t)bs * W * 128 + 128 + (size_t)k * 2048 + lane;
    f32x4* dst = (f32x4*)(A.out + okvs(g, a & 1)) + (size_t)bs * W * 128 + (size_t)k * 2048 + lane;
    const int n = (W - 1) * 128 - k * 2048 - lane;
    f32x4 r[32];
#pragma unroll
    for (int u = 0; u < 32; ++u) if (64 * u < n) r[u] = __builtin_nontemporal_load(src + 64 * u);
#pragma unroll
    for (int u = 0; u < 32; ++u) if (64 * u < n) __builtin_nontemporal_store(r[u], dst + 64 * u);
}

__device__ __forceinline__ void st_bf8(bf16* p, f32x4 a, f32x4 b) { u32x4 w; w.x = pk2(a[0], a[1]); w.y = pk2(a[2], a[3]); w.z = pk2(b[0], b[1]); w.w = pk2(b[2], b[3]); *(u32x4*)p = w; }
__device__ __forceinline__ void ld_bf8(const bf16* p, f32x4& a, f32x4& b) { const u32x4 w = *(const u32x4*)p; a = (f32x4){bflo(w.x), bfhi(w.x), bflo(w.y), bfhi(w.y)}; b = (f32x4){bflo(w.z), bfhi(w.z), bflo(w.w), bfhi(w.w)}; }

namespace pg8 {
typedef bf16 bf16_t;
constexpr int BM = 256, BK = 64, HALF = 128, HTB = HALF * BK * 2, STAGE_BYTES = 8 * HTB, NXCD = 8, WGM = 8;
__host__ __device__ __forceinline__ int lds_byte(int r, int c) { const int st = (r >> 4) * 2 + (c >> 5), rr = r & 15, cc = c & 31, ob = rr * 64 + cc * 2; return st * 1024 + (ob ^ (((ob >> 9) & 1) << 5)); }
__host__ __device__ __forceinline__ void stage_rc(int b, int& R, int& C) { const int st = b / 1024, sb = b % 1024, swz = sb ^ (((sb >> 9) & 1) << 5); R = (st >> 1) * 16 + swz / 64; C = (st & 1) * 32 + (swz % 64) / 2; }
__host__ __device__ __forceinline__ int perm32(int rho) { const int n = rho >> 4, i = rho & 15; return 8 * (i >> 2) + 4 * n + (i & 3); }
struct Unit { const char* A; const char* B; int lda, ldb, nt, pm, pn, kind, keep; };
__device__ __forceinline__ void tile_of(int L, int nM, int nN, int& pm, int& pn) {
    const int nwg = nM * nN; int wgid = L; { const int q = nwg / NXCD, r = nwg % NXCD, xcd = wgid % NXCD, off = wgid / NXCD; wgid = (xcd < r ? xcd * (q + 1) : r * (q + 1) + (xcd - r) * q) + off; }
    const int nig = WGM * nN, gid = wgid / nig, fm = gid * WGM, gsz = (nM - fm) < WGM ? (nM - fm) : WGM;
    pm = fm + ((wgid % nig) % gsz); pn = (wgid % nig) / gsz;
}
template <class F> __device__ __forceinline__ void for_tile(f32x4 (&acc)[2][2][4][2], const Unit& u, int wr, int wc, int fr, int fq, const F& f) {
#pragma unroll
    for (int ai = 0; ai < 2; ++ai)
#pragma unroll
        for (int m = 0; m < 4; ++m) { const int row = u.pm * BM + ai * HALF + wr * 64 + m * 16 + fr;
#pragma unroll
            for (int bj = 0; bj < 2; ++bj) f(row, u.pn * BM + bj * HALF + wc * 32 + 8 * fq, acc[ai][bj][m][0], acc[ai][bj][m][1]); }
}
template <class Epi, class Sched>
__device__ __forceinline__ void gemm_phase(LAS unsigned char* lds, const Sched& S, const Epi& E) {
    const int tid = threadIdx.x, wid = __builtin_amdgcn_readfirstlane(tid >> 6), lane = tid & 63, wr = wid >> 2, wc = wid & 3, fr = lane & 15, fq = lane >> 4;
    unsigned RA[2], RB[2], CC[2];
#pragma unroll
    for (int i = 0; i < 2; ++i) { int R, C; stage_rc(tid * 16 + i * 8192, R, C); RA[i] = 2u * (unsigned)R; RB[i] = 2u * (unsigned)((R & ~31) + perm32(R & 31)); CC[i] = 2u * (unsigned)C; }
    const size_t kstep = (size_t)(BK * 2);
    const unsigned ldsw = (unsigned)wid * 1024u;
    const int aoff = lds_byte(wr * 64 + fr, fq * 8), boff = lds_byte(wc * 32 + fr, fq * 8);
#define PG8_SA(b, h) (((b) * 2 + (h)) * HTB)
#define PG8_SB(b, h) ((4 + (b) * 2 + (h)) * HTB)
#define PG8_STAGE(bufoff, gbase, RR, ld) do { _Pragma("unroll") for (int _i = 0; _i < 2; ++_i) \
        __builtin_amdgcn_global_load_lds((const unsigned*)((const char*)(gbase) + (RR[_i] * (unsigned)(ld) + CC[_i])), (LAS unsigned*)(lds + (bufoff) + ldsw + _i * 8192), 16, 0, 0); } while (0)
#define PG8_LDA(dst, b, h) do { _Pragma("unroll") for (int m = 0; m < 4; ++m) _Pragma("unroll") for (int k = 0; k < 2; ++k) dst[m][k] = *(const LAS bf16x8*)(lds + PG8_SA(b, h) + aoff + m * 2048 + k * 1024); } while (0)
#define PG8_LDB(dst, b, h) do { _Pragma("unroll") for (int n = 0; n < 2; ++n) _Pragma("unroll") for (int k = 0; k < 2; ++k) dst[n][k] = *(const LAS bf16x8*)(lds + PG8_SB(b, h) + boff + n * 2048 + k * 1024); } while (0)
#define PG8_MMA(ai, bj, At, Bt) do { __builtin_amdgcn_s_setprio(1); _Pragma("unroll") for (int m = 0; m < 4; ++m) _Pragma("unroll") for (int n = 0; n < 2; ++n) _Pragma("unroll") for (int k = 0; k < 2; ++k) \
        acc[ai][bj][m][n] = __builtin_amdgcn_mfma_f32_16x16x32_bf16(Bt[n][k], At[m][k], acc[ai][bj][m][n], 0, 0, 0); __builtin_amdgcn_s_setprio(0); } while (0)
#define PG8_WAIT_V(n) asm volatile("s_waitcnt vmcnt(" #n ")" ::: "memory")
#define PG8_WAIT_L(n) asm volatile("s_waitcnt lgkmcnt(" #n ")" ::: "memory")
#define PG8_BAR __builtin_amdgcn_s_barrier()
#define PG8_SCHED __builtin_amdgcn_sched_barrier(0)
    Unit cur, nxt; int ui = 0;
    if (!S.next(0, cur)) return;
    f32x4 acc[2][2][4][2];
#pragma unroll
    for (int a = 0; a < 2; ++a)
#pragma unroll
        for (int b = 0; b < 2; ++b)
#pragma unroll
            for (int m = 0; m < 4; ++m)
#pragma unroll
                for (int n = 0; n < 2; ++n) acc[a][b][m][n] = (f32x4){0.f, 0.f, 0.f, 0.f};
    bf16x8 At[4][2], B0[2][2], B1[2][2];
    int ldAc = cur.lda, ldBc = cur.ldb;
    const char* cA = cur.A; const char* cB = cur.B;
#define HA(ld) ((size_t)HALF * 2 * (size_t)(ld))
    PG8_STAGE(PG8_SB(0, 0), cB, RB, ldBc); PG8_STAGE(PG8_SB(0, 1), cB + HA(ldBc), RB, ldBc); PG8_STAGE(PG8_SA(0, 0), cA, RA, ldAc); PG8_STAGE(PG8_SA(0, 1), cA + HA(ldAc), RA, ldAc);
    if (wr == 1) PG8_BAR;
    PG8_WAIT_V(2); PG8_BAR;
    PG8_STAGE(PG8_SB(1, 0), cB + kstep, RB, ldBc); PG8_STAGE(PG8_SA(1, 0), cA + kstep, RA, ldAc); PG8_STAGE(PG8_SB(1, 1), cB + HA(ldBc) + kstep, RB, ldBc);
    PG8_WAIT_V(6); PG8_BAR;
    for (;;) {
        const bool has_next = S.next(ui + 1, nxt);
        const char* nA = cA; const char* nB = cB; int ldAn = ldAc, ldBn = ldBc;
        if (has_next) { nA = nxt.A; nB = nxt.B; ldAn = nxt.lda; ldBn = nxt.ldb; }
        const int nt = cur.nt;
        for (int t = 0; t < nt; t += 2) {
            const bool last = (t == nt - 2);
            const char* a1 = cA + (size_t)(t + 1) * kstep;
            const char* a2 = last ? nA : cA + (size_t)(t + 2) * kstep; const char* b2 = last ? nB : cB + (size_t)(t + 2) * kstep;
            const char* a3 = a2 + kstep; const char* b3 = b2 + kstep;
            const int ldA2 = last ? ldAn : ldAc, ldB2 = last ? ldBn : ldBc;
            PG8_LDB(B0, 0, 0); PG8_LDB(B1, 0, 1); PG8_SCHED; PG8_LDA(At, 0, 0); PG8_STAGE(PG8_SA(1, 1), a1 + HA(ldAc), RA, ldAc);
            PG8_WAIT_V(8); PG8_WAIT_L(0); PG8_BAR; PG8_MMA(0, 0, At, B0); PG8_MMA(0, 1, At, B1); PG8_BAR; PG8_SCHED;
            PG8_LDA(At, 0, 1); PG8_STAGE(PG8_SB(0, 0), b2, RB, ldB2); PG8_STAGE(PG8_SB(0, 1), b2 + HA(ldB2), RB, ldB2); PG8_STAGE(PG8_SA(0, 0), a2, RA, ldA2);
            PG8_WAIT_V(8); PG8_WAIT_L(0); PG8_BAR; PG8_MMA(1, 0, At, B0); PG8_MMA(1, 1, At, B1); PG8_BAR; PG8_SCHED;
            PG8_LDB(B0, 1, 0); PG8_LDB(B1, 1, 1); PG8_SCHED; PG8_LDA(At, 1, 0); PG8_STAGE(PG8_SA(0, 1), a2 + HA(ldA2), RA, ldA2);
            PG8_WAIT_V(8); PG8_WAIT_L(0); PG8_BAR; PG8_MMA(0, 0, At, B0); PG8_MMA(0, 1, At, B1); PG8_BAR; PG8_SCHED;
            PG8_LDA(At, 1, 1); PG8_STAGE(PG8_SB(1, 0), b3, RB, ldB2); PG8_STAGE(PG8_SB(1, 1), b3 + HA(ldB2), RB, ldB2); PG8_STAGE(PG8_SA(1, 0), a3, RA, ldA2);
            PG8_WAIT_V(8); PG8_WAIT_L(0); PG8_BAR; PG8_MMA(1, 0, At, B0); PG8_MMA(1, 1, At, B1); PG8_BAR; PG8_SCHED;
        }
        if (wr == 0) PG8_BAR;
        E(acc, cur, wr, wc, fr, fq);
        if (!has_next) break;
        if (!cur.keep) {
#pragma unroll
            for (int a = 0; a < 2; ++a)
#pragma unroll
                for (int b = 0; b < 2; ++b)
#pragma unroll
                    for (int m = 0; m < 4; ++m)
#pragma unroll
                        for (int n = 0; n < 2; ++n) acc[a][b][m][n] = (f32x4){0.f, 0.f, 0.f, 0.f};
        }
        cur = nxt; cA = nA; cB = nB; ldAc = ldAn; ldBc = ldBn; ++ui;
        if (wr == 1) PG8_BAR;
    }
    PG8_WAIT_V(0);
    PG8_BAR;
#undef PG8_SA
#undef PG8_SB
#undef PG8_STAGE
#undef PG8_LDA
#undef PG8_LDB
#undef PG8_MMA
#undef PG8_WAIT_V
#undef PG8_WAIT_L
#undef PG8_BAR
#undef PG8_SCHED
#undef HA
}
}

template <class F>
__device__ __forceinline__ void sample_tile(LAS unsigned char* lds, const bf16* __restrict__ A, int lda, const bf16* __restrict__ Bt, int ldb, int K, int tile, const F& f) {
    const int tid = threadIdx.x, lane = tid & 63, wave = tid >> 6, fr = lane & 15, fq = lane >> 4;
    f32x4 acc[2][4];
#pragma unroll
    for (int a = 0; a < 2; ++a)
#pragma unroll
        for (int b = 0; b < 4; ++b) acc[a][b] = (f32x4){0.f, 0.f, 0.f, 0.f};
    const int kw = K / 8;
    const bf16* ap = A + (size_t)fr * lda + wave * kw + fq * 8;
    const bf16* bp = Bt + (size_t)(tile * 64 + fr) * ldb + wave * kw + fq * 8;
    for (int k0 = 0; k0 < kw; k0 += 32) {
        bf16x8 a[2], b[4];
#pragma unroll
        for (int mi = 0; mi < 2; ++mi) a[mi] = *(const bf16x8*)(ap + (size_t)mi * 16 * lda + k0);
#pragma unroll
        for (int ni = 0; ni < 4; ++ni) b[ni] = *(const bf16x8*)(bp + (size_t)ni * 16 * ldb + k0);
#pragma unroll
        for (int mi = 0; mi < 2; ++mi)
#pragma unroll
            for (int ni = 0; ni < 4; ++ni) acc[mi][ni] = __builtin_amdgcn_mfma_f32_16x16x32_bf16(b[ni], a[mi], acc[mi][ni], 0, 0, 0);
    }
    LAS float* part = (LAS float*)lds;
#pragma unroll
    for (int mi = 0; mi < 2; ++mi)
#pragma unroll
        for (int ni = 0; ni < 4; ++ni) *(LAS f32x4*)(part + ((size_t)wave * 32 + mi * 16 + fr) * 68 + ni * 16 + fq * 4) = acc[mi][ni];
    __syncthreads();
    if (tid < 256) {
        const int row = tid >> 3, cg = (tid & 7) * 8;
        f32x4 v0 = (f32x4){0.f, 0.f, 0.f, 0.f}, v1 = v0;
#pragma unroll
        for (int w = 0; w < 8; ++w) { v0 += *(const LAS f32x4*)(part + ((size_t)w * 32 + row) * 68 + cg); v1 += *(const LAS f32x4*)(part + ((size_t)w * 32 + row) * 68 + cg + 4); }
        f(MP + row, tile * 64 + cg, v0, v1);
    }
    __syncthreads();
}

struct EIn {
    bf16 *RQ, *RK, *RV, *RG, *AQ, *AK, *AV, *SGR, *SGA; const f32x2* rope; const f32x2* dec; float* out;
    template <int SEG> __device__ __forceinline__ void seg(int row, int c, f32x4 v0, f32x4 v1) const {
        if (SEG == 0 || SEG == 1) {
            const int cc = c & 511, h = cc >> 6, tp = row < MP ? (row & (SEQ - 1)) : SEQ, i0 = (cc & 63) >> 1;
            const f32x4 r0 = *(const f32x4*)(rope + tp * 32 + i0), r1 = *(const f32x4*)(rope + tp * 32 + i0 + 2);
            const f32x2 dd = dec[h * 128 + (row < MP ? (row & 127) : 0)];
            const float sc = SEG == 1 ? 0.125f * dd.y : dd.x;
            f32x4 o0, o1;
            o0[0] = v0[0] * r0[0] - v0[1] * r0[1]; o0[1] = v0[0] * r0[1] + v0[1] * r0[0]; o0[2] = v0[2] * r0[2] - v0[3] * r0[3]; o0[3] = v0[2] * r0[3] + v0[3] * r0[2];
            o1[0] = v1[0] * r1[0] - v1[1] * r1[1]; o1[1] = v1[0] * r1[1] + v1[1] * r1[0]; o1[2] = v1[2] * r1[2] - v1[3] * r1[3]; o1[3] = v1[2] * r1[3] + v1[3] * r1[2];
            o0 *= sc; o1 *= sc;
            st_bf8((SEG == 1 ? RK : RQ) + (size_t)row * 512 + cc, o0, o1);
        } else if (SEG == 2) {
            st_bf8(RV + (size_t)row * 1024 + (c - 1024), v0, v1);
        } else if (SEG == 3) {
            f32x4 s0, s1;
#pragma unroll
            for (int j = 0; j < 4; ++j) { s0[j] = v0[j] * sigmoidf_(v0[j]); s1[j] = v1[j] * sigmoidf_(v1[j]); }
            st_bf8(RG + (size_t)row * 1024 + (c - 2048), s0, s1);
        } else if (SEG == 4) {
            st_bf8(AQ + (size_t)row * 1536 + (c - 3072), v0 * QSCALE, v1 * QSCALE);
        } else if (SEG == 5 || SEG == 6) {
            const int isv = SEG == 6; const int cc = c - (isv ? 6144 : 4608); const int g = cc >> 9, hc = cc & 511;
            const int W = win_of(g);
            float* dst = nullptr;
            if (row < MP) { const int t = row & (SEQ - 1), b = row >> 11; if (t >= SEQ - W) dst = out + okvp(g, isv) + ((size_t)(b * W + t - (SEQ - W)) * 512 + hc); }
            else { const int bs = row - MP; dst = out + okvs(g, isv) + ((size_t)(bs * W + (W - 1)) * 512 + hc); }
            if (dst) { *(f32x4*)dst = v0; *(f32x4*)(dst + 4) = v1; }
            st_bf8((isv ? AV : AK) + (size_t)row * 1536 + cc, v0, v1);
        } else {
            f32x4 s0, s1;
#pragma unroll
            for (int j = 0; j < 4; ++j) { s0[j] = sigmoidf_(v0[j]); s1[j] = sigmoidf_(v1[j]); }
            st_bf8((SEG == 8 ? SGA : SGR) + (size_t)row * 1024 + (c - (SEG == 8 ? 8704 : 7680)), s0, s1);
        }
    }
    __device__ __forceinline__ static int seg_of(int c) { return c < 512 ? 0 : c < 1024 ? 1 : c < 2048 ? 2 : c < 3072 ? 3 : c < 4608 ? 4 : c < 6144 ? 5 : c < 7680 ? 6 : c < 8704 ? 7 : 8; }
    __device__ __forceinline__ void operator()(int row, int c, f32x4 v0, f32x4 v1) const {
        switch (seg_of(c)) { case 0: seg<0>(row, c, v0, v1); break; case 1: seg<1>(row, c, v0, v1); break; case 2: seg<2>(row, c, v0, v1); break; case 3: seg<3>(row, c, v0, v1); break;
            case 4: seg<4>(row, c, v0, v1); break; case 5: seg<5>(row, c, v0, v1); break; case 6: seg<6>(row, c, v0, v1); break; case 7: seg<7>(row, c, v0, v1); break; default: seg<8>(row, c, v0, v1); break; }
    }
};
struct EStoreBf { bf16* O; int ld; __device__ __forceinline__ void operator()(int row, int c, f32x4 v0, f32x4 v1) const { st_bf8(O + (size_t)row * ld + c, v0, v1); } };
struct EResIn {
    const float *xp, *xs; float* X; bf16* H2; const float* g2;
    __device__ __forceinline__ float operator()(int row, int c, f32x4 v0, f32x4 v1) const {
        const float* src = row < MP ? xp + (size_t)row * 1024 + c : xs + (size_t)(row - MP) * 1024 + c; float* d = X + (size_t)row * 1024 + c;
        const f32x4 o0 = *(const f32x4*)src + v0, o1 = *(const f32x4*)(src + 4) + v1;
        *(f32x4*)d = o0; *(f32x4*)(d + 4) = o1;
        st_bf8(H2 + (size_t)row * 1024 + c, o0 * *(const f32x4*)(g2 + c), o1 * *(const f32x4*)(g2 + c + 4));
        return (o0[0] * o0[0] + o0[1] * o0[1]) + (o0[2] * o0[2] + o0[3] * o0[3]) + (o1[0] * o1[0] + o1[1] * o1[1]) + (o1[2] * o1[2] + o1[3] * o1[3]);
    }
};
struct EpiWo {
    EResIn e; float* RSQ;
    __device__ __forceinline__ void operator()(f32x4 (&acc)[2][2][4][2], const pg8::Unit& u, int wr, int wc, int fr, int fq) const {
#pragma unroll
        for (int ai = 0; ai < 2; ++ai)
#pragma unroll
            for (int m = 0; m < 4; ++m) { const int row = u.pm * 256 + ai * 128 + wr * 64 + m * 16 + fr; float ss = 0.f;
#pragma unroll
                for (int bj = 0; bj < 2; ++bj) ss += e(row, u.pn * 256 + bj * 128 + wc * 32 + 8 * fq, acc[ai][bj][m][0], acc[ai][bj][m][1]);
                ss += __shfl_xor(ss, 16); ss += __shfl_xor(ss, 32);
                if (fq == 0) RSQ[(size_t)row * 16 + u.pn * 4 + wc] = ss; }
    }
};
__device__ __forceinline__ float row_rstd(const float* __restrict__ RSQ, int row) {
    const f32x4 a = *(const f32x4*)(RSQ + (size_t)row * 16), b = *(const f32x4*)(RSQ + (size_t)row * 16 + 4), c = *(const f32x4*)(RSQ + (size_t)row * 16 + 8), d = *(const f32x4*)(RSQ + (size_t)row * 16 + 12);
    const f32x4 s = (a + b) + (c + d);
    return rsqrtf(((s[0] + s[1]) + (s[2] + s[3])) * (1.f / 1024.f) + NORM_EPS);
}
struct ERelu2 {
    bf16* U;
    __device__ __forceinline__ void operator()(int row, int c, f32x4 v0, f32x4 v1, float rs) const {
        f32x4 s0, s1;
#pragma unroll
        for (int j = 0; j < 4; ++j) { const float a = fmaxf(v0[j] * rs, 0.f), b = fmaxf(v1[j] * rs, 0.f); s0[j] = a * a; s1[j] = b * b; }
        st_bf8(U + (size_t)row * DFF + c, s0, s1);
    }
};
struct EpiUp {
    ERelu2 e; const float* RSQ;
    __device__ __forceinline__ void operator()(f32x4 (&acc)[2][2][4][2], const pg8::Unit& u, int wr, int wc, int fr, int fq) const {
#pragma unroll
        for (int ai = 0; ai < 2; ++ai)
#pragma unroll
            for (int m = 0; m < 4; ++m) { const int row = u.pm * 256 + ai * 128 + wr * 64 + m * 16 + fr; const float rs = row_rstd(RSQ, row);
#pragma unroll
                for (int bj = 0; bj < 2; ++bj) e(row, u.pn * 256 + bj * 128 + wc * 32 + 8 * fq, acc[ai][bj][m][0], acc[ai][bj][m][1], rs); }
    }
};
struct EResX {
    float* X; bf16* XB;
    __device__ __forceinline__ void operator()(int row, int c, f32x4 v0, f32x4 v1) const {
        float* p = X + (size_t)row * 1024 + c; const f32x4 o0 = *(const f32x4*)p + v0, o1 = *(const f32x4*)(p + 4) + v1; *(f32x4*)p = o0; *(f32x4*)(p + 4) = o1;
        st_bf8(XB + (size_t)row * 1024 + c, o0, o1);
    }
};
struct EPle {
    float* X; const bf16* P;
    __device__ __forceinline__ void operator()(int row, int c, f32x4 v0, f32x4 v1) const {
        float* p = X + (size_t)row * 1024 + c; f32x4 p0, p1; ld_bf8(P + (size_t)row * 1024 + c, p0, p1); f32x4 o0 = *(const f32x4*)p, o1 = *(const f32x4*)(p + 4);
#pragma unroll
        for (int j = 0; j < 4; ++j) { o0[j] += sigmoidf_(v0[j]) * p0[j]; o1[j] += sigmoidf_(v1[j]) * p1[j]; }
        *(f32x4*)p = o0; *(f32x4*)(p + 4) = o1;
    }
};

enum { K_IN = 0, K_P = 1, K_MIXA = 2, K_MIXB = 3 };
struct EpiG1 {
    EIn e; EStoreBf ep;
    __device__ __forceinline__ void operator()(f32x4 (&acc)[2][2][4][2], const pg8::Unit& u, int wr, int wc, int fr, int fq) const {
        if (u.kind == K_P) { pg8::for_tile(acc, u, wr, wc, fr, fq, [&](int r, int c, f32x4& a, f32x4& b) { ep(r, c, a, b); }); return; }
        switch (EIn::seg_of(u.pn * 256)) {
            case 0: pg8::for_tile(acc, u, wr, wc, fr, fq, [&](int r, int c, f32x4& a, f32x4& b) { e.seg<0>(r, c, a, b); }); break;
            case 1: pg8::for_tile(acc, u, wr, wc, fr, fq, [&](int r, int c, f32x4& a, f32x4& b) { e.seg<1>(r, c, a, b); }); break;
            case 2: pg8::for_tile(acc, u, wr, wc, fr, fq, [&](int r, int c, f32x4& a, f32x4& b) { e.seg<2>(r, c, a, b); }); break;
            case 3: pg8::for_tile(acc, u, wr, wc, fr, fq, [&](int r, int c, f32x4& a, f32x4& b) { e.seg<3>(r, c, a, b); }); break;
            case 4: pg8::for_tile(acc, u, wr, wc, fr, fq, [&](int r, int c, f32x4& a, f32x4& b) { e.seg<4>(r, c, a, b); }); break;
            case 5: pg8::for_tile(acc, u, wr, wc, fr, fq, [&](int r, int c, f32x4& a, f32x4& b) { e.seg<5>(r, c, a, b); }); break;
            case 6: pg8::for_tile(acc, u, wr, wc, fr, fq, [&](int r, int c, f32x4& a, f32x4& b) { e.seg<6>(r, c, a, b); }); break;
            case 7: pg8::for_tile(acc, u, wr, wc, fr, fq, [&](int r, int c, f32x4& a, f32x4& b) { e.seg<7>(r, c, a, b); }); break;
            default: pg8::for_tile(acc, u, wr, wc, fr, fq, [&](int r, int c, f32x4& a, f32x4& b) { e.seg<8>(r, c, a, b); }); break;
        }
    }
};
struct SchedG1 {
    int G, c; const char *HN, *WIN, *PB, *WPL;
    __device__ __forceinline__ bool next(int i, pg8::Unit& u) const {
        constexpr int NMAIN = 64 * 38;
        long L = (long)i * G + c;
        if (L >= NMAIN && G == 256 && i == 10) L = (long)i * G + ((c + 128) & 255);
        if (L < NMAIN) { int pm, pn; pg8::tile_of((int)L, 64, 38, pm, pn); u.A = HN + (size_t)pm * 256 * 1024 * 2; u.B = WIN + (size_t)pn * 256 * 1024 * 2; u.lda = 1024; u.ldb = 1024; u.nt = 16; u.pm = pm; u.pn = pn; u.kind = K_IN; u.keep = 0; return true; }
        L -= NMAIN; if (L >= 256) return false;
        const int pm = (int)(L >> 2), pn = (int)(L & 3);
        u.A = PB + (size_t)pm * 256 * DPLE * 2; u.B = WPL + (size_t)pn * 256 * DPLE * 2; u.lda = DPLE; u.ldb = DPLE; u.nt = 4; u.pm = pm; u.pn = pn; u.kind = K_P; u.keep = 0; return true;
    }
};
template <class F> struct EpiSimple {
    F f;
    __device__ __forceinline__ void operator()(f32x4 (&acc)[2][2][4][2], const pg8::Unit& u, int wr, int wc, int fr, int fq) const {
        pg8::for_tile(acc, u, wr, wc, fr, fq, [&](int r, int c, f32x4& a, f32x4& b) { f(r, c, a, b); });
    }
};
struct SchedPlain {
    int G, c, nN, K; const char *A, *B;
    __device__ __forceinline__ bool next(int i, pg8::Unit& u) const {
        const long L = (long)i * G + c; if (L >= 64 * nN) return false;
        int pm, pn; pg8::tile_of((int)L, 64, nN, pm, pn);
        u.A = A + (size_t)pm * 256 * K * 2; u.B = B + (size_t)pn * 256 * K * 2; u.lda = K; u.ldb = K; u.nt = K / 64; u.pm = pm; u.pn = pn; u.kind = 0; u.keep = 0; return true;
    }
};
struct EpiMix {
    const bf16 *SGR, *SGA; bf16* MIX;
    __device__ __forceinline__ void operator()(f32x4 (&acc)[2][2][4][2], const pg8::Unit& u, int wr, int wc, int fr, int fq) const {
        if (u.kind == K_MIXA) pg8::for_tile(acc, u, wr, wc, fr, fq, [&](int r, int c, f32x4& a, f32x4& b) {
            f32x4 r0, r1, a0, a1; ld_bf8(SGR + (size_t)r * 1024 + c, r0, r1); ld_bf8(SGA + (size_t)r * 1024 + c, a0, a1);
#pragma unroll
            for (int j = 0; j < 4; ++j) { a[j] *= r0[j] * rcp_(a0[j]); b[j] *= r1[j] * rcp_(a1[j]); } });
        else pg8::for_tile(acc, u, wr, wc, fr, fq, [&](int r, int c, f32x4& a, f32x4& b) {
            f32x4 a0, a1; ld_bf8(SGA + (size_t)r * 1024 + c, a0, a1); st_bf8(MIX + (size_t)r * 1024 + c, a * a0, b * a1); });
    }
};
struct SchedMix {
    int G, c; const char *ARET, *WRB, *AATT, *WAB;
    __device__ __forceinline__ bool next(int i, pg8::Unit& u) const {
        const int tile = (i >> 1) * G + c; if (tile >= 256) return false;
        int pm, pn; pg8::tile_of(tile, 64, 4, pm, pn); u.pm = pm; u.pn = pn;
        if ((i & 1) == 0) { u.A = ARET + (size_t)pm * 256 * 1024 * 2; u.B = WRB + (size_t)pn * 256 * 1024 * 2; u.lda = 1024; u.ldb = 1024; u.nt = 16; u.kind = K_MIXA; u.keep = 1; }
        else { u.A = AATT + (size_t)pm * 256 * 512 * 2; u.B = WAB + (size_t)pn * 256 * 512 * 2; u.lda = 512; u.ldb = 512; u.nt = 8; u.kind = K_MIXB; u.keep = 0; }
        return true;
    }
};

#define MFMA32(a, b, c) __builtin_amdgcn_mfma_f32_32x32x16_bf16((a), (b), (c), 0, 0, 0)
__device__ __forceinline__ bf16x8 pack8(const float* v) { u32x4 w; w.x = pk2(v[0], v[1]); w.y = pk2(v[2], v[3]); w.z = pk2(v[4], v[5]); w.w = pk2(v[6], v[7]); return __builtin_bit_cast(bf16x8, w); }
__device__ __forceinline__ bf16x8 ld_2x4(const bf16* p) { const u32x2 lo = *(const u32x2*)p, hi = *(const u32x2*)(p + 8); u32x4 w; w.x = lo.x; w.y = lo.y; w.z = hi.x; w.w = hi.y; return __builtin_bit_cast(bf16x8, w); }

__device__ __forceinline__ unsigned off_b(unsigned row, unsigned ch) { return 256u * row + 16u * (ch ^ (((row & 3) << 2) | ((row >> 2) & 3))); }
__device__ __forceinline__ unsigned off_k(unsigned row, unsigned ch) { return 128u * row + 16u * (ch ^ (((row >> 1) & 1) << 2)); }
typedef short v4i16_t __attribute__((ext_vector_type(4)));
__device__ __forceinline__ v4i16_t tr_rd(const LAS unsigned char* p) { return __builtin_amdgcn_ds_read_tr16_b64_v4i16((LAS v4i16_t*)p); }
__device__ __forceinline__ bf16x8 cat44(v4i16_t a, v4i16_t b) { return (bf16x8){a[0], a[1], a[2], a[3], b[0], b[1], b[2], b[3]}; }
__device__ __forceinline__ v4i16_t tr_b(const LAS unsigned char* T, int r0, int ct, int lane) { const int blk = (lane >> 4) & 1, q = (lane & 15) >> 2, pp = lane & 3; return tr_rd(T + off_b(r0 + q, 4 * ct + 2 * blk + (pp >> 1)) + 8 * (pp & 1)); }
__device__ __forceinline__ v4i16_t tr_k(const LAS unsigned char* T, int r0, int ct, int lane) { const int blk = (lane >> 4) & 1, q = (lane & 15) >> 2, pp = lane & 3; return tr_rd(T + off_k(r0 + q, 4 * ct + 2 * blk + (pp >> 1)) + 8 * (pp & 1)); }

constexpr int BT = 192;
__device__ __forceinline__ void attn_tile(int item, const bf16* __restrict__ AQ, const bf16* __restrict__ AK, const bf16* __restrict__ AV, bf16* __restrict__ OG, float* __restrict__ LSE,
                                          const LAS float* biasl, LAS unsigned char* wl, int lane) {
    const int q32 = item & 3, idx16 = (item >> 2) & 15, h = (item >> 6) & 3, gb = item >> 8, b = gb & 7, g = gb >> 3;
    const int sh = 2 * g, dil = 1 << sh, nbs = 4 - sh;
    const int s = idx16 >> nbs, q0 = (idx16 & ((1 << nbs) - 1)) * 128 + q32 * 32;
    const int r = lane & 31, hh = lane >> 5, srow = lane >> 4, sch = lane & 15;
    const size_t rowbase = (size_t)b * SEQ + s;
    LAS unsigned char* Kt = wl; LAS unsigned char* Vt = wl + 8192;
    bf16x8 qf[8];
    { const bf16* qp = AQ + (rowbase + (size_t)dil * (q0 + r)) * 1536 + g * 512 + h * 128 + hh * 8;
#pragma unroll
      for (int ks = 0; ks < 8; ++ks) qf[ks] = *(const bf16x8*)(qp + ks * 16); }
    const int kb_lo = q0 >= 128 ? 0 : 4 - (q0 >> 5);
    const size_t kstride = (size_t)dil * 1536;
    const bf16* kg = AK + (rowbase + (size_t)dil * srow) * 1536 + g * 512 + h * 128 + sch * 8;
    const bf16* vg = AV + (rowbase + (size_t)dil * srow) * 1536 + g * 512 + h * 128 + sch * 8;
    u32x4 kr[8], vr[8];
    { const int kbase = q0 - 128 + 32 * kb_lo;
#pragma unroll
      for (int t = 0; t < 8; ++t) { kr[t] = *(const u32x4*)(kg + (size_t)(kbase + 4 * t) * kstride); vr[t] = *(const u32x4*)(vg + (size_t)(kbase + 4 * t) * kstride); } }
    f32x16 O[4];
#pragma unroll
    for (int dt = 0; dt < 4; ++dt)
#pragma unroll
        for (int q = 0; q < 16; ++q) O[dt][q] = 0.f;
    float m = -INFINITY, l = 0.f;
    const LAS float* bl = biasl + (g * 4 + h) * BT + 32 + r - 4 * hh;
    for (int kb = kb_lo; kb < 5; ++kb) {
        const int kbase = q0 - 128 + 32 * kb;
#pragma unroll
        for (int t = 0; t < 8; ++t) { *(LAS u32x4*)(Kt + off_b(4 * t + srow, sch)) = kr[t]; *(LAS u32x4*)(Vt + off_b(4 * t + srow, sch)) = vr[t]; }
        if (kb < 4) {
#pragma unroll
            for (int t = 0; t < 8; ++t) { kr[t] = *(const u32x4*)(kg + (size_t)(kbase + 32 + 4 * t) * kstride); vr[t] = *(const u32x4*)(vg + (size_t)(kbase + 32 + 4 * t) * kstride); } }
        f32x16 S;
#pragma unroll
        for (int q = 0; q < 16; ++q) S[q] = 0.f;
#pragma unroll
        for (int ks = 0; ks < 8; ++ks) { const bf16x8 kf = *(const LAS bf16x8*)(Kt + off_b(r, 2 * ks + hh)); S = MFMA32(kf, qf[ks], S); }
        const LAS float* bq = bl + (q0 - kbase);
        float sv[16]; float mx = -INFINITY;
#pragma unroll
        for (int q = 0; q < 16; ++q) { sv[q] = S[q] + bq[-((q & 3) + 8 * (q >> 2))]; mx = fmaxf(mx, sv[q]); }
        mx = fmaxf(mx, __shfl_xor(mx, 32));
        const float mn = fmaxf(m, mx), ms = (mn == -INFINITY) ? 0.f : mn;
        const float alpha = ex2_(m - ms);
        float rs = 0.f;
#pragma unroll
        for (int q = 0; q < 16; ++q) { sv[q] = ex2_(sv[q] - ms); rs += sv[q]; }
        rs += __shfl_xor(rs, 32);
        l = l * alpha + rs; m = mn;
        if (!__all(alpha == 1.0f)) {
#pragma unroll
            for (int dt = 0; dt < 4; ++dt) O[dt] *= alpha; }
        const bf16x8 pb0 = pack8(sv), pb1 = pack8(sv + 8);
#pragma unroll
        for (int dt = 0; dt < 4; ++dt) {
            const bf16x8 v0 = cat44(tr_b(Vt, 4 * hh, dt, lane), tr_b(Vt, 8 + 4 * hh, dt, lane));
            const bf16x8 v1 = cat44(tr_b(Vt, 16 + 4 * hh, dt, lane), tr_b(Vt, 24 + 4 * hh, dt, lane));
            O[dt] = MFMA32(v0, pb0, O[dt]); O[dt] = MFMA32(v1, pb1, O[dt]);
        }
    }
    const float inv = rcp_(l);
    const size_t row = rowbase + (size_t)dil * (q0 + r);
    bf16* op = OG + ((size_t)g * MT + row) * 512 + h * 128 + 4 * hh;
#pragma unroll
    for (int dt = 0; dt < 4; ++dt)
#pragma unroll
        for (int rg = 0; rg < 4; ++rg) st_bf4(op + dt * 32 + 8 * rg, (f32x4){O[dt][4 * rg] * inv, O[dt][4 * rg + 1] * inv, O[dt][4 * rg + 2] * inv, O[dt][4 * rg + 3] * inv});
    if (hh == 0) LSE[((size_t)g * MT + row) * 4 + h] = m + log2f(l);
}

__device__ __forceinline__ void ret_kv_tile(int item, const bf16* __restrict__ RK, const bf16* __restrict__ RV, float* __restrict__ KV, const f32x2* __restrict__ dec, LAS unsigned char* wl, int lane) {
    const int kt = item & 1, c = (item >> 1) & 15, bh = item >> 5, b = bh >> 3, h = bh & 7, r = lane & 31, hh = lane >> 5;
    LAS unsigned char* Kt = wl; LAS unsigned char* Vt = wl + 4096;
    const size_t tok0 = (size_t)b * SEQ + c * 128;
    const bf16* kg = RK + (tok0 + (lane >> 3)) * 512 + h * 64 + (lane & 7) * 8;
    const bf16* vg = RV + (tok0 + (lane >> 4)) * 1024 + h * 128 + (lane & 15) * 8;
    u32x4 kr[4], vr[8];
#pragma unroll
    for (int t = 0; t < 4; ++t) kr[t] = *(const u32x4*)(kg + (size_t)(8 * t) * 512);
#pragma unroll
    for (int t = 0; t < 8; ++t) vr[t] = *(const u32x4*)(vg + (size_t)(4 * t) * 1024);
    f32x16 D[4];
#pragma unroll
    for (int vt = 0; vt < 4; ++vt)
#pragma unroll
        for (int q = 0; q < 16; ++q) D[vt][q] = 0.f;
    for (int tb = 0; tb < 4; ++tb) {
#pragma unroll
        for (int t = 0; t < 4; ++t) *(LAS u32x4*)(Kt + off_k(8 * t + (lane >> 3), lane & 7)) = kr[t];
#pragma unroll
        for (int t = 0; t < 8; ++t) *(LAS u32x4*)(Vt + off_b(4 * t + (lane >> 4), lane & 15)) = vr[t];
        if (tb < 3) {
#pragma unroll
            for (int t = 0; t < 4; ++t) kr[t] = *(const u32x4*)(kg + (size_t)((tb + 1) * 32 + 8 * t) * 512);
#pragma unroll
            for (int t = 0; t < 8; ++t) vr[t] = *(const u32x4*)(vg + (size_t)((tb + 1) * 32 + 4 * t) * 1024);
        }
#pragma unroll
        for (int s2 = 0; s2 < 2; ++s2) {
            const bf16x8 af = cat44(tr_k(Kt, 16 * s2 + 8 * hh, kt, lane), tr_k(Kt, 16 * s2 + 8 * hh + 4, kt, lane));
#pragma unroll
            for (int vt = 0; vt < 4; ++vt) { const bf16x8 bv = cat44(tr_b(Vt, 16 * s2 + 8 * hh, vt, lane), tr_b(Vt, 16 * s2 + 8 * hh + 4, vt, lane)); D[vt] = MFMA32(af, bv, D[vt]); }
        }
    }
    const float g127 = dec[h * 128 + 127].x;
    float* o = KV + ((size_t)(bh * 16 + c) * 64 + kt * 32) * 128 + r;
#pragma unroll
    for (int vt = 0; vt < 4; ++vt)
#pragma unroll
        for (int q = 0; q < 16; ++q) { const int pq = (q & 3) + 8 * (q >> 2) + 4 * hh; o[(size_t)pq * 128 + vt * 32] = D[vt][q] * g127; }
}

__device__ __forceinline__ void ret_out_tile(int item, const bf16* __restrict__ RQ, const bf16* __restrict__ RK, const bf16* __restrict__ RV, const bf16* __restrict__ ST,
                                             const bf16* __restrict__ RG, const float* __restrict__ gn, bf16* __restrict__ ARET, LAS unsigned char* wl, int lane) {
    const int qb = item & 3, c = (item >> 2) & 15, bh = item >> 6, b = bh >> 3, h = bh & 7, r = lane & 31, hh = lane >> 5;
    const size_t tok0 = (size_t)b * SEQ + c * 128, row = tok0 + qb * 32 + r;
    LAS unsigned char* Vt = wl;
    bf16x8 qf[4], kf[4];
    { const bf16* qp = RQ + row * 512 + h * 64 + hh * 8;
#pragma unroll
      for (int ks = 0; ks < 4; ++ks) qf[ks] = *(const bf16x8*)(qp + ks * 16); }
    { const bf16* kp = RK + (tok0 + r) * 512 + h * 64 + hh * 8;
#pragma unroll
      for (int ks = 0; ks < 4; ++ks) kf[ks] = *(const bf16x8*)(kp + ks * 16); }
    const bf16* vg = RV + (tok0 + (lane >> 4)) * 1024 + h * 128 + (lane & 15) * 8;
    u32x4 vr[8];
#pragma unroll
    for (int t = 0; t < 8; ++t) vr[t] = *(const u32x4*)(vg + (size_t)(4 * t) * 1024);
    f32x16 O[4];
#pragma unroll
    for (int vt = 0; vt < 4; ++vt)
#pragma unroll
        for (int q = 0; q < 16; ++q) O[vt][q] = 0.f;
    if (c > 0) {
        const bf16* sp = ST + ((size_t)(bh * 16 + c) * 16 * 64 + lane) * 8;
#pragma unroll
        for (int ks = 0; ks < 4; ++ks) {
            bf16x8 sf[4];
#pragma unroll
            for (int vt = 0; vt < 4; ++vt) sf[vt] = *(const bf16x8*)(sp + (size_t)(vt * 4 + ks) * 64 * 8);
#pragma unroll
            for (int vt = 0; vt < 4; ++vt) O[vt] = MFMA32(sf[vt], qf[ks], O[vt]);
        }
    }
    for (int kb = 0; kb <= qb; ++kb) {
#pragma unroll
        for (int t = 0; t < 8; ++t) *(LAS u32x4*)(Vt + off_b(4 * t + (lane >> 4), lane & 15)) = vr[t];
        if (kb < qb) {
#pragma unroll
            for (int t = 0; t < 8; ++t) vr[t] = *(const u32x4*)(vg + (size_t)((kb + 1) * 32 + 4 * t) * 1024); }
        f32x16 X;
#pragma unroll
        for (int q = 0; q < 16; ++q) X[q] = 0.f;
#pragma unroll
        for (int ks = 0; ks < 4; ++ks) X = MFMA32(kf[ks], qf[ks], X);
        if (kb < qb) { const bf16* kp = RK + (tok0 + (kb + 1) * 32 + r) * 512 + h * 64 + hh * 8;
#pragma unroll
            for (int ks = 0; ks < 4; ++ks) kf[ks] = *(const bf16x8*)(kp + ks * 16); }
        float xv[16];
#pragma unroll
        for (int q = 0; q < 16; ++q) { const int kk = (q & 3) + 8 * (q >> 2) + 4 * hh; xv[q] = (kb == qb && kk > r) ? 0.f : X[q]; }
        const bf16x8 pb0 = pack8(xv), pb1 = pack8(xv + 8);
#pragma unroll
        for (int vt = 0; vt < 4; ++vt) {
            const bf16x8 v0 = cat44(tr_b(Vt, 4 * hh, vt, lane), tr_b(Vt, 8 + 4 * hh, vt, lane));
            const bf16x8 v1 = cat44(tr_b(Vt, 16 + 4 * hh, vt, lane), tr_b(Vt, 24 + 4 * hh, vt, lane));
            O[vt] = MFMA32(v0, pb0, O[vt]); O[vt] = MFMA32(v1, pb1, O[vt]);
        }
    }
    float sum = 0.f;
#pragma unroll
    for (int vt = 0; vt < 4; ++vt)
#pragma unroll
        for (int q = 0; q < 16; ++q) sum += O[vt][q];
    sum += __shfl_xor(sum, 32);
    const float mu = sum * (1.f / 128.f);
    float sq = 0.f;
#pragma unroll
    for (int vt = 0; vt < 4; ++vt)
#pragma unroll
        for (int q = 0; q < 16; ++q) { const float d = O[vt][q] - mu; sq += d * d; }
    sq += __shfl_xor(sq, 32);
    const float rstd = rsqrtf(sq * (1.f / 128.f) + NORM_EPS);
    const size_t ob = row * 1024 + h * 128 + 4 * hh;
#pragma unroll
    for (int vt = 0; vt < 4; ++vt)
#pragma unroll
        for (int rg = 0; rg < 4; ++rg) {
            const int vo = vt * 32 + 8 * rg;
            const f32x4 gate = ld_bf4(RG + ob + vo), gg = *(const f32x4*)(gn + h * 128 + 4 * hh + vo);
            f32x4 o;
#pragma unroll
            for (int j = 0; j < 4; ++j) o[j] = gate[j] * (O[vt][4 * rg + j] - mu) * rstd * gg[j];
            st_bf4(ARET + ob + vo, o);
        }
}

template <bool PERM>
__device__ __forceinline__ void transpose_item(const float* __restrict__ W, int K, int N, bf16* __restrict__ WT, LAS float* scr, int item, int lane) {
    const int nblk = N / 32, kb = item / nblk, nb = item % nblk, k0 = 64 * kb, n0 = 32 * nb;
    int srcc = n0 + (lane & 31);
    if (PERM && n0 < 1024) srcc = (n0 & ~63) + ((n0 & 32) >> 1) + ((lane & 31) >> 1) + 32 * (lane & 1);
#pragma unroll 8
    for (int i = 0; i < 32; ++i) { const int kk = 2 * i + (lane >> 5); scr[kk * 33 + (lane & 31)] = W[(size_t)(k0 + kk) * N + srcc]; }
    asm volatile("s_waitcnt lgkmcnt(0)" ::: "memory");
    const int c = lane & 7;
#pragma unroll
    for (int j = 0; j < 4; ++j) { const int n = (lane >> 3) + 8 * j; const LAS float* s = scr + (8 * c) * 33 + n;
        u32x4 o; o.x = pk2(s[0 * 33], s[1 * 33]); o.y = pk2(s[2 * 33], s[3 * 33]); o.z = pk2(s[4 * 33], s[5 * 33]); o.w = pk2(s[6 * 33], s[7 * 33]);
        *(u32x4*)(WT + (size_t)(n0 + n) * K + k0 + 8 * c) = o; }
    asm volatile("s_waitcnt lgkmcnt(0)" ::: "memory");
}
__device__ __forceinline__ void rms_row_to_bf16(const float* __restrict__ xrow, const float* __restrict__ g, bf16* __restrict__ orow, int lane) {
    f32x4 v[4]; float s = 0.f;
#pragma unroll
    for (int j = 0; j < 4; ++j) { v[j] = *(const f32x4*)(xrow + 4 * lane + 256 * j); s += (v[j][0] * v[j][0] + v[j][1] * v[j][1]) + (v[j][2] * v[j][2] + v[j][3] * v[j][3]); }
    const float r = rsqrtf(wave_sum(s) * (1.f / 1024.f) + NORM_EPS);
#pragma unroll
    for (int j = 0; j < 4; ++j) { const f32x4 gg = *(const f32x4*)(g + 4 * lane + 256 * j); st_bf4(orow + 4 * lane + 256 * j, v[j] * r * gg); }
}

#define XB_TMO      128
#define XB_XCNT(j)  (256  + 64 * (j))
#define XB_XSUB(j)  (1280 + 64 * (j))
#define XB_XGEN(j)  (2304 + 64 * (j))
#define XB_TOP      3328
#define XB_TOPGEN   3392
#define XCD_BAR_WORDS 3456
#define XB_SPIN_CAP (1u << 18)
__device__ __forceinline__ unsigned xb_ld(unsigned* p)              { return __hip_atomic_load(p, __ATOMIC_RELAXED, __HIP_MEMORY_SCOPE_AGENT); }
__device__ __forceinline__ unsigned xb_add(unsigned* p, unsigned v) { return __hip_atomic_fetch_add(p, v, __ATOMIC_RELAXED, __HIP_MEMORY_SCOPE_AGENT); }
__device__ __forceinline__ unsigned xb_xcc_id() { return (unsigned)__builtin_amdgcn_s_getreg((3 << 11) | 20) & 0xFu; }
#define XB_SPIN(cond, bar) do { unsigned _sp = 0; while (cond) { __builtin_amdgcn_s_sleep(1); \
    if ((++_sp & 255u) == 0u) { if (xb_ld(&(bar)[XB_TMO])) break; if (_sp > XB_SPIN_CAP) { atomicAdd(&(bar)[XB_TMO], 1u); break; } } } } while (0)
struct XcdBarrier { unsigned* bar; unsigned x; volatile LAS unsigned* st; };
__device__ __forceinline__ XcdBarrier xcd_barrier_post(unsigned* bar, volatile LAS unsigned* st) {
    XcdBarrier b; b.bar = bar; b.x = xb_xcc_id(); b.st = st;
    if (threadIdx.x == 0) (void)xb_add(&bar[XB_XCNT(b.x)], 1u);
    return b;
}
__device__ __forceinline__ void xcd_barrier_complete(unsigned* bar, unsigned x, unsigned& nloc, unsigned& nx) {
    const unsigned G = gridDim.x * gridDim.y * gridDim.z;
    unsigned sum, cnt, mine, sp = 0u;
    for (;;) {
        sum = 0u; cnt = 0u; mine = 0u;
#pragma unroll
        for (unsigned j = 0; j < 16; ++j) { const unsigned c = xb_ld(&bar[XB_XCNT(j)]); sum += c; cnt += (c > 0u) ? 1u : 0u; mine = (j == x) ? c : mine; }
        if (sum == G) break;
        __builtin_amdgcn_s_sleep(1);
        if ((++sp & 255u) == 0u) { if (xb_ld(&bar[XB_TMO])) break; if (sp > XB_SPIN_CAP) { atomicAdd(&bar[XB_TMO], 1u); break; } }
    }
    nloc = mine > 0u ? mine : 1u; nx = cnt > 0u ? cnt : 1u;
}
__device__ __forceinline__ void xcd_barrier(const XcdBarrier& b) {
    asm volatile("s_waitcnt vmcnt(0)" ::: "memory");
    __syncthreads();
    if (threadIdx.x == 0) {
        unsigned* bar = b.bar;
        __builtin_amdgcn_s_waitcnt(0);
        unsigned nloc = b.st[0], nx = b.st[1];
        if (nloc == 0u) { xcd_barrier_complete(bar, b.x, nloc, nx); b.st[0] = nloc; b.st[1] = nx; }
        const unsigned old = xb_add(&bar[XB_XSUB(b.x)], 1u);
        const unsigned gen = old / nloc;
        if (old + 1u == (gen + 1u) * nloc) {
            __builtin_amdgcn_fence(__ATOMIC_RELEASE, "agent");
            asm volatile("s_waitcnt vmcnt(0)" ::: "memory");
            const unsigned og = xb_add(&bar[XB_TOP], 1u);
            const unsigned tg = og / nx;
            if (og + 1u == (tg + 1u) * nx) xb_add(&bar[XB_TOPGEN], 1u);
            else XB_SPIN(xb_ld(&bar[XB_TOPGEN]) == tg, bar);
            __builtin_amdgcn_fence(__ATOMIC_ACQUIRE, "agent");
            xb_add(&bar[XB_XGEN(b.x)], 1u);
            asm volatile("s_waitcnt vmcnt(0)" ::: "memory");
        } else {
            XB_SPIN(xb_ld(&bar[XB_XGEN(b.x)]) == gen, bar);
            __builtin_amdgcn_fence(__ATOMIC_ACQUIRE, "agent");
            asm volatile("s_waitcnt vmcnt(0)" ::: "memory");
        }
    }
    __syncthreads();
}

constexpr int NPHASE = 12;
__global__ void __launch_bounds__(NTHREADS, 2) fwd_kernel(Params p) {
    extern __shared__ __attribute__((aligned(16))) unsigned char lds_raw[];
    LAS unsigned char* lds = (LAS unsigned char*)lds_raw;
    volatile LAS unsigned* bst = (volatile LAS unsigned*)(lds + 131072 + 1024);
    if (threadIdx.x == 0) { bst[0] = 0u; bst[1] = 0u; bst[2] = 0u; bst[3] = 0u; }
    __syncthreads();
    const XcdBarrier gbar = xcd_barrier_post((unsigned*)(p.ws + WS_CTL) + 4096, bst);
    const int G = gridDim.x, nw = G * NWAVES;
    const size_t nthr = (size_t)G * NTHREADS;
#define PHASE_IDS int tid = threadIdx.x; asm volatile("" : "+v"(tid)); const int lane = tid & 63, wave = tid >> 6, gw = blockIdx.x * NWAVES + wave; const size_t gtid = (size_t)blockIdx.x * NTHREADS + tid; (void)lane; (void)wave; (void)gw; (void)gtid;
    unsigned char* ws = p.ws; float* out = p.out;
    const f32x2* rope = (const f32x2*)(ws + WS_ROPE);
    float* bias2 = (float*)(ws + WS_BIAS);
    const f32x2* dec = (const f32x2*)(ws + WS_DEC);
    bf16* WIN = (bf16*)(ws + WS_WIN); bf16* WRB = (bf16*)(ws + WS_WRB); bf16* WAB = (bf16*)(ws + WS_WAB); bf16* WO = (bf16*)(ws + WS_WO);
    bf16* WU = (bf16*)(ws + WS_WU); bf16* WD = (bf16*)(ws + WS_WD); bf16* WPL = (bf16*)(ws + WS_WPL); bf16* WPG = (bf16*)(ws + WS_WPG);
    bf16* HN = (bf16*)(ws + WS_HN); float* KV = (float*)(ws + WS_HN); bf16* ARET = HN; bf16* PB = (bf16*)(ws + WS_PB); bf16* P = (bf16*)(ws + WS_P);
    bf16* RQ = (bf16*)(ws + WS_RQ); bf16* RK = (bf16*)(ws + WS_RK); bf16* RV = (bf16*)(ws + WS_RV); bf16* MIX = RV;
    float* ROS = (float*)(ws + WS_ROS);
    bf16* RG = (bf16*)(ws + WS_RG); bf16* H2 = RG; bf16* AQ = (bf16*)(ws + WS_AQ); bf16* ST = AQ; bf16* AK = (bf16*)(ws + WS_AK); bf16* AATT = AK; bf16* AV = (bf16*)(ws + WS_AV); bf16* U = AQ;
    bf16* SGR = (bf16*)(ws + WS_SGR); bf16* X2B = SGR; bf16* SGA = (bf16*)(ws + WS_SGA); bf16* OG = (bf16*)(ws + WS_OG); float* LSE = (float*)(ws + WS_LSE);
    float* RSQ = (float*)(ws + WS_RSQ);
    float* X = out + O_Y;
    const int lo = p.ph_lo, hi = p.ph_hi;
#define IN(k) (lo <= (k) && (k) < hi)
#define SEAM(k) do { if (IN(k) && IN((k) + 1)) xcd_barrier(gbar); } while (0)

    if (IN(0)) { PHASE_IDS
        LAS float* scr = (LAS float*)(lds + wave * 16384);
        constexpr int I_IN = 16 * (NIN / 32), I_RB = 16 * 32, I_AB = 8 * 32, I_O = 16 * 32, I_U = 16 * 128, I_D = 64 * 32, I_PL = 4 * 32, I_PG = 16 * 32;
        constexpr int NITEMS = I_IN + I_RB + I_AB + I_O + I_U + I_D + I_PL + I_PG;
        for (int it = gw; it < NITEMS; it += nw) {
            int r = it;
            if (r < I_IN) { transpose_item<true>(p.in[I_WIN], 1024, NIN, WIN, scr, r, lane); continue; } r -= I_IN;
            if (r < I_RB) { transpose_item<false>(p.in[I_WRB], 1024, 1024, WRB, scr, r, lane); continue; } r -= I_RB;
            if (r < I_AB) { transpose_item<false>(p.in[I_WAB], 512, 1024, WAB, scr, r, lane); continue; } r -= I_AB;
            if (r < I_O) { transpose_item<false>(p.in[I_WO], 1024, 1024, WO, scr, r, lane); continue; } r -= I_O;
            if (r < I_U) { transpose_item<false>(p.in[I_WU], 1024, DFF, WU, scr, r, lane); continue; } r -= I_U;
            if (r < I_D) { transpose_item<false>(p.in[I_WD], DFF, 1024, WD, scr, r, lane); continue; } r -= I_D;
            if (r < I_PL) { transpose_item<false>(p.in[I_WPL], DPLE, 1024, WPL, scr, r, lane); continue; } r -= I_PL;
            transpose_item<false>(p.in[I_WPG], 1024, 1024, WPG, scr, r, lane);
        }
        for (int m = gw; m < MT; m += nw) {
            const float* xr = m < MP ? p.in[I_XP] + (size_t)m * 1024 : p.in[I_XS] + (size_t)(m - MP) * 1024;
            rms_row_to_bf16(xr, p.in[I_LN1], HN + (size_t)m * 1024, lane);
            const float* pr = m < MP ? p.in[I_PP] + (size_t)m * DPLE : p.in[I_PS] + (size_t)(m - MP) * DPLE;
            st_bf4(PB + (size_t)m * DPLE + 4 * lane, *(const f32x4*)(pr + 4 * lane));
        }
        for (size_t i = gtid; i < (size_t)2049 * 32; i += nthr) {
            const int tp = (int)(i >> 5), j = (int)(i & 31);
            const float pos = tp < SEQ ? (float)tp : 16384.0f;
            const float inv = exp2f(-(float)j * (13.287712379549449f / 32.0f));
            const float ang = pos * inv;
            double rev = (double)ang * 0.15915494309189535; rev -= floor(rev);
            const float rr = (float)(rev * 6.283185307179586 - 3.141592653589793);
            float sn, cs; __sincosf(rr, &sn, &cs);
            ((f32x2*)(ws + WS_ROPE))[i] = (f32x2){-cs, -sn};
        }
        for (size_t i = gtid; i < 12 * 128; i += nthr) {
            const int gh = (int)(i >> 7), j = (int)(i & 127), g = gh >> 2;
            const int d = j * dil_of(g);
            int bkt;
            if (d < 16) bkt = d;
            else { const float lr = logf((float)d / 16.0f) / 4.852030263919617f; bkt = 16 + (int)(lr * 16.0f); bkt = bkt < 31 ? bkt : 31; }
            bias2[i] = p.in[I_RELB][bkt * 12 + gh] * LOG2E;
        }
        for (size_t i = gtid; i < 8 * 128; i += nthr) {
            const int h = (int)(i >> 7), j = (int)(i & 127);
            const float lg = log2f(1.0f - exp2f(-5.0f - (float)h));
            ((f32x2*)(ws + WS_DEC))[i] = (f32x2){exp2f((float)j * lg), exp2f(-(float)j * lg)};
        }
        { const CpArgs cpa{p.in[I_CK128], p.in[I_CV128], p.in[I_CK512], p.in[I_CV512], p.in[I_CK2K], p.in[I_CV2K], out};
          for (int cid = CP_CHUNKS - 1 - gw; cid >= 0; cid -= nw) cp_chunk(cpa, cid, lane); }
    }
    SEAM(0);

    if (IN(1)) { PHASE_IDS
        const EIn e{RQ, RK, RV, RG, AQ, AK, AV, SGR, SGA, rope, dec, out}; const EStoreBf ep{P, 1024};
        { const EpiG1 E{e, ep}; const SchedG1 S{G, (int)blockIdx.x, (const char*)HN, (const char*)WIN, (const char*)PB, (const char*)WPL}; pg8::gemm_phase(lds, S, E); }
        const int s0 = (G == 256) ? (int)blockIdx.x - 128 : (int)blockIdx.x, sn = (G == 256) ? 128 : G;
        if (s0 >= 0) for (int t = s0; t < 168; t += sn) {
            if (t < 152) sample_tile(lds, HN + (size_t)MP * 1024, 1024, WIN, 1024, 1024, t, e);
            else sample_tile(lds, PB + (size_t)MP * DPLE, DPLE, WPL, DPLE, DPLE, t - 152, ep);
        }
    }
    SEAM(1);

    if (IN(2)) { PHASE_IDS
        LAS float* biasl = (LAS float*)(lds + 131072 + 2048);
        LAS unsigned char* wl = lds + wave * 16384;
        LAS float* qs = biasl + 12 * BT;
        LAS float* sc = qs + 128;
        LAS float* red = sc + 128;
        for (int i = tid; i < 12 * BT; i += NTHREADS) { const int gh = i / BT, jd = i - gh * BT - 32; biasl[i] = ((unsigned)jd <= 127u) ? bias2[gh * 128 + jd] : -INFINITY; }
        __syncthreads();
        for (int it = blockIdx.x; it < 3 * SB * 4; it += G) {
            const int g = it / (SB * 4), rem = it - g * (SB * 4), bs = rem >> 2, h = rem & 3, dil = dil_of(g), W = win_of(g);
            const size_t row = (size_t)MP + bs;
            const float* ck = p.in[I_CK128 + 2 * g] + (size_t)bs * W * 512 + h * 128;
            const float* cv = p.in[I_CV128 + 2 * g] + (size_t)bs * W * 512 + h * 128;
            if (tid < 64) { const unsigned w = *(const unsigned*)(AQ + row * 1536 + g * 512 + h * 128 + 2 * tid); qs[2 * tid] = bflo(w); qs[2 * tid + 1] = bfhi(w); }
            __syncthreads();
            {
                const int j = tid >> 2, part = tid & 3;
                float acc = 0.f;
                if (j == 0) {
                    const bf16* kp = AK + row * 1536 + g * 512 + h * 128 + part * 32;
#pragma unroll
                    for (int c8 = 0; c8 < 4; ++c8) { f32x4 k0, k1; ld_bf8(kp + c8 * 8, k0, k1); const f32x4 q0 = *(const LAS f32x4*)(qs + part * 32 + c8 * 8), q1 = *(const LAS f32x4*)(qs + part * 32 + c8 * 8 + 4);
                        acc += k0[0] * q0[0] + k0[1] * q0[1] + k0[2] * q0[2] + k0[3] * q0[3] + k1[0] * q1[0] + k1[1] * q1[1] + k1[2] * q1[2] + k1[3] * q1[3]; }
                } else {
                    const f32x4* kp = (const f32x4*)(ck + (size_t)(W - j * dil) * 512 + part * 32);
                    f32x4 kv[8];
#pragma unroll
                    for (int c4 = 0; c4 < 8; ++c4) kv[c4] = kp[c4];
#pragma unroll
                    for (int c4 = 0; c4 < 8; ++c4) { const f32x4 q0 = *(const LAS f32x4*)(qs + part * 32 + c4 * 4); acc += kv[c4][0] * q0[0] + kv[c4][1] * q0[1] + kv[c4][2] * q0[2] + kv[c4][3] * q0[3]; }
                }
                acc += __shfl_xor(acc, 1); acc += __shfl_xor(acc, 2);
                if (part == 0) sc[j] = acc + biasl[(g * 4 + h) * BT + 32 + j];
            }
            __syncthreads();
            if (tid < 64) {
                const float s0 = sc[tid], s1 = sc[tid + 64];
                const float m = wave_max(fmaxf(s0, s1));
                const float p0 = exp2f(s0 - m), p1 = exp2f(s1 - m);
                const float den = wave_sum(p0 + p1), inv = 1.0f / den;
                sc[tid] = p0 * inv; sc[tid + 64] = p1 * inv;
                if (tid == 0) LSE[((size_t)g * MT + row) * 4 + h] = m + log2f(den);
            }
            __syncthreads();
            {
                const int d = tid & 127, kq = tid >> 7;
                float vv[32];
#pragma unroll
                for (int u = 0; u < 32; ++u) { const int j = kq * 32 + u; vv[u] = (j == 0) ? bf2f(AV[row * 1536 + g * 512 + h * 128 + d]) : cv[(size_t)(W - j * dil) * 512 + d]; }
                float o = 0.f;
#pragma unroll
                for (int u = 0; u < 32; ++u) o += sc[kq * 32 + u] * vv[u];
                red[kq * 128 + d] = o;
            }
            __syncthreads();
            if (tid < 64) {
                const float o0 = (red[2 * tid] + red[128 + 2 * tid]) + (red[256 + 2 * tid] + red[384 + 2 * tid]);
                const float o1 = (red[2 * tid + 1] + red[128 + 2 * tid + 1]) + (red[256 + 2 * tid + 1] + red[384 + 2 * tid + 1]);
                *(unsigned*)(OG + ((size_t)g * MT + row) * 512 + h * 128 + 2 * tid) = pk2(o0, o1);
            }
            __syncthreads();
        }
        if (tid < 128) for (size_t it = (size_t)blockIdx.x * 128 + tid; it < (size_t)SB * 8 * 128; it += (size_t)G * 128) {
            const int bs = (int)(it >> 10), h = (int)(it >> 7) & 7, v = (int)(it & 127);
            const float gamma = 1.0f - exp2f(-5.0f - (float)h);
            const size_t row = (size_t)MP + bs;
            const float vv = bf2f(RV[row * 1024 + h * 128 + v]);
            const float* si = p.in[I_STATE] + ((size_t)(bs * 8 + h) * 64) * 128 + v;
            float* so = out + O_STS + ((size_t)(bs * 8 + h) * 64) * 128 + v;
            float o = 0.f;
#pragma unroll 16
            for (int k = 0; k < 64; ++k) {
                const int ko = (k >> 1) + 32 * (k & 1);
                const float s = gamma * si[(size_t)ko * 128] + bf2f(RK[row * 512 + h * 64 + k]) * vv;
                o += bf2f(RQ[row * 512 + h * 64 + k]) * s;
                so[(size_t)ko * 128] = s;
            }
            ROS[(size_t)bs * 1024 + h * 128 + v] = o;
        }
        for (int it = gw; it < 3 * NB * 4 * 16 * 4; it += nw) attn_tile(it, AQ, AK, AV, OG, LSE, biasl, wl, lane);
        for (int it = gw; it < NB * 8 * 16 * 2; it += nw) ret_kv_tile(it, RK, RV, KV, dec, wl, lane);
    }
    SEAM(2);

    if (IN(3)) { PHASE_IDS
        {
            const int h = lane >> 4, co = h * 128 + (lane & 15) * 8;
#pragma unroll 2
            for (int row = gw; row < MT; row += nw) {
                const float l0 = LSE[((size_t)0 * MT + row) * 4 + h], l1 = LSE[((size_t)1 * MT + row) * 4 + h], l2 = LSE[((size_t)2 * MT + row) * 4 + h];
                const size_t off = (size_t)row * 512 + co;
                f32x4 a0, a1, b0, b1, c0, c1; ld_bf8(OG + (size_t)0 * MT * 512 + off, a0, a1); ld_bf8(OG + (size_t)1 * MT * 512 + off, b0, b1); ld_bf8(OG + (size_t)2 * MT * 512 + off, c0, c1);
                const float mx = fmaxf(l0, fmaxf(l1, l2));
                float w0 = ex2_(l0 - mx), w1 = ex2_(l1 - mx), w2 = ex2_(l2 - mx); const float inv = rcp_(w0 + w1 + w2); w0 *= inv; w1 *= inv; w2 *= inv;
                st_bf8(AATT + off, a0 * w0 + b0 * w1 + c0 * w2, a1 * w0 + b1 * w1 + c1 * w2);
            }
        }
        for (size_t it = gtid; it < (size_t)64 * 8 * 128; it += nthr) {
            const int v = (int)(it & 127), pc = (int)(it >> 7) & 7, bh = (int)(it >> 10), h = bh & 7;
            const float gamma = dec[h * 128 + 1].x, g128 = dec[h * 128 + 127].x * gamma;
            float S[8];
#pragma unroll
            for (int j = 0; j < 8; ++j) S[j] = 0.f;
            for (int c0 = 0; c0 < 16; c0 += 4) {
                float kv[4][8];
#pragma unroll
                for (int cc = 0; cc < 4; ++cc) { const float* kvp = KV + ((size_t)(bh * 16 + c0 + cc) * 64 + pc * 8) * 128 + v;
#pragma unroll
                    for (int j = 0; j < 8; ++j) kv[cc][j] = kvp[(size_t)j * 128]; }
#pragma unroll
                for (int cc = 0; cc < 4; ++cc) { const int c = c0 + cc;
#pragma unroll
                    for (int j = 0; j < 8; ++j) S[j] = g128 * S[j] + kv[cc][j];
                    if (c < 15) st_bf8(ST + ((((size_t)(bh * 16 + (c + 1)) * 4 + (v >> 5)) * 4 + (pc >> 1)) * 64 + (pc & 1) * 32 + (v & 31)) * 8, (f32x4){gamma * S[0], gamma * S[1], gamma * S[2], gamma * S[3]}, (f32x4){gamma * S[4], gamma * S[5], gamma * S[6], gamma * S[7]}); }
            }
            float* so = out + O_STP + ((size_t)bh * 64) * 128 + v;
#pragma unroll
            for (int j = 0; j < 8; ++j) { const int pq = pc * 8 + j; so[(size_t)((pq >> 1) + 32 * (pq & 1)) * 128] = S[j]; }
        }
    }
    SEAM(3);

    if (IN(4)) { PHASE_IDS
        for (int it = gw; it < NB * 8 * 16 * 4; it += nw) ret_out_tile(it, RQ, RK, RV, ST, RG, p.in[I_GN], ARET, lds + wave * 16384, lane);
        const float* gn = p.in[I_GN];
        for (int it = gw; it < SB * 8; it += nw) {
            const int bs = it >> 3, h = it & 7;
            const size_t base = (size_t)(MP + bs) * 1024 + h * 128, sb = (size_t)bs * 1024 + h * 128;
            const float x0 = ROS[sb + lane], x1 = ROS[sb + 64 + lane];
            const float mu = wave_sum(x0 + x1) * (1.f / 128.f);
            const float d0 = x0 - mu, d1 = x1 - mu;
            const float r = rsqrtf(wave_sum(d0 * d0 + d1 * d1) * (1.f / 128.f) + NORM_EPS);
            ARET[base + lane] = (bf16)f2bf(bf2f(RG[base + lane]) * d0 * r * gn[h * 128 + lane]);
            ARET[base + 64 + lane] = (bf16)f2bf(bf2f(RG[base + 64 + lane]) * d1 * r * gn[h * 128 + 64 + lane]);
        }
    }
    SEAM(4);

    if (IN(5)) {
        for (int t = blockIdx.x; t < 16; t += G) {
            f32x4 r0 = (f32x4){0.f, 0.f, 0.f, 0.f}, r1 = r0;
            sample_tile(lds, ARET + (size_t)MP * 1024, 1024, WRB, 1024, 1024, t, [&](int, int, f32x4 v0, f32x4 v1) { r0 = v0; r1 = v1; });
            sample_tile(lds, AATT + (size_t)MP * 512, 512, WAB, 512, 512, t, [&](int row, int c, f32x4 v0, f32x4 v1) {
                f32x4 g0, g1, a0, a1; ld_bf8(SGR + (size_t)row * 1024 + c, g0, g1); ld_bf8(SGA + (size_t)row * 1024 + c, a0, a1);
                st_bf8(MIX + (size_t)row * 1024 + c, g0 * r0 + a0 * v0, g1 * r1 + a1 * v1); });
        }
        const EpiMix E{SGR, SGA, MIX}; const SchedMix S{G, (int)blockIdx.x, (const char*)ARET, (const char*)WRB, (const char*)AATT, (const char*)WAB};
        pg8::gemm_phase(lds, S, E);
    }
    SEAM(5);
    if (IN(6)) {
        const EResIn e{p.in[I_XP], p.in[I_XS], X, H2, p.in[I_LN2]};
        for (int t = blockIdx.x; t < 16; t += G) sample_tile(lds, MIX + (size_t)MP * 1024, 1024, WO, 1024, 1024, t, [&](int row, int c, f32x4 v0, f32x4 v1) {
            float ss = e(row, c, v0, v1); ss += __shfl_xor(ss, 1); ss += __shfl_xor(ss, 2); ss += __shfl_xor(ss, 4);
            if ((threadIdx.x & 7) == 0) RSQ[(size_t)row * 16 + t] = ss; });
        const EpiWo E{e, RSQ}; const SchedPlain S{G, (int)blockIdx.x, 4, 1024, (const char*)MIX, (const char*)WO}; pg8::gemm_phase(lds, S, E);
    }
    SEAM(6);
    if (IN(8)) {
        const ERelu2 e{U};
        for (int t = blockIdx.x; t < 64; t += G) sample_tile(lds, H2 + (size_t)MP * 1024, 1024, WU, 1024, 1024, t, [&](int row, int c, f32x4 v0, f32x4 v1) { e(row, c, v0, v1, row_rstd(RSQ, row)); });
        const EpiUp E{e, RSQ}; const SchedPlain S{G, (int)blockIdx.x, 16, 1024, (const char*)H2, (const char*)WU}; pg8::gemm_phase(lds, S, E);
    }
    SEAM(8);
    if (IN(9)) {
        const EResX e{X, X2B};
        for (int t = blockIdx.x; t < 16; t += G) sample_tile(lds, U + (size_t)MP * DFF, DFF, WD, DFF, DFF, t, e);
        const EpiSimple<EResX> E{e}; const SchedPlain S{G, (int)blockIdx.x, 4, DFF, (const char*)U, (const char*)WD}; pg8::gemm_phase(lds, S, E);
    }
    SEAM(9);
    if (IN(10)) {
        const EPle e{X, P};
        for (int t = blockIdx.x; t < 16; t += G) sample_tile(lds, X2B + (size_t)MP * 1024, 1024, WPG, 1024, 1024, t, e);
        const EpiSimple<EPle> E{e}; const SchedPlain S{G, (int)blockIdx.x, 4, 1024, (const char*)X2B, (const char*)WPG}; pg8::gemm_phase(lds, S, E);
    }
    SEAM(10);
    if (IN(11)) { PHASE_IDS
        const float* g = p.in[I_LNF];
        for (int m = gw; m < MT; m += nw) {
            float* xr = X + (size_t)m * 1024;
            f32x4 v[4]; float s = 0.f;
#pragma unroll
            for (int j = 0; j < 4; ++j) { v[j] = *(const f32x4*)(xr + 4 * lane + 256 * j); s += (v[j][0] * v[j][0] + v[j][1] * v[j][1]) + (v[j][2] * v[j][2] + v[j][3] * v[j][3]); }
            const float r = rsqrtf(wave_sum(s) * (1.f / 1024.f) + NORM_EPS);
#pragma unroll
            for (int j = 0; j < 4; ++j) { const f32x4 gg = *(const f32x4*)(g + 4 * lane + 256 * j); *(f32x4*)(xr + 4 * lane + 256 * j) = v[j] * r * gg; }
        }
    }
#undef IN
#undef SEAM
}

#ifndef MK_N_LAUNCHES
#define MK_N_LAUNCHES 1
#endif
extern "C" void kernel_launch(void* const* d_in, const int* in_sizes, int n_in, void* d_out, int out_size, void* d_ws, size_t ws_size, hipStream_t stream) {
    static int grid = 0;
    if (grid == 0) {
        if (n_in != 24 || (size_t)out_size != O_END || ws_size < WS_END) { fprintf(stderr, "kernel_launch: unexpected problem shape (n_in %d out %d ws %zu)\n", n_in, out_size, ws_size); grid = -1; return; }
        int dev = 0, cus = 0, per_cu = 0;
        if (hipGetDevice(&dev) != hipSuccess || hipDeviceGetAttribute(&cus, hipDeviceAttributeMultiprocessorCount, dev) != hipSuccess) { grid = -1; return; }
        if (hipFuncSetAttribute((const void*)fwd_kernel, hipFuncAttributeMaxDynamicSharedMemorySize, LDS_BYTES) != hipSuccess) { fprintf(stderr, "kernel_launch: hipFuncSetAttribute failed\n"); grid = -1; return; }
        if (hipOccupancyMaxActiveBlocksPerMultiprocessor(&per_cu, (const void*)fwd_kernel, NTHREADS, LDS_BYTES) != hipSuccess || per_cu < 1) { fprintf(stderr, "kernel_launch: occupancy query failed (%d)\n", per_cu); (void)hipGetLastError(); per_cu = 1; }
        grid = cus * (per_cu < 1 ? 1 : (per_cu > 1 ? 1 : per_cu));
    }
    if (grid < 0) return;
    (void)hipMemsetAsync((char*)d_ws + WS_CTL, 0, CTL_ZERO_BYTES, stream);
    Params p{};
    for (int i = 0; i < 24; ++i) p.in[i] = (const float*)d_in[i];
    p.out = (float*)d_out; p.ws = (unsigned char*)d_ws;
#if MK_N_LAUNCHES == 1
    p.ph_lo = 0; p.ph_hi = NPHASE;
    void* args[] = {&p};
    hipError_t e = hipLaunchCooperativeKernel((const void*)fwd_kernel, dim3(grid), dim3(NTHREADS), args, LDS_BYTES, stream);
    if (e != hipSuccess) fprintf(stderr, "kernel_launch: cooperative launch failed: %s (grid %d)\n", hipGetErrorString(e), grid);
#else
    for (int k = 0; k < NPHASE; ++k) { p.ph_lo = k; p.ph_hi = k + 1; hipLaunchKernelGGL(fwd_kernel, dim3(grid), dim3(NTHREADS), LDS_BYTES, stream, p); }
#endif
}
```
